# Optimizing an MI355X kernel written in HIP

```python
import jax, jax.numpy as jnp
from jax import lax
import numpy as np

D_MODEL = 1024
BATCH = 4
SEQ = 8192
DEPTH = 2

GRID_W = 64
HEAD_DIM = 64
MIX_WIDTH = D_MODEL // 2
ATTN_Q_HEADS = MIX_WIDTH // HEAD_DIM
ATTN_KV_HEADS = ATTN_Q_HEADS // 4
NAT_HEADS = MIX_WIDTH // HEAD_DIM
NAT_WIN_ROWS = 8
NAT_WIN_COLS = 16
SSM_GROUP = 16
SSM_GROUPS = MIX_WIDTH // SSM_GROUP
SSM_STATE = 64
N_BRANCHES = 3
FFN_DIM = 4 * D_MODEL
Q_BLOCK = 128
ROPE_THETA = 10000.0
LN_EPS = 1e-5
RMS_EPS = 1e-6
DEEPNORM_ALPHA = (2 * DEPTH) ** 0.25
DEEPNORM_BETA = (8 * DEPTH) ** -0.25
IN_SPLITS = (ATTN_Q_HEADS * HEAD_DIM, ATTN_KV_HEADS * HEAD_DIM, ATTN_KV_HEADS * HEAD_DIM,
             NAT_HEADS * HEAD_DIM, NAT_HEADS * HEAD_DIM, NAT_HEADS * HEAD_DIM,
             MIX_WIDTH, N_BRANCHES * D_MODEL)
IN_WIDTH = sum(IN_SPLITS)

kernel_name = 'hybrid_gated_gqa_nat_s5_encoder'


def _layer_norm(x, gain, bias):
    xf = x.astype(jnp.float32)
    mu = jnp.mean(xf, axis=-1, keepdims=True)
    xc = xf - mu
    var = jnp.mean(xc * xc, axis=-1, keepdims=True)
    y = xc * lax.rsqrt(var + LN_EPS) * gain.astype(jnp.float32) + bias.astype(jnp.float32)
    return y.astype(x.dtype)


def _rms_norm_f32(x, gain):
    xf = x.astype(jnp.float32)
    return xf * lax.rsqrt(jnp.mean(xf * xf, axis=-1, keepdims=True) + RMS_EPS) * gain.astype(jnp.float32)


def _axial_rope_tables(seq_len):
    t = jnp.arange(seq_len)
    row = (t // GRID_W).astype(jnp.float32)
    col = (t % GRID_W).astype(jnp.float32)
    axis_dim = HEAD_DIM // 2
    inv_freq = 1.0 / (ROPE_THETA ** (jnp.arange(0, axis_dim, 2, dtype=jnp.float32) / axis_dim))
    ang_r = row[:, None] * inv_freq[None, :]
    ang_c = col[:, None] * inv_freq[None, :]
    return (jnp.cos(ang_r), jnp.sin(ang_r), jnp.cos(ang_c), jnp.sin(ang_c))


def _rope_rotate(x, cos, sin):
    half = x.shape[-1] // 2
    x1 = x[..., :half]
    x2 = x[..., half:]
    c = cos[None, :, None, :]
    s = sin[None, :, None, :]
    return jnp.concatenate([x1 * c - x2 * s, x2 * c + x1 * s], axis=-1)


def _apply_axial_rope(x, rope):
    cos_r, sin_r, cos_c, sin_c = rope
    axis_dim = HEAD_DIM // 2
    return jnp.concatenate([_rope_rotate(x[..., :axis_dim], cos_r, sin_r),
                            _rope_rotate(x[..., axis_dim:], cos_c, sin_c)], axis=-1)


def _gqa_block_attention(q, k, v):
    bsz, seq_len, n_q, d = q.shape
    n_kv = k.shape[2]
    grp = n_q // n_kv
    n_blocks = seq_len // Q_BLOCK
    scale = d ** -0.5
    qb = jnp.moveaxis(q.reshape(bsz, n_blocks, Q_BLOCK, n_kv, grp, d), 1, 0)

    def block(qi):
        s = jnp.einsum('bqkgd,bskd->bkgqs', qi, k).astype(jnp.float32) * scale
        p = jax.nn.softmax(s, axis=-1).astype(v.dtype)
        return jnp.einsum('bkgqs,bskd->bqkgd', p, v)

    out = lax.map(block, qb)
    return jnp.moveaxis(out, 0, 1).reshape(bsz, seq_len, n_q * d)


def _neighbourhood_attention(q, k, v, rel_bias):
    bsz, seq_len, n_h, d = q.shape
    rows = seq_len // GRID_W
    kr = min(NAT_WIN_ROWS, rows)
    kc = NAT_WIN_COLS
    scale = d ** -0.5
    qg = q.reshape(bsz, rows, GRID_W, n_h, d)
    kg = k.reshape(bsz, rows, GRID_W, n_h, d)
    vg = v.reshape(bsz, rows, GRID_W, n_h, d)
    cols = jnp.arange(GRID_W)
    col_start = jnp.clip(cols - kc // 2, 0, GRID_W - kc)
    col_idx = col_start[:, None] + jnp.arange(kc)[None, :]
    col_off = col_idx - cols[:, None] + (NAT_WIN_COLS - 1)
    row_ids = jnp.arange(rows)
    row_start = jnp.clip(row_ids - kr // 2, 0, rows - kr)

    def one_row(args):
        r, rs = args
        qr = lax.dynamic_index_in_dim(qg, r, axis=1, keepdims=False)
        k_rows = lax.dynamic_slice_in_dim(kg, rs, kr, axis=1)
        v_rows = lax.dynamic_slice_in_dim(vg, rs, kr, axis=1)
        kw = k_rows[:, :, col_idx]
        vw = v_rows[:, :, col_idx]
        row_off = rs + jnp.arange(kr) - r + (NAT_WIN_ROWS - 1)
        bias = rel_bias[:, row_off[None, :, None], col_off[:, None, :]].astype(jnp.float32)
        s = jnp.einsum('bqhd,biqjhd->bhqij', qr, kw).astype(jnp.float32) * scale + bias[None]
        p = jax.nn.softmax(s.reshape(bsz, n_h, GRID_W, kr * kc), axis=-1).reshape(s.shape).astype(vw.dtype)
        return jnp.einsum('bhqij,biqjhd->bqhd', p, vw)

    out = lax.map(one_row, (row_ids, row_start))
    return jnp.moveaxis(out, 0, 1).reshape(bsz, seq_len, n_h * d)


def _complex_diag_combine(e1, e2):
    ar1, ai1, br1, bi1 = e1
    ar2, ai2, br2, bi2 = e2
    ar = ar2 * ar1 - ai2 * ai1
    ai = ar2 * ai1 + ai2 * ar1
    br = ar2 * br1 - ai2 * bi1 + br2
    bi = ar2 * bi1 + ai2 * br1 + bi2
    return (ar, ai, br, bi)


def _s5_scan_direction(ug, a_re, a_im, log_dt, b_re, b_im, c_re, c_im, reverse):
    seq_len = ug.shape[1]
    a_re = a_re.astype(jnp.float32)
    a_im = a_im.astype(jnp.float32)
    dt = jnp.exp(log_dt.astype(jnp.float32))[:, None]
    decay = jnp.exp(a_re * dt)
    phase = a_im * dt
    lam_re = decay * jnp.cos(phase)
    lam_im = decay * jnp.sin(phase)
    den = a_re * a_re + a_im * a_im
    num_re = lam_re - 1.0
    coef_re = (num_re * a_re + lam_im * a_im) / den
    coef_im = (lam_im * a_re - num_re * a_im) / den
    b_re = b_re.astype(jnp.float32)
    b_im = b_im.astype(jnp.float32)
    bbar_re = coef_re[..., None] * b_re - coef_im[..., None] * b_im
    bbar_im = coef_re[..., None] * b_im + coef_im[..., None] * b_re
    bu_re = jnp.einsum('blgh,gph->lbgp', ug, bbar_re)
    bu_im = jnp.einsum('blgh,gph->lbgp', ug, bbar_im)
    lam_re_seq = jnp.broadcast_to(lam_re[None, None], (seq_len, 1) + lam_re.shape)
    lam_im_seq = jnp.broadcast_to(lam_im[None, None], (seq_len, 1) + lam_im.shape)
    _, _, s_re, s_im = lax.associative_scan(_complex_diag_combine,
                                            (lam_re_seq, lam_im_seq, bu_re, bu_im),
                                            reverse=reverse, axis=0)
    return (jnp.einsum('lbgp,ghp->blgh', s_re, c_re.astype(jnp.float32))
            - jnp.einsum('lbgp,ghp->blgh', s_im, c_im.astype(jnp.float32)))


def _s5_bidirectional(u, a_re, a_im, log_dt, b_re, b_im, c_re, c_im, d_skip, w_glu):
    bsz, seq_len, _ = u.shape
    ug = u.reshape(bsz, seq_len, SSM_GROUPS, SSM_GROUP).astype(jnp.float32)
    y = d_skip.astype(jnp.float32) * ug
    for direction, reverse in ((0, False), (1, True)):
        y = y + _s5_scan_direction(ug, a_re[direction], a_im[direction], log_dt[direction],
                                   b_re, b_im, c_re[direction], c_im[direction], reverse)
    y = y.reshape(bsz, seq_len, MIX_WIDTH)
    z = jax.nn.gelu(y)
    out = z * jax.nn.sigmoid(z @ w_glu.astype(jnp.float32))
    return out.astype(u.dtype)


def _hybrid_mixer(h, w_in, q_norm_gain, k_norm_gain, nat_rel_bias, ssm_a_re, ssm_a_im, ssm_log_dt,
                  ssm_b_re, ssm_b_im, ssm_c_re, ssm_c_im, ssm_d, ssm_w_glu, w_branch, w_out, rope):
    bsz, seq_len, _ = h.shape
    proj = h @ w_in
    split_points = np.cumsum(IN_SPLITS)[:-1].tolist()
    aq, ak, av, nq, nk, nv, su, gate_pre = jnp.split(proj, split_points, axis=-1)
    aq = aq.reshape(bsz, seq_len, ATTN_Q_HEADS, HEAD_DIM)
    ak = ak.reshape(bsz, seq_len, ATTN_KV_HEADS, HEAD_DIM)
    av = av.reshape(bsz, seq_len, ATTN_KV_HEADS, HEAD_DIM)
    aq = _apply_axial_rope(_rms_norm_f32(aq, q_norm_gain), rope).astype(h.dtype)
    ak = _apply_axial_rope(_rms_norm_f32(ak, k_norm_gain), rope).astype(h.dtype)
    attn_o = _gqa_block_attention(aq, ak, av)
    nq = nq.reshape(bsz, seq_len, NAT_HEADS, HEAD_DIM)
    nk = nk.reshape(bsz, seq_len, NAT_HEADS, HEAD_DIM)
    nv = nv.reshape(bsz, seq_len, NAT_HEADS, HEAD_DIM)
    nat_o = _neighbourhood_attention(nq, nk, nv, nat_rel_bias)
    ssm_o = _s5_bidirectional(su, ssm_a_re, ssm_a_im, ssm_log_dt, ssm_b_re, ssm_b_im,
                              ssm_c_re, ssm_c_im, ssm_d, ssm_w_glu)
    branches = jnp.stack([attn_o, nat_o, ssm_o], axis=2)
    branch_d = jnp.einsum('blnm,nmd->blnd', branches, w_branch)
    gates = jax.nn.sigmoid(gate_pre.reshape(bsz, seq_len, N_BRANCHES, D_MODEL))
    merged = jnp.sum(gates * branch_d, axis=2)
    return merged @ w_out


def _squared_relu_mlp(h, w_up, w_down):
    return jnp.square(jax.nn.relu(h @ w_up)) @ w_down


def setup_inputs(seed: int = 0) -> dict:
    key = jax.random.key(seed)
    ks = jax.random.split(key, 24)
    f32 = jnp.float32

    def nrm(k, shape, scale):
        return jax.random.normal(k, shape, f32) * scale

    G, P, Hs = SSM_GROUPS, SSM_STATE, SSM_GROUP
    x = nrm(ks[0], (BATCH, SEQ, D_MODEL), 1.0)
    w_in = nrm(ks[1], (DEPTH, D_MODEL, IN_WIDTH), D_MODEL ** -0.5)
    q_norm_gain = 1.0 + nrm(ks[2], (DEPTH, HEAD_DIM), 0.02)
    k_norm_gain = 1.0 + nrm(ks[3], (DEPTH, HEAD_DIM), 0.02)
    nat_rel_bias = nrm(ks[4], (DEPTH, NAT_HEADS, 2 * NAT_WIN_ROWS - 1, 2 * NAT_WIN_COLS - 1), 0.1)
    ssm_a_re = -0.5 + nrm(ks[5], (DEPTH, 2, G, P), 0.01)
    ssm_a_im = jnp.pi * jnp.arange(P, dtype=f32) + nrm(ks[6], (DEPTH, 2, G, P), 0.01)
    ssm_log_dt = jax.random.uniform(ks[7], (DEPTH, 2, G), f32,
                                    minval=float(np.log(1e-3)), maxval=float(np.log(1e-1)))
    ssm_b_re = nrm(ks[8], (DEPTH, G, P, Hs), (2 * Hs) ** -0.5)
    ssm_b_im = nrm(ks[9], (DEPTH, G, P, Hs), (2 * Hs) ** -0.5)
    ssm_c_re = nrm(ks[10], (DEPTH, 2, G, Hs, P), P ** -0.5)
    ssm_c_im = nrm(ks[11], (DEPTH, 2, G, Hs, P), P ** -0.5)
    ssm_d = nrm(ks[12], (DEPTH, G, Hs), 1.0)
    ssm_w_glu = nrm(ks[13], (DEPTH, MIX_WIDTH, MIX_WIDTH), MIX_WIDTH ** -0.5)
    w_branch = nrm(ks[14], (DEPTH, N_BRANCHES, MIX_WIDTH, D_MODEL), MIX_WIDTH ** -0.5)
    w_out = nrm(ks[15], (DEPTH, D_MODEL, D_MODEL), D_MODEL ** -0.5 * DEEPNORM_BETA)
    ln1_gain = 1.0 + nrm(ks[16], (DEPTH, D_MODEL), 0.02)
    ln1_bias = nrm(ks[17], (DEPTH, D_MODEL), 0.02)
    w_ffn_up = nrm(ks[18], (DEPTH, D_MODEL, FFN_DIM), D_MODEL ** -0.5)
    w_ffn_down = nrm(ks[19], (DEPTH, FFN_DIM, D_MODEL), FFN_DIM ** -0.5 * DEEPNORM_BETA)
    ln2_gain = 1.0 + nrm(ks[20], (DEPTH, D_MODEL), 0.02)
    ln2_bias = nrm(ks[21], (DEPTH, D_MODEL), 0.02)
    return {'x': x, 'w_in': w_in, 'q_norm_gain': q_norm_gain, 'k_norm_gain': k_norm_gain,
            'nat_rel_bias': nat_rel_bias, 'ssm_a_re': ssm_a_re, 'ssm_a_im': ssm_a_im,
            'ssm_log_dt': ssm_log_dt, 'ssm_b_re': ssm_b_re, 'ssm_b_im': ssm_b_im,
            'ssm_c_re': ssm_c_re, 'ssm_c_im': ssm_c_im, 'ssm_d': ssm_d, 'ssm_w_glu': ssm_w_glu,
            'w_branch': w_branch, 'w_out': w_out, 'ln1_gain': ln1_gain, 'ln1_bias': ln1_bias,
            'w_ffn_up': w_ffn_up, 'w_ffn_down': w_ffn_down, 'ln2_gain': ln2_gain, 'ln2_bias': ln2_bias}


def reference(x, w_in, q_norm_gain, k_norm_gain, nat_rel_bias, ssm_a_re, ssm_a_im, ssm_log_dt,
              ssm_b_re, ssm_b_im, ssm_c_re, ssm_c_im, ssm_d, ssm_w_glu, w_branch, w_out,
              ln1_gain, ln1_bias, w_ffn_up, w_ffn_down, ln2_gain, ln2_bias):
    rope = _axial_rope_tables(x.shape[1])
    for layer in range(DEPTH):
        mix = _hybrid_mixer(x, w_in[layer], q_norm_gain[layer], k_norm_gain[layer], nat_rel_bias[layer],
                            ssm_a_re[layer], ssm_a_im[layer], ssm_log_dt[layer], ssm_b_re[layer],
                            ssm_b_im[layer], ssm_c_re[layer], ssm_c_im[layer], ssm_d[layer],
                            ssm_w_glu[layer], w_branch[layer], w_out[layer], rope)
        x = _layer_norm(DEEPNORM_ALPHA * x + mix, ln1_gain[layer], ln1_bias[layer])
        ffn = _squared_relu_mlp(x, w_ffn_up[layer], w_ffn_down[layer])
        x = _layer_norm(DEEPNORM_ALPHA * x + ffn, ln2_gain[layer], ln2_bias[layer])
    return x
```

```cpp
#include <hip/hip_runtime.h>
#include <hip/hip_cooperative_groups.h>
#include <cstdio>
namespace cg = cooperative_groups;

#ifndef SINGLE_LAUNCH
#define SINGLE_LAUNCH 1
#endif

typedef unsigned short bf16_t;
typedef short bf16x8 __attribute__((ext_vector_type(8)));
typedef float f32x16 __attribute__((ext_vector_type(16)));
typedef float f32x4 __attribute__((ext_vector_type(4)));
typedef float f32x2 __attribute__((ext_vector_type(2)));
typedef unsigned u32x4 __attribute__((ext_vector_type(4)));
typedef unsigned u32x2 __attribute__((ext_vector_type(2)));
#define DEVI __device__ __forceinline__

constexpr int DM = 1024, SEQ = 8192, NB = 4, MTOK = NB * SEQ, FFN = 4096, INW = 5888;
constexpr int PW = 2816;
constexpr int CQ = 0, CK = 512, CNQ = 768, CNK = 1280, CSU = 2304;
constexpr float ALPHA = 1.4142135623730951f;
constexpr float LOG2E = 1.4426950408889634f;
constexpr int NTHREADS = 512, NWAVES = 8;
constexpr int LSTR = 72;
constexpr int LDS_BYTES = 2 * (256 + 256) * LSTR * 2;

constexpr size_t MiB = 1u << 20;
constexpr size_t OFF_P = 0, OFF_H = 0, OFF_ZB = 176 * MiB, OFF_MERGED = 176 * MiB, OFF_NVT = 208 * MiB, OFF_VT = 240 * MiB;
constexpr size_t OFF_ZS = 256 * MiB, OFF_SPREV = 288 * MiB;
constexpr size_t OFF_W = 304 * MiB, W_LAYER = 34 * MiB;
constexpr size_t W_IN = 0, W_GLU = 12 * MiB, W_BR = 13 * MiB, W_OUT = 16 * MiB, W_UP = 18 * MiB, W_DN = 26 * MiB;
constexpr size_t OFF_S5 = 372 * MiB, S5_LAYER = 35 * MiB;
constexpr size_t S5_BT = 0, S5_ZT = 24 * MiB, S5_KTAB = 32 * MiB, S5_LAMT = 34 * MiB;
constexpr size_t OFF_XB = 442 * MiB;
constexpr size_t OFF_CTL = 506 * MiB;
constexpr size_t OFF_STATS = 507 * MiB;
constexpr size_t WS_END = 509 * MiB;

struct Params {
    const float* in[22];
    float* out;
    unsigned char* ws;
    int ph_lo, ph_hi;
};

DEVI unsigned char* ows(const Params& p) { unsigned char* w = p.ws; asm volatile("" : "+s"(w)); return w; }
#define GAS __attribute__((address_space(1)))
DEVI u32x4 gld16(const void* p) { return *(const GAS u32x4*)(const GAS char*)p; }
DEVI bf16x8 gld16b(const void* p) { return *(const GAS bf16x8*)(const GAS char*)p; }
DEVI void gst8(void* base, unsigned off, u32x2 v) { *(GAS u32x2*)((GAS char*)base + off) = v; }
DEVI void gst2(void* base, unsigned off, bf16_t v) { *(GAS bf16_t*)((GAS char*)base + off) = v; }
DEVI int otid() { int t = threadIdx.x; asm volatile("" : "+v"(t)); return t; }
typedef __bf16 bf16x2_t __attribute__((ext_vector_type(2)));
DEVI unsigned pk_bf16_m(float lo, float hi) { const f32x2 v = {lo, hi}; const bf16x2_t b = __builtin_convertvector(v, bf16x2_t); return __builtin_bit_cast(unsigned, b); }
DEVI unsigned pk_bf16(float lo, float hi) { unsigned r; asm("v_cvt_pk_bf16_f32 %0, %1, %2" : "=v"(r) : "v"(lo), "v"(hi)); return r; }
DEVI bf16_t f2bf(float f) { return (bf16_t)(pk_bf16(f, 0.f) & 0xffffu); }
DEVI float bf2f(unsigned v) { return __uint_as_float(v << 16); }
DEVI float fexp2(float x) { return __builtin_amdgcn_exp2f(x); }
DEVI float sigmoidf_(float x) { return 1.0f / (1.0f + fexp2(-x * LOG2E)); }
DEVI float gelu_tanh(float y) {
    const float u = 0.7978845608028654f * (y + 0.044715f * y * y * y);
    return y * sigmoidf_(2.0f * u);
}
DEVI f32x16 mfma32(bf16x8 a, bf16x8 b, f32x16 c) { return __builtin_amdgcn_mfma_f32_32x32x16_bf16(a, b, c, 0, 0, 0); }
DEVI float xhalf(float v) { return __shfl_xor(v, 32); }

#define LAS __attribute__((address_space(3)))
#define SB() __builtin_amdgcn_sched_barrier(0)
template <int NT, int MT, class XF>
DEVI void gemm_kloop(f32x16 (&acc)[NT][MT], const bf16_t* wbase, int ldw, const bf16_t* xbase, const XF& xf, int K, bf16_t* lds) {
    const int tid = otid(), lane = tid & 63;
    const int wave = __builtin_amdgcn_readfirstlane(tid >> 6);
    const int wn = wave & 1, wm = wave >> 1, l32 = lane & 31, hi = lane >> 5;
    constexpr int WR = 64 * NT, XR = 128 * MT, WI = WR / 64, XI = XR / 64, STAGE = (WR + XR) * 64, NP = WI + XI;
    const int nk = K >> 6;
    const int lrow = wave * 8 + (lane >> 3);
    const int lc = ((lane & 7) ^ ((lrow >> 1) & 7)) * 8;
    const unsigned woff0 = ((unsigned)lrow * (unsigned)ldw + (unsigned)lc) * 2u;
    const unsigned wstep = 64u * (unsigned)ldw * 2u;
    unsigned xoff[XI];
#pragma unroll
    for (int j = 0; j < XI; ++j) xoff[j] = xf.off((unsigned)(lrow + 64 * j), (unsigned)lc) * 2u;
    const GAS char* wp = (const GAS char*)wbase;
    const GAS char* xp = (const GAS char*)xbase;
    const unsigned xstep = (unsigned)xf.kstep() * 2u;
    LAS bf16_t* L = (LAS bf16_t*)lds;
    const int sw = (l32 >> 1) & 7;
    int koff[4];
#pragma unroll
    for (int kk = 0; kk < 4; ++kk) koff[kk] = ((kk * 2 + hi) ^ sw) * 8;
#define GEMM_PIECE(bufi, pi) do { \
        LAS bf16_t* _d = L + (bufi) * STAGE + wave * 8 * 64; \
        if ((pi) < WI) __builtin_amdgcn_global_load_lds((const GAS unsigned*)(wp + woff0 + (pi) * wstep), (LAS unsigned*)(_d + (pi) * 64 * 64), 16, 0, 0); \
        else if ((pi) < NP) __builtin_amdgcn_global_load_lds((const GAS unsigned*)(xp + xoff[((pi) - WI) < XI ? ((pi) - WI) : 0]), (LAS unsigned*)(_d + (WR + ((pi) - WI) * 64) * 64), 16, 0, 0); \
    } while (0)
#define GEMM_RFR(set, kk) do { \
        _Pragma("unroll") for (int mt = 0; mt < MT; ++mt) fb[set][mt] = *(const LAS bf16x8*)(xsb + mt * 32 * 64 + koff[kk]); \
        _Pragma("unroll") for (int nt = 0; nt < NT; ++nt) fa[set][nt] = *(const LAS bf16x8*)(wsb + nt * 32 * 64 + koff[kk]); \
    } while (0)
#define GEMM_MMA(set, nlo, nhi) do { \
        __builtin_amdgcn_s_setprio(1); \
        _Pragma("unroll") for (int nt = (nlo); nt < (nhi); ++nt) \
        _Pragma("unroll") for (int mt = 0; mt < MT; ++mt) acc[nt][mt] = mfma32(fa[set][nt], fb[set][mt], acc[nt][mt]); \
        __builtin_amdgcn_s_setprio(0); \
    } while (0)
    asm volatile("s_waitcnt vmcnt(0)" ::: "memory");
    __builtin_amdgcn_s_barrier();
#pragma unroll
    for (int pi = 0; pi < NP; ++pi) GEMM_PIECE(0, pi);
#pragma unroll 1
    for (int kt = 0; kt < nk; ++kt) {
        const int buf = kt & 1;
        const bool more = (kt + 1 < nk);
        asm volatile("s_waitcnt vmcnt(0) lgkmcnt(0)" ::: "memory");
        __builtin_amdgcn_s_barrier();
        const LAS bf16_t* wsb = L + buf * STAGE + (wn * 32 * NT + l32) * 64;
        const LAS bf16_t* xsb = L + buf * STAGE + (WR + wm * 32 * MT + l32) * 64;
        bf16x8 fa[2][NT], fb[2][MT];
        GEMM_RFR(0, 0);
        SB();
        if (more) { wp += 128; xp += xstep; }
#pragma unroll
        for (int kk = 0; kk < 4; ++kk) {
            if (kk < 3) { GEMM_RFR((kk + 1) & 1, kk + 1); }
            SB();
            if (more && kk < 2) { GEMM_PIECE(buf ^ 1, 4 * kk); GEMM_PIECE(buf ^ 1, 4 * kk + 1); }
            SB();
            GEMM_MMA(kk & 1, 0, NT / 2);
            SB();
            if (more && kk < 2) { GEMM_PIECE(buf ^ 1, 4 * kk + 2); GEMM_PIECE(buf ^ 1, 4 * kk + 3); }
            SB();
            GEMM_MMA(kk & 1, NT / 2, NT);
            SB();
        }
    }
#undef GEMM_PIECE
#undef GEMM_RFR
#undef GEMM_MMA
}

template <int NT, int MT> DEVI void zero_acc(f32x16 (&acc)[NT][MT]) {
#pragma unroll
    for (int nt = 0; nt < NT; ++nt)
#pragma unroll
        for (int mt = 0; mt < MT; ++mt)
#pragma unroll
            for (int i = 0; i < 16; ++i) acc[nt][mt][i] = 0.f;
}
DEVI int vblock() { const int G = gridDim.x, b = blockIdx.x; return (G % 8 == 0) ? (b % 8) * (G / 8) + b / 8 : b; }

struct XRow {
    int ld;
    DEVI unsigned off(unsigned r, unsigned kc) const { return r * (unsigned)ld + kc; }
    DEVI int kstep() const { return 64; }
};
struct XS5 {
    DEVI unsigned off(unsigned r, unsigned kc) const { return (r * 32u + (kc >> 4)) * (unsigned)PW + (kc & 15u); }
    DEVI int kstep() const { return 4 * PW; }
};


template <int NT> DEVI void wave_rows_out(const bf16_t* wl, bf16_t* gbase, long ld, int lane) {
    constexpr int RS = NT * 32 + 8, CPR = NT * 4, RPI = 64 / CPR;
    asm volatile("s_waitcnt lgkmcnt(0)" ::: "memory");
    const bf16_t* lp = wl + (lane / CPR) * RS + (lane % CPR) * 8;
    const unsigned loff = ((unsigned)(lane / CPR) * (unsigned)ld + (unsigned)(lane % CPR) * 8u) * 2u;
    GAS char* gp = (GAS char*)gbase;
    const unsigned gstep = (unsigned)RPI * (unsigned)ld * 2u;
#pragma unroll 4
    for (int j = 0; j < NT * 4; ++j) {
        const u32x4 v = *(const u32x4*)(lp);
        *(GAS u32x4*)(gp + loff) = v;
        gp += gstep; lp += RPI * RS;
    }
}

DEVI void phase_inproj(const Params& p, int layer, bf16_t* lds) {
    unsigned char* ws = ows(p);
    const bf16_t* xb = (const bf16_t*)(ws + OFF_XB);
    const bf16_t* wt = (const bf16_t*)(ws + OFF_W + layer * W_LAYER + W_IN);
    bf16_t* P = (bf16_t*)(ws + OFF_P);
    bf16_t* VT = (bf16_t*)(ws + OFF_VT);
    bf16_t* NVT = (bf16_t*)(ws + OFF_NVT);
    const float* qg = p.in[2] + layer * 64;
    const float* kg = p.in[3] + layer * 64;
    const int tid0 = otid();
    const int wave = __builtin_amdgcn_readfirstlane(tid0 >> 6), wn = wave & 1, wm = wave >> 1;
    constexpr int NT_N = PW / 256, NT_M = MTOK / 256;
    for (int t = vblock(); t < NT_N * NT_M; t += gridDim.x) {
        const int tm = t / NT_N, tn = t % NT_N;
        const int n0 = tn * 256, m0 = tm * 256;
        f32x16 acc[4][2];
        zero_acc<4, 2>(acc);
        gemm_kloop<4, 2>(acc, wt + (long)n0 * DM, DM, xb + (long)m0 * DM, XRow{DM}, DM, lds);
        __syncthreads();
        bf16_t* wl = lds + wave * (64 * 136);
        int lane = tid0 & 63; asm volatile("" : "+v"(lane));
        const int l32 = lane & 31, hi = lane >> 5;
        const int nbw = n0 + wn * 128;
        const int mw = m0 + wm * 64;
        bf16_t* pbase = P + (long)mw * PW + nbw;
        if (nbw < 640) {
            const float* gain = (nbw < 512) ? qg : kg;
#pragma unroll
            for (int hp = 0; hp < 2; ++hp)
#pragma unroll
            for (int mt = 0; mt < 2; ++mt) {
                const int tpos = (mw + mt * 32 + l32) & (SEQ - 1);
                float ss = 0.f;
#pragma unroll
                for (int nt = 0; nt < 2; ++nt)
#pragma unroll
                    for (int i = 0; i < 16; ++i) ss += acc[2 * hp + nt][mt][i] * acc[2 * hp + nt][mt][i];
                ss += xhalf(ss);
                const float rs = rsqrtf(ss * (1.0f / 64.0f) + 1e-6f) * ((nbw < 512) ? 0.125f * LOG2E : 1.0f);
#pragma unroll
                for (int nt = 0; nt < 2; ++nt) {
                    const float pos = (float)(nt == 0 ? (tpos >> 6) : (tpos & 63));
                    float v[16];
#pragma unroll
                    for (int q = 0; q < 4; ++q) {
                        const f32x4 g4 = *(const GAS f32x4*)(const GAS float*)(gain + nt * 32 + 8 * q + 4 * hi);
                        v[4 * q] = acc[2 * hp + nt][mt][4 * q] * rs * g4.x; v[4 * q + 1] = acc[2 * hp + nt][mt][4 * q + 1] * rs * g4.y;
                        v[4 * q + 2] = acc[2 * hp + nt][mt][4 * q + 2] * rs * g4.z; v[4 * q + 3] = acc[2 * hp + nt][mt][4 * q + 3] * rs * g4.w;
                    }
#pragma unroll
                    for (int i = 0; i < 8; ++i) {
                        const int j = 8 * (i >> 2) + 4 * hi + (i & 3);
                        const float inv = fexp2(-(float)j * 0.8304820237218406f);
                        const float ang = pos * inv;
                        const float c = __cosf(ang), sn = __sinf(ang);
                        const float x1 = v[i], x2 = v[i + 8];
                        v[i] = x1 * c - x2 * sn;
                        v[i + 8] = x2 * c + x1 * sn;
                    }
#pragma unroll
                    for (int q = 0; q < 4; ++q) {
                        u32x2 w; w.x = pk_bf16(v[4 * q], v[4 * q + 1]); w.y = pk_bf16(v[4 * q + 2], v[4 * q + 3]);
                        *(u32x2*)(wl + (mt * 32 + l32) * 136 + hp * 64 + nt * 32 + 8 * q + 4 * hi) = w;
                    }
                    __builtin_amdgcn_sched_barrier(0);
                }
            }
            wave_rows_out<4>(wl, pbase, PW, lane);
        } else if (nbw == 640 || (nbw >= 1792 && nbw < 2304)) {
            const int b = mw >> 13, tpos0 = mw & (SEQ - 1);
            bf16_t* base = (nbw == 640) ? VT + ((long)(b * 2) * 64) * SEQ + tpos0 : NVT + ((long)(b * 8 + ((nbw - 1792) >> 6)) * 64) * SEQ + tpos0;
            const unsigned voff = (unsigned)(4 * hi * SEQ + l32) * 2u;
#pragma unroll
            for (int mt = 0; mt < 2; ++mt)
#pragma unroll
                for (int nt = 0; nt < 4; ++nt)
#pragma unroll
                    for (int i = 0; i < 16; ++i)
                        gst2(base, voff + (unsigned)(((nt * 32 + 8 * (i >> 2) + (i & 3)) * SEQ + mt * 32) * 2), f2bf(acc[nt][mt][i]));
        } else {
#pragma unroll
            for (int mt = 0; mt < 2; ++mt)
#pragma unroll
                for (int nt = 0; nt < 4; ++nt)
#pragma unroll
                    for (int q = 0; q < 4; ++q) {
                        u32x2 w; w.x = pk_bf16(acc[nt][mt][4 * q], acc[nt][mt][4 * q + 1]); w.y = pk_bf16(acc[nt][mt][4 * q + 2], acc[nt][mt][4 * q + 3]);
                        *(u32x2*)(wl + (mt * 32 + l32) * 136 + nt * 32 + 8 * q + 4 * hi) = w;
                    }
            wave_rows_out<4>(wl, pbase, PW, lane);
        }
    }
}

DEVI void online_softmax(f32x16 (&s)[2], f32x16 (&o)[2], float& mrun, float& lrun, bf16x8 (&pb)[2][2]) {
    float mx = s[0][0];
#pragma unroll
    for (int kt = 0; kt < 2; ++kt)
#pragma unroll
        for (int i = 0; i < 16; ++i) mx = fmaxf(mx, s[kt][i]);
    mx = fmaxf(mx, xhalf(mx));
    const float mnew = fmaxf(mrun, mx);
    const float alpha = fexp2(mrun - mnew);
    mrun = mnew;
    float ps = 0.f;
#pragma unroll
    for (int kt = 0; kt < 2; ++kt)
#pragma unroll
        for (int i = 0; i < 16; ++i) { const float e = fexp2(s[kt][i] - mnew); s[kt][i] = e; ps += e; }
    lrun = lrun * alpha + ps;
#pragma unroll
    for (int dt = 0; dt < 2; ++dt)
#pragma unroll
        for (int i = 0; i < 16; ++i) o[dt][i] *= alpha;
#pragma unroll
    for (int kt = 0; kt < 2; ++kt)
#pragma unroll
        for (int sl = 0; sl < 2; ++sl) {
            u32x4 w;
            w.x = pk_bf16_m(s[kt][8 * sl + 0], s[kt][8 * sl + 1]); w.y = pk_bf16_m(s[kt][8 * sl + 2], s[kt][8 * sl + 3]);
            w.z = pk_bf16_m(s[kt][8 * sl + 4], s[kt][8 * sl + 5]); w.w = pk_bf16_m(s[kt][8 * sl + 6], s[kt][8 * sl + 7]);
            pb[kt][sl] = __builtin_bit_cast(bf16x8, w);
        }
}
DEVI int kperm(int r) { return (r & 16) + 8 * ((r >> 2) & 1) + 4 * ((r >> 3) & 1) + (r & 3); }

DEVI void gqa_unit(const Params& p, int layer, int unit, bf16_t* lds) {
    unsigned char* ws = ows(p);
    bf16_t* P = (bf16_t*)(ws + OFF_P);
    const bf16_t* VT = (const bf16_t*)(ws + OFF_VT);
    const int tid = otid(), lane = tid & 63, wave = tid >> 6, l32 = lane & 31, hi = lane >> 5;
    const int qb = unit & 31, h = (unit >> 5) & 7, b = unit >> 8, kvh = h >> 2;
    const int qrow = qb * 256 + wave * 32 + l32;
    bf16_t* Ks = lds;
    bf16_t* Vs = lds + 2 * 64 * LSTR;
    bf16x8 qf[4];
    {
        const bf16_t* qp = P + ((long)(b * SEQ + qrow)) * PW + CQ + h * 64 + hi * 8;
#pragma unroll
        for (int kk = 0; kk < 4; ++kk) qf[kk] = *(const bf16x8*)(qp + kk * 16);
    }
    float mb;
    {
        float gq = fabsf(p.in[2][layer * 64 + lane]), gk = fabsf(p.in[3][layer * 64 + lane]);
#pragma unroll
        for (int o2 = 1; o2 < 64; o2 <<= 1) { gq = fmaxf(gq, __shfl_xor(gq, o2)); gk = fmaxf(gk, __shfl_xor(gk, o2)); }
        mb = 8.0f * gq * gk * LOG2E * 1.01f;
    }
    const bf16_t* kbase = P + ((long)b * SEQ) * PW + CK + kvh * 64;
    const bf16_t* vbase = VT + ((long)(b * 2 + kvh) * 64) * SEQ;
    f32x16 o[2];
#pragma unroll
    for (int dt = 0; dt < 2; ++dt)
#pragma unroll
        for (int i = 0; i < 16; ++i) o[dt][i] = 0.f;
    float lrun = 0.f;
    u32x4 kreg[1], vreg[1];
#pragma unroll
    for (int i = 0; i < 1; ++i) {
        const int c = tid, r = c >> 3, cc = (c & 7) * 8;
        kreg[i] = gld16(kbase + (long)r * PW + cc);
        vreg[i] = gld16(vbase + (long)r * SEQ + cc);
    }
#pragma unroll
    for (int i = 0; i < 1; ++i) {
        const int c = tid, r = c >> 3, cc = (c & 7) * 8;
        *(u32x4*)(Ks + r * LSTR + cc) = kreg[i];
        *(u32x4*)(Vs + r * LSTR + cc) = vreg[i];
    }
    __syncthreads();
    const int kr = kperm(l32);
    for (int kt0 = 0; kt0 < SEQ / 64; ++kt0) {
        const int buf = kt0 & 1;
        const bool more = (kt0 + 1 < SEQ / 64);
        if (more) {
            const int key0 = (kt0 + 1) * 64;
#pragma unroll
            for (int i = 0; i < 1; ++i) {
                const int c = tid, r = c >> 3, cc = (c & 7) * 8;
                kreg[i] = gld16(kbase + (long)(key0 + r) * PW + cc);
                vreg[i] = gld16(vbase + (long)r * SEQ + key0 + cc);
            }
        }
        f32x16 s[2];
        bf16x8 kf[2][4], vf[2][2][2];
#pragma unroll
        for (int kt = 0; kt < 2; ++kt) {
            const bf16_t* kp = Ks + (buf * 64 + kt * 32 + kr) * LSTR + hi * 8;
#pragma unroll
            for (int kk = 0; kk < 4; ++kk) kf[kt][kk] = *(const bf16x8*)(kp + kk * 16);
        }
#pragma unroll
        for (int dt = 0; dt < 2; ++dt) {
            const bf16_t* vp = Vs + (buf * 64 + dt * 32 + l32) * LSTR + hi * 8;
#pragma unroll
            for (int kt = 0; kt < 2; ++kt)
#pragma unroll
                for (int sl = 0; sl < 2; ++sl) vf[dt][kt][sl] = *(const bf16x8*)(vp + kt * 32 + sl * 16);
        }
        __builtin_amdgcn_sched_barrier(0);
        __builtin_amdgcn_s_setprio(1);
#pragma unroll
        for (int kt = 0; kt < 2; ++kt) {
#pragma unroll
            for (int i = 0; i < 16; ++i) s[kt][i] = -mb;
#pragma unroll
            for (int kk = 0; kk < 4; ++kk) s[kt] = mfma32(kf[kt][kk], qf[kk], s[kt]);
        }
        __builtin_amdgcn_s_setprio(0);
        bf16x8 pb[2][2];
#pragma unroll
        for (int kt = 0; kt < 2; ++kt) {
#pragma unroll
            for (int i = 0; i < 16; ++i) { const float e = fexp2(s[kt][i]); s[kt][i] = e; lrun += e; }
#pragma unroll
            for (int sl = 0; sl < 2; ++sl) {
                u32x4 w;
                w.x = pk_bf16_m(s[kt][8 * sl + 0], s[kt][8 * sl + 1]); w.y = pk_bf16_m(s[kt][8 * sl + 2], s[kt][8 * sl + 3]);
                w.z = pk_bf16_m(s[kt][8 * sl + 4], s[kt][8 * sl + 5]); w.w = pk_bf16_m(s[kt][8 * sl + 6], s[kt][8 * sl + 7]);
                pb[kt][sl] = __builtin_bit_cast(bf16x8, w);
            }
        }
#pragma unroll
        for (int dt = 0; dt < 2; ++dt)
#pragma unroll
            for (int kt = 0; kt < 2; ++kt)
#pragma unroll
                for (int sl = 0; sl < 2; ++sl) o[dt] = mfma32(vf[dt][kt][sl], pb[kt][sl], o[dt]);
        if (more) {
            const int nb = buf ^ 1;
#pragma unroll
            for (int i = 0; i < 1; ++i) {
                const int c = tid, r = c >> 3, cc = (c & 7) * 8;
                *(u32x4*)(Ks + (nb * 64 + r) * LSTR + cc) = kreg[i];
                *(u32x4*)(Vs + (nb * 64 + r) * LSTR + cc) = vreg[i];
            }
        }
        __syncthreads();
    }
    lrun += xhalf(lrun);
    const float inv = 1.0f / lrun;
    bf16_t* op = P + ((long)(b * SEQ + qrow)) * PW + CQ + h * 64;
#pragma unroll
    for (int dt = 0; dt < 2; ++dt)
#pragma unroll
        for (int q = 0; q < 4; ++q) {
            u32x2 w; w.x = pk_bf16(o[dt][4 * q] * inv, o[dt][4 * q + 1] * inv); w.y = pk_bf16(o[dt][4 * q + 2] * inv, o[dt][4 * q + 3] * inv);
            *(u32x2*)(op + dt * 32 + 8 * q + 4 * hi) = w;
        }
}

DEVI void nat_block_unit(const Params& p, int layer, int unit, bf16_t* lds) {
    unsigned char* ws = ows(p);
    bf16_t* P = (bf16_t*)(ws + OFF_P);
    const bf16_t* NVT = (const bf16_t*)(ws + OFF_NVT);
    const float* bias = p.in[4] + (long)layer * 8 * 15 * 31;
    const int tid = otid(), lane = tid & 63, wave = __builtin_amdgcn_readfirstlane(tid >> 6), l32 = lane & 31, hi = lane >> 5;
    const int wu = unit * NWAVES + wave;
    const int qt = wu & 1, h = (wu >> 1) & 7, r = (wu >> 4) & 127, b = wu >> 11;
    const int h0 = (unit * 4) & 7;
    float* bl = (float*)lds;
    for (int e = tid; e < 4 * 465; e += NTHREADS) bl[e] = bias[h0 * 465 + e];
    __syncthreads();
    const float* bh = bl + (h - h0) * 465;
    int rs = r - 4; rs = rs < 0 ? 0 : (rs > 120 ? 120 : rs);
    const int qc = qt * 32 + l32;
    int cs = qc - 8; cs = cs < 0 ? 0 : (cs > 48 ? 48 : cs);
    const long tok0 = (long)b * SEQ;
    bf16x8 qf[4];
    {
        const bf16_t* qp = P + (tok0 + r * 64 + qc) * PW + CNQ + h * 64 + hi * 8;
#pragma unroll
        for (int kk = 0; kk < 4; ++kk) qf[kk] = gld16b(qp + kk * 16);
    }
    f32x16 o[2];
#pragma unroll
    for (int dt = 0; dt < 2; ++dt)
#pragma unroll
        for (int i = 0; i < 16; ++i) o[dt][i] = 0.f;
    float mrun = -INFINITY, lrun = 0.f;
    const int kr = kperm(l32);
    constexpr float C = 0.125f * LOG2E;
    const bf16_t* kbase = P + (tok0 + kr) * PW + CNK + h * 64 + hi * 8;
    const bf16_t* vbase = NVT + ((long)(b * 8 + h) * 64 + l32) * SEQ + hi * 8;
    bf16_t* wl = (bf16_t*)((unsigned char*)lds + 8192) + wave * (64 * LSTR);
    const int srow = lane >> 3, scol = (lane & 7) * 8;
    const bf16_t* kg = P + (tok0 + srow) * PW + CNK + h * 64 + scol;
    const bf16_t* vg = NVT + ((long)(b * 8 + h) * 64 + srow) * SEQ + scol;
    u32x4 kst[8], vst[8];
#define NAT_LOADK(krow) do { _Pragma("unroll") for (int i = 0; i < 8; ++i) kst[i] = gld16(kg + (long)((krow) * 64 + 8 * i) * PW); } while (0)
#define NAT_LOADV(krow) do { _Pragma("unroll") for (int i = 0; i < 8; ++i) vst[i] = gld16(vg + (long)(8 * i) * SEQ + (krow) * 64); } while (0)
    NAT_LOADK(rs);
    NAT_LOADV(rs);
#pragma unroll 1
    for (int ir = 0; ir < 8; ++ir) {
        const int krow = rs + ir;
        const int nrow = (ir < 7) ? krow + 1 : krow;
        const float* brow = bh + (krow - r + 7) * 31 + 15 - qc;
        bf16x8 kf[2][4], vf[2][2][2];
#pragma unroll
        for (int i = 0; i < 8; ++i) *(u32x4*)(wl + (srow + 8 * i) * LSTR + scol) = kst[i];
        __builtin_amdgcn_sched_barrier(0);
#pragma unroll
        for (int kt = 0; kt < 2; ++kt)
#pragma unroll
            for (int kk = 0; kk < 4; ++kk) kf[kt][kk] = *(const bf16x8*)(wl + (kt * 32 + kr) * LSTR + hi * 8 + kk * 16);
        __builtin_amdgcn_sched_barrier(0);
        NAT_LOADK(nrow);
        f32x16 s[2];
#pragma unroll
        for (int kt = 0; kt < 2; ++kt) {
#pragma unroll
            for (int i = 0; i < 16; ++i) s[kt][i] = 0.f;
#pragma unroll
            for (int kk = 0; kk < 4; ++kk) s[kt] = mfma32(kf[kt][kk], qf[kk], s[kt]);
        }
        __builtin_amdgcn_sched_barrier(0);
#pragma unroll
        for (int i = 0; i < 8; ++i) *(u32x4*)(wl + (srow + 8 * i) * LSTR + scol) = vst[i];
        __builtin_amdgcn_sched_barrier(0);
#pragma unroll
        for (int dt = 0; dt < 2; ++dt)
#pragma unroll
            for (int kt = 0; kt < 2; ++kt)
#pragma unroll
                for (int sl = 0; sl < 2; ++sl) vf[dt][kt][sl] = *(const bf16x8*)(wl + (dt * 32 + l32) * LSTR + hi * 8 + kt * 32 + sl * 16);
        __builtin_amdgcn_sched_barrier(0);
        NAT_LOADV(nrow);
#pragma unroll
        for (int kt = 0; kt < 2; ++kt) {
#pragma unroll
            for (int i = 0; i < 16; ++i) {
                const int kc = kt * 32 + 16 * (i >> 3) + 8 * hi + (i & 7);
                const bool valid = (kc >= cs) && (kc < cs + 16);
                const float bv = brow[valid ? kc : qc];
                s[kt][i] = valid ? (s[kt][i] * C + bv * LOG2E) : -INFINITY;
            }
        }
        bf16x8 pb[2][2];
        online_softmax(s, o, mrun, lrun, pb);
#pragma unroll
        for (int dt = 0; dt < 2; ++dt)
#pragma unroll
            for (int kt = 0; kt < 2; ++kt)
#pragma unroll
                for (int sl = 0; sl < 2; ++sl) o[dt] = mfma32(vf[dt][kt][sl], pb[kt][sl], o[dt]);
        __builtin_amdgcn_sched_barrier(0);
    }
#undef NAT_LOADK
#undef NAT_LOADV
    lrun += xhalf(lrun);
    const float inv = 1.0f / lrun;
    bf16_t* op = P + (tok0 + r * 64 + qc) * PW + CNQ + h * 64;
#pragma unroll
    for (int dt = 0; dt < 2; ++dt)
#pragma unroll
        for (int q = 0; q < 4; ++q) {
            u32x2 w; w.x = pk_bf16(o[dt][4 * q] * inv, o[dt][4 * q + 1] * inv); w.y = pk_bf16(o[dt][4 * q + 2] * inv, o[dt][4 * q + 3] * inv);
            *(u32x2*)(op + dt * 32 + 8 * q + 4 * hi) = w;
        }
}

DEVI void s5z_tile(const Params& p, int layer, int t, bf16_t* lds) {
    unsigned char* ws = ows(p);
    const bf16_t* P = (const bf16_t*)(ws + OFF_P);
    const bf16_t* Zt = (const bf16_t*)(ws + OFF_S5 + layer * S5_LAYER + S5_ZT);
    float* ZS = (float*)(ws + OFF_ZS);
    const int lane = otid() & 63, wave = __builtin_amdgcn_readfirstlane(otid() >> 6), wn = wave & 1, wm = wave >> 1, l32 = lane & 31, hi = lane >> 5;
    const int g = t >> 2, tm = t & 3;
    const int m0 = tm * 256;
    f32x16 acc[4][2];
    zero_acc<4, 2>(acc);
    gemm_kloop<4, 2>(acc, Zt + ((long)g * 256) * 512, 512, P + ((long)m0 * 32) * PW + CSU + g * 16, XS5{}, 512, lds);
#pragma unroll
    for (int mt = 0; mt < 2; ++mt) {
        const int R = m0 + wm * 64 + mt * 32 + l32, b = R >> 8, c = R & 255;
        float* zp = ZS + ((long)((b * 32 + g) * 256 + c)) * 256 + wn * 128;
#pragma unroll
        for (int nt = 0; nt < 4; ++nt)
#pragma unroll
            for (int q = 0; q < 4; ++q) {
                f32x4 v = {acc[nt][mt][4 * q], acc[nt][mt][4 * q + 1], acc[nt][mt][4 * q + 2], acc[nt][mt][4 * q + 3]};
                *(f32x4*)(zp + nt * 32 + 8 * q + 4 * hi) = v;
            }
    }
}


DEVI void scan_wave_unit(const Params& p, int layer, int b, int g, int dir) {
    unsigned char* ws = ows(p);
    const float* ZS = (const float*)(ws + OFF_ZS);
    bf16_t* SP = (bf16_t*)(ws + OFF_SPREV);
    const f32x2* LT = (const f32x2*)(ws + OFF_S5 + layer * S5_LAYER + S5_LAMT);
    const int lane = otid() & 63;
    const f32x2 lt = LT[(dir * 32 + g) * 64 + lane];
    const long base = ((long)(b * 32 + g) * 256) * 256 + dir * 128 + lane;
    float sr = 0.f, si = 0.f;
    for (int cb = 0; cb < 16; ++cb) {
        float zr[16], zi[16];
#pragma unroll
        for (int i = 0; i < 16; ++i) {
            const int cc = cb * 16 + i, c = dir ? 255 - cc : cc;
            zr[i] = ZS[base + (long)c * 256]; zi[i] = ZS[base + (long)c * 256 + 64];
        }
#pragma unroll
        for (int i = 0; i < 16; ++i) {
            const int cc = cb * 16 + i, c = dir ? 255 - cc : cc;
            SP[base + (long)c * 256] = f2bf(sr); SP[base + (long)c * 256 + 64] = f2bf(si);
            const float nr = lt.x * sr - lt.y * si + zr[i], ni = lt.x * si + lt.y * sr + zi[i];
            sr = nr; si = ni;
        }
    }
}

DEVI void s5c_tile(const Params& p, int layer, int t, bf16_t* lds) {
    unsigned char* ws = ows(p);
    const bf16_t* P = (const bf16_t*)(ws + OFF_P);
    const bf16_t* SP = (const bf16_t*)(ws + OFF_SPREV);
    const bf16_t* Bt = (const bf16_t*)(ws + OFF_S5 + layer * S5_LAYER + S5_BT);
    bf16_t* ZB = (bf16_t*)(ws + OFF_ZB);
    const int lane = otid() & 63, wave = __builtin_amdgcn_readfirstlane(otid() >> 6), wn = wave & 1, wm = wave >> 1, l32 = lane & 31, hi = lane >> 5;
    {
        const int g = t >> 3, tm = (t >> 1) & 3, tn = t & 1;
        const int n0 = tn * 256, m0 = tm * 256;
        f32x16 acc[4][2];
        zero_acc<4, 2>(acc);
        gemm_kloop<4, 2>(acc, Bt + ((long)g * 512 + n0) * 768, 768, P + ((long)m0 * 32) * PW + CSU + g * 16, XS5{}, 512, lds);
        gemm_kloop<4, 2>(acc, Bt + ((long)g * 512 + n0) * 768 + 512, 768, SP + ((long)(((m0 >> 8) * 32 + g) * 256)) * 256, XRow{256}, 256, lds);
#pragma unroll
        for (int mt = 0; mt < 2; ++mt) {
            const int R = m0 + wm * 64 + mt * 32 + l32;
#pragma unroll
            for (int nt = 0; nt < 4; ++nt)
#pragma unroll
                for (int q = 0; q < 4; ++q) {
                    const int n = n0 + wn * 128 + nt * 32 + 8 * q + 4 * hi;
                    u32x2 w;
                    w.x = pk_bf16(gelu_tanh(acc[nt][mt][4 * q]), gelu_tanh(acc[nt][mt][4 * q + 1]));
                    w.y = pk_bf16(gelu_tanh(acc[nt][mt][4 * q + 2]), gelu_tanh(acc[nt][mt][4 * q + 3]));
                    *(u32x2*)(ZB + ((long)R * 32 + (n >> 4)) * 512 + g * 16 + (n & 15)) = w;
                }
        }
    }
}

DEVI void glu_tile(const Params& p, int layer, int t, bf16_t* lds) {
    unsigned char* ws = ows(p);
    bf16_t* P = (bf16_t*)(ws + OFF_P);
    const bf16_t* ZB = (const bf16_t*)(ws + OFF_ZB);
    const bf16_t* wt = (const bf16_t*)(ws + OFF_W + layer * W_LAYER + W_GLU);
    const int lane = otid() & 63, wave = __builtin_amdgcn_readfirstlane(otid() >> 6), wn = wave & 1, wm = wave >> 1, l32 = lane & 31, hi = lane >> 5;
    {
        const int tm = t >> 1, tn = t & 1;
        const int n0 = tn * 256, m0 = tm * 256;
        f32x16 acc[4][2];
        zero_acc<4, 2>(acc);
        gemm_kloop<4, 2>(acc, wt + (long)n0 * 512, 512, ZB + (long)m0 * 512, XRow{512}, 512, lds);
#pragma unroll
        for (int mt = 0; mt < 2; ++mt) {
            const int m = m0 + wm * 64 + mt * 32 + l32;
#pragma unroll
            for (int nt = 0; nt < 4; ++nt)
#pragma unroll
                for (int q = 0; q < 4; ++q) {
                    const int n = n0 + wn * 128 + nt * 32 + 8 * q + 4 * hi;
                    const u32x2 zz = *(const u32x2*)(ZB + (long)m * 512 + n);
                    const float z0 = bf2f(zz.x & 0xffffu), z1 = bf2f(zz.x >> 16), z2 = bf2f(zz.y & 0xffffu), z3 = bf2f(zz.y >> 16);
                    u32x2 w;
                    w.x = pk_bf16(z0 * sigmoidf_(acc[nt][mt][4 * q]), z1 * sigmoidf_(acc[nt][mt][4 * q + 1]));
                    w.y = pk_bf16(z2 * sigmoidf_(acc[nt][mt][4 * q + 2]), z3 * sigmoidf_(acc[nt][mt][4 * q + 3]));
                    *(u32x2*)(P + (long)m * PW + CSU + n) = w;
                }
        }
    }
}

DEVI int queue_grab(unsigned* ctr, volatile unsigned* slot, int tid) {
    asm volatile("s_waitcnt vmcnt(0)" ::: "memory");
    __syncthreads();
    if (tid == 0) *slot = __hip_atomic_fetch_add(ctr, 1u, __ATOMIC_RELAXED, __HIP_MEMORY_SCOPE_AGENT);
    __syncthreads();
    return (int)*slot;
}
DEVI void phase_mixers(const Params& p, int layer, bf16_t* lds) {
    unsigned char* ws = ows(p);
    unsigned* ctl = (unsigned*)(ws + OFF_CTL);
    unsigned* q = ctl + 64 + layer * 320;
    unsigned* done = ctl + 704 + layer * 64;
    volatile unsigned* slot = (volatile unsigned*)((unsigned char*)lds + LDS_BYTES - 16);
    const int tid = otid();
    const int wave = __builtin_amdgcn_readfirstlane(tid >> 6);
    const int xcd = (int)(__builtin_amdgcn_s_getreg((3 << 11) | 20) & 7u);
    int u;
    while ((u = queue_grab(q, slot, tid)) < 128) {
        const int g = u >> 2, b = u & 3;
        s5z_tile(p, layer, u, lds);
        asm volatile("s_waitcnt vmcnt(0)" ::: "memory");
        __syncthreads();
        __builtin_amdgcn_fence(__ATOMIC_ACQUIRE, "agent");
        if (wave < 2) scan_wave_unit(p, layer, b, g, wave);
        asm volatile("s_waitcnt vmcnt(0)" ::: "memory");
        __syncthreads();
        __builtin_amdgcn_fence(__ATOMIC_ACQUIRE, "agent");
        s5c_tile(p, layer, (g << 3) + (b << 1), lds);
        s5c_tile(p, layer, (g << 3) + (b << 1) + 1, lds);
        asm volatile("s_waitcnt vmcnt(0)" ::: "memory");
        __syncthreads();
        if (tid == 0) {
            __builtin_amdgcn_fence(__ATOMIC_RELEASE, "agent");
            asm volatile("s_waitcnt vmcnt(0)" ::: "memory");
            __hip_atomic_fetch_add(done + b * 16, 1u, __ATOMIC_RELAXED, __HIP_MEMORY_SCOPE_AGENT);
        }
    }
#pragma unroll 1
    for (int j8 = 0; j8 < 8; ++j8) {
        const int xs = (xcd + j8) & 7;
        while ((u = queue_grab(q + 16 * (1 + xs), slot, tid)) < 128)
            gqa_unit(p, layer, ((xs >> 1) << 8) | ((((xs & 1) << 2) | (u & 3)) << 5) | (u >> 2), lds);
    }
    while ((u = queue_grab(q + 16 * 9, slot, tid)) < 256) {
        const int b = u >> 6;
        if (tid == 0) {
            while (__hip_atomic_load(done + b * 16, __ATOMIC_RELAXED, __HIP_MEMORY_SCOPE_AGENT) < 32u) __builtin_amdgcn_s_sleep(8);
            __builtin_amdgcn_fence(__ATOMIC_ACQUIRE, "agent");
            asm volatile("s_waitcnt vmcnt(0)" ::: "memory");
        }
        __syncthreads();
        glu_tile(p, layer, u, lds);
    }
#pragma unroll 1
    for (int j8 = 0; j8 < 8; ++j8) {
        const int xs = (xcd + j8) & 7;
        while ((u = queue_grab(q + 16 * (10 + xs), slot, tid)) < 128)
            nat_block_unit(p, layer, ((xs >> 1) << 8) | (u << 1) | (xs & 1), lds);
    }
}

DEVI void phase_merge(const Params& p, int layer, bf16_t* lds) {
    unsigned char* ws = ows(p);
    const bf16_t* P = (const bf16_t*)(ws + OFF_P);
    const bf16_t* xb = (const bf16_t*)(ws + OFF_XB);
    const bf16_t* wg = (const bf16_t*)(ws + OFF_W + layer * W_LAYER + W_IN) + (long)PW * DM;
    const bf16_t* wbr = (const bf16_t*)(ws + OFF_W + layer * W_LAYER + W_BR);
    bf16_t* MG = (bf16_t*)(ws + OFF_MERGED);
    const int lane = otid() & 63, wave = __builtin_amdgcn_readfirstlane(otid() >> 6), wn = wave & 1, wm = wave >> 1, l32 = lane & 31, hi = lane >> 5;
    for (int t = vblock(); t < 8 * 128; t += gridDim.x) {
        const int tm = t >> 3, tn = t & 7;
        const int n0 = tn * 128, m0 = tm * 256;
        f32x16 mg[2][2];
        zero_acc<2, 2>(mg);
#pragma unroll 1
        for (int br = 0; br < 3; ++br) {
            const int bcol = (br == 0) ? CQ : (br == 1 ? CNQ : CSU);
            f32x16 acc[2][2];
            unsigned sg[2][2][8];
            zero_acc<2, 2>(acc);
            gemm_kloop<2, 2>(acc, wg + ((long)br * DM + n0) * DM, DM, xb + (long)m0 * DM, XRow{DM}, DM, lds);
#pragma unroll
            for (int nt = 0; nt < 2; ++nt)
#pragma unroll
                for (int mt = 0; mt < 2; ++mt)
#pragma unroll
                    for (int i = 0; i < 8; ++i) sg[nt][mt][i] = pk_bf16(sigmoidf_(acc[nt][mt][2 * i]), sigmoidf_(acc[nt][mt][2 * i + 1]));
            zero_acc<2, 2>(acc);
            gemm_kloop<2, 2>(acc, wbr + ((long)br * DM + n0) * 512, 512, P + (long)m0 * PW + bcol, XRow{PW}, 512, lds);
#pragma unroll
            for (int nt = 0; nt < 2; ++nt)
#pragma unroll
                for (int mt = 0; mt < 2; ++mt)
#pragma unroll
                    for (int i = 0; i < 8; ++i) {
                        mg[nt][mt][2 * i] += bf2f(sg[nt][mt][i] & 0xffffu) * acc[nt][mt][2 * i];
                        mg[nt][mt][2 * i + 1] += bf2f(sg[nt][mt][i] >> 16) * acc[nt][mt][2 * i + 1];
                    }
        }
        __syncthreads();
        bf16_t* wl = lds + wave * (64 * 72);
#pragma unroll
        for (int mt = 0; mt < 2; ++mt)
#pragma unroll
            for (int nt = 0; nt < 2; ++nt)
#pragma unroll
                for (int q = 0; q < 4; ++q) {
                    u32x2 w; w.x = pk_bf16(mg[nt][mt][4 * q], mg[nt][mt][4 * q + 1]); w.y = pk_bf16(mg[nt][mt][4 * q + 2], mg[nt][mt][4 * q + 3]);
                    *(u32x2*)(wl + (mt * 32 + l32) * 72 + nt * 32 + 8 * q + 4 * hi) = w;
                }
        wave_rows_out<2>(wl, MG + (long)(m0 + wm * 64) * DM + n0 + wn * 64, DM, lane);
    }
}

DEVI void phase_res_gemm_ln(const bf16_t* A, int K, const bf16_t* wt, float* out, bf16_t* xb, const float* gain, const float* bias,
                            f32x2* stats, unsigned* cnt, bf16_t* lds, bool rev = false) {
    const int tid = otid(), lane = tid & 63, wave = __builtin_amdgcn_readfirstlane(tid >> 6), wn = wave & 1, wm = wave >> 1, l32 = lane & 31, hi = lane >> 5;
    for (int t = vblock(); t < 4 * 128; t += gridDim.x) {
        const int tm = rev ? 127 - (t >> 2) : (t >> 2), tn = t & 3;
        const int n0 = tn * 256, m0 = tm * 256;
        f32x16 acc[4][2];
        zero_acc<4, 2>(acc);
        gemm_kloop<4, 2>(acc, wt + (long)n0 * K, K, A + (long)m0 * K, XRow{K}, K, lds);
#pragma unroll
        for (int mt = 0; mt < 2; ++mt) {
            const int m = m0 + wm * 64 + mt * 32 + l32;
            float s1 = 0.f, s2 = 0.f;
#pragma unroll
            for (int nt = 0; nt < 4; ++nt)
#pragma unroll
                for (int q = 0; q < 4; ++q) {
                    const long idx = (long)m * DM + n0 + wn * 128 + nt * 32 + 8 * q + 4 * hi;
                    const u32x2 rr = *(const u32x2*)(xb + idx);
                    const float r[4] = {bf2f(rr.x & 0xffffu), bf2f(rr.x >> 16), bf2f(rr.y & 0xffffu), bf2f(rr.y >> 16)};
#pragma unroll
                    for (int e = 0; e < 4; ++e) {
                        const float v = ALPHA * r[e] + acc[nt][mt][4 * q + e];
                        acc[nt][mt][4 * q + e] = v; s1 += v; s2 += v * v;
                    }
                }
            s1 += xhalf(s1); s2 += xhalf(s2);
            if (hi == 0) stats[(long)m * 8 + tn * 2 + wn] = (f32x2){s1, s2};
        }
        asm volatile("s_waitcnt vmcnt(0)" ::: "memory");
        __syncthreads();
        if (tid == 0) {
            __builtin_amdgcn_fence(__ATOMIC_RELEASE, "agent");
            asm volatile("s_waitcnt vmcnt(0)" ::: "memory");
            __hip_atomic_fetch_add(cnt + tm, 1u, __ATOMIC_RELAXED, __HIP_MEMORY_SCOPE_AGENT);
            while (__hip_atomic_load(cnt + tm, __ATOMIC_RELAXED, __HIP_MEMORY_SCOPE_AGENT) < 4u) __builtin_amdgcn_s_sleep(1);
            __builtin_amdgcn_fence(__ATOMIC_ACQUIRE, "agent");
            asm volatile("s_waitcnt vmcnt(0)" ::: "memory");
        }
        __syncthreads();
        float mu[2], rstd[2];
#pragma unroll
        for (int mt = 0; mt < 2; ++mt) {
            const int m = m0 + wm * 64 + mt * 32 + l32;
            float s1 = 0.f, s2 = 0.f;
#pragma unroll
            for (int j = 0; j < 8; ++j) { const f32x2 pj = *(const GAS f32x2*)(const GAS void*)(stats + (long)m * 8 + j); s1 += pj.x; s2 += pj.y; }
            mu[mt] = s1 * (1.0f / DM);
            const float var = fmaxf(s2 * (1.0f / DM) - mu[mt] * mu[mt], 0.f);
            rstd[mt] = rsqrtf(var + 1e-5f);
        }
#pragma unroll
        for (int nt = 0; nt < 4; ++nt) {
#pragma unroll
            for (int q = 0; q < 4; ++q) {
                const int n = n0 + wn * 128 + nt * 32 + 8 * q + 4 * hi;
                const f32x4 g4 = *(const GAS f32x4*)(const GAS float*)(gain + n), b4 = *(const GAS f32x4*)(const GAS float*)(bias + n);
#pragma unroll
                for (int mt = 0; mt < 2; ++mt) {
                    acc[nt][mt][4 * q] = (acc[nt][mt][4 * q] - mu[mt]) * rstd[mt] * g4.x + b4.x; acc[nt][mt][4 * q + 1] = (acc[nt][mt][4 * q + 1] - mu[mt]) * rstd[mt] * g4.y + b4.y;
                    acc[nt][mt][4 * q + 2] = (acc[nt][mt][4 * q + 2] - mu[mt]) * rstd[mt] * g4.z + b4.z; acc[nt][mt][4 * q + 3] = (acc[nt][mt][4 * q + 3] - mu[mt]) * rstd[mt] * g4.w + b4.w;
                }
            }
            __builtin_amdgcn_sched_barrier(0);
        }
        __builtin_amdgcn_sched_barrier(0);
        if (out) {
#pragma unroll
            for (int mt = 0; mt < 2; ++mt) {
                float* orow = out + (long)(m0 + wm * 64 + mt * 32 + l32) * DM + n0 + wn * 128 + 4 * hi;
#pragma unroll
                for (int nt = 0; nt < 4; ++nt)
#pragma unroll
                    for (int q = 0; q < 4; ++q)
                        *(f32x4*)(orow + nt * 32 + 8 * q) = (f32x4){acc[nt][mt][4 * q], acc[nt][mt][4 * q + 1], acc[nt][mt][4 * q + 2], acc[nt][mt][4 * q + 3]};
            }
        } else {
            bf16_t* wl = lds + wave * (64 * 136);
#pragma unroll
            for (int mt = 0; mt < 2; ++mt)
#pragma unroll
                for (int nt = 0; nt < 4; ++nt)
#pragma unroll
                    for (int q = 0; q < 4; ++q) {
                        u32x2 w; w.x = pk_bf16(acc[nt][mt][4 * q], acc[nt][mt][4 * q + 1]); w.y = pk_bf16(acc[nt][mt][4 * q + 2], acc[nt][mt][4 * q + 3]);
                        *(u32x2*)(wl + (mt * 32 + l32) * 136 + nt * 32 + 8 * q + 4 * hi) = w;
                    }
            wave_rows_out<4>(wl, xb + (long)(m0 + wm * 64) * DM + n0 + wn * 128, DM, lane);
        }
    }
}

DEVI void phase_ffn_up(const Params& p, int layer, bf16_t* lds) {
    unsigned char* ws = ows(p);
    const bf16_t* xb = (const bf16_t*)(ws + OFF_XB);
    const bf16_t* wt = (const bf16_t*)(ws + OFF_W + layer * W_LAYER + W_UP);
    bf16_t* H = (bf16_t*)(ws + OFF_H);
    const int lane = otid() & 63, wave = __builtin_amdgcn_readfirstlane(otid() >> 6), wn = wave & 1, wm = wave >> 1, l32 = lane & 31, hi = lane >> 5;
    for (int t = vblock(); t < 16 * 128; t += gridDim.x) {
        const int tm = t >> 4, tn = t & 15;
        const int n0 = tn * 256, m0 = tm * 256;
        f32x16 acc[4][2];
        zero_acc<4, 2>(acc);
        gemm_kloop<4, 2>(acc, wt + (long)n0 * DM, DM, xb + (long)m0 * DM, XRow{DM}, DM, lds);
        __syncthreads();
        bf16_t* wl = lds + wave * (64 * 136);
#pragma unroll
        for (int mt = 0; mt < 2; ++mt)
#pragma unroll
            for (int nt = 0; nt < 4; ++nt)
#pragma unroll
                for (int q = 0; q < 4; ++q) {
                    float v[4];
#pragma unroll
                    for (int e = 0; e < 4; ++e) { const float a = fmaxf(acc[nt][mt][4 * q + e], 0.f); v[e] = a * a; }
                    u32x2 w; w.x = pk_bf16(v[0], v[1]); w.y = pk_bf16(v[2], v[3]);
                    *(u32x2*)(wl + (mt * 32 + l32) * 136 + nt * 32 + 8 * q + 4 * hi) = w;
                }
        wave_rows_out<4>(wl, H + (long)(m0 + wm * 64) * FFN + n0 + wn * 128, FFN, lane);
    }
}

DEVI void phase_ln(const float* src, float* dst, bf16_t* xb, const float* gain, const float* bias) {
    const int lane = otid() & 63, wave = otid() >> 6;
    for (int row = blockIdx.x * NWAVES + wave; row < MTOK; row += gridDim.x * NWAVES) {
        const float* s = src + (long)row * DM;
        f32x4 v[4];
#pragma unroll
        for (int i = 0; i < 4; ++i) v[i] = *(const f32x4*)(s + i * 256 + lane * 4);
        float sum = 0.f;
#pragma unroll
        for (int i = 0; i < 4; ++i) sum += v[i].x + v[i].y + v[i].z + v[i].w;
#pragma unroll
        for (int o = 1; o < 64; o <<= 1) sum += __shfl_xor(sum, o);
        const float mu = sum * (1.0f / DM);
        float sq = 0.f;
#pragma unroll
        for (int i = 0; i < 4; ++i) { v[i].x -= mu; v[i].y -= mu; v[i].z -= mu; v[i].w -= mu; sq += v[i].x * v[i].x + v[i].y * v[i].y + v[i].z * v[i].z + v[i].w * v[i].w; }
#pragma unroll
        for (int o = 1; o < 64; o <<= 1) sq += __shfl_xor(sq, o);
        const float rstd = rsqrtf(sq * (1.0f / DM) + 1e-5f);
#pragma unroll
        for (int i = 0; i < 4; ++i) {
            const int c = i * 256 + lane * 4;
            const f32x4 g = *(const f32x4*)(gain + c), bb = *(const f32x4*)(bias + c);
            f32x4 y;
            y.x = v[i].x * rstd * g.x + bb.x; y.y = v[i].y * rstd * g.y + bb.y; y.z = v[i].z * rstd * g.z + bb.z; y.w = v[i].w * rstd * g.w + bb.w;
            *(f32x4*)(dst + (long)row * DM + c) = y;
            u32x2 w; w.x = pk_bf16(y.x, y.y); w.y = pk_bf16(y.z, y.w);
            *(u32x2*)(xb + (long)row * DM + c) = w;
        }
    }
}

DEVI void transpose_mat(const float* src, int K, int N, bf16_t* dst, float* tl) {
    const int tid = otid();
    const int tk = K / 64, tn = N / 64;
    for (int t = blockIdx.x; t < tk * tn; t += gridDim.x) {
        const int k0 = (t / tn) * 64, n0 = (t % tn) * 64;
        __syncthreads();
#pragma unroll
        for (int i = 0; i < 2; ++i) {
            const int e = tid + 512 * i, r = e >> 4, c4 = (e & 15) * 4;
            const f32x4 v = *(const f32x4*)(src + (long)(k0 + r) * N + n0 + c4);
            tl[r * 65 + c4] = v.x; tl[r * 65 + c4 + 1] = v.y; tl[r * 65 + c4 + 2] = v.z; tl[r * 65 + c4 + 3] = v.w;
        }
        __syncthreads();
#pragma unroll
        for (int i = 0; i < 1; ++i) {
            const int e = tid, n = e >> 3, kc = (e & 7) * 8;
            u32x4 w;
            w.x = pk_bf16(tl[(kc + 0) * 65 + n], tl[(kc + 1) * 65 + n]); w.y = pk_bf16(tl[(kc + 2) * 65 + n], tl[(kc + 3) * 65 + n]);
            w.z = pk_bf16(tl[(kc + 4) * 65 + n], tl[(kc + 5) * 65 + n]); w.w = pk_bf16(tl[(kc + 6) * 65 + n], tl[(kc + 7) * 65 + n]);
            *(u32x4*)(dst + (long)(n0 + n) * K + k0 + kc) = w;
        }
    }
}

struct Cx { float re, im; };
DEVI Cx cmul(Cx a, Cx b) { return {a.re * b.re - a.im * b.im, a.re * b.im + a.im * b.re}; }
DEVI Cx lam_pow(float are, float aim, float dt, float n) {
    const float mag = fexp2(are * dt * n * LOG2E);
    const float ph = (aim * dt) * n;
    return {mag * __cosf(ph), mag * __sinf(ph)};
}
DEVI Cx zoh_coef(float are, float aim, float dt) {
    const Cx lam = lam_pow(are, aim, dt, 1.0f);
    const float den = are * are + aim * aim, nr = lam.re - 1.0f;
    return {(nr * are + lam.im * aim) / den, (lam.im * are - nr * aim) / den};
}

DEVI void phase_prologue_a(const Params& p, bf16_t* lds) {
    unsigned char* ws = ows(p);
    float* tl = (float*)lds;
    const int tid = otid();
    const long gtid = (long)blockIdx.x * NTHREADS + tid, gsz = (long)gridDim.x * NTHREADS;
    {
        const float* x = p.in[0];
        bf16_t* xb = (bf16_t*)(ws + OFF_XB);
        for (long e = gtid; e < (long)MTOK * DM / 4; e += gsz) {
            const f32x4 v = *(const f32x4*)(x + e * 4);
            u32x2 w; w.x = pk_bf16(v.x, v.y); w.y = pk_bf16(v.z, v.w);
            *(u32x2*)(xb + e * 4) = w;
        }
    }
    for (int layer = 0; layer < 2; ++layer) {
        unsigned char* wl = ws + OFF_W + layer * W_LAYER;
        transpose_mat(p.in[1] + (long)layer * DM * INW, DM, INW, (bf16_t*)(wl + W_IN), tl);
        transpose_mat(p.in[13] + (long)layer * 512 * 512, 512, 512, (bf16_t*)(wl + W_GLU), tl);
        for (int br = 0; br < 3; ++br)
            transpose_mat(p.in[14] + ((long)layer * 3 + br) * 512 * DM, 512, DM, (bf16_t*)(wl + W_BR) + (long)br * DM * 512, tl);
        transpose_mat(p.in[15] + (long)layer * DM * DM, DM, DM, (bf16_t*)(wl + W_OUT), tl);
        transpose_mat(p.in[18] + (long)layer * DM * FFN, DM, FFN, (bf16_t*)(wl + W_UP), tl);
        transpose_mat(p.in[19] + (long)layer * FFN * DM, FFN, DM, (bf16_t*)(wl + W_DN), tl);

        unsigned char* sl = ws + OFF_S5 + layer * S5_LAYER;
        bf16_t* Bt = (bf16_t*)(sl + S5_BT);
        bf16_t* Zt = (bf16_t*)(sl + S5_ZT);
        float* KT = (float*)(sl + S5_KTAB);
        f32x2* LT = (f32x2*)(sl + S5_LAMT);
        const float* a_re = p.in[5] + layer * 2 * 32 * 64;
        const float* a_im = p.in[6] + layer * 2 * 32 * 64;
        const float* ldt = p.in[7] + layer * 2 * 32;
        const float* b_re = p.in[8] + (long)layer * 32 * 64 * 16;
        const float* b_im = p.in[9] + (long)layer * 32 * 64 * 16;
        const float* c_re = p.in[10] + (long)layer * 2 * 32 * 16 * 64;
        const float* c_im = p.in[11] + (long)layer * 2 * 32 * 16 * 64;
        for (long e = gtid; e < 2 * 32 * 64; e += gsz) {
            const int dg = (int)(e >> 6);
            const float dt = __expf(ldt[dg]);
            const Cx l = lam_pow(a_re[e], a_im[e], dt, 32.0f);
            LT[e] = (f32x2){l.re, l.im};
        }
        for (long e = gtid; e < 32 * 2 * 32 * 64; e += gsz) {
            const int pp = (int)(e & 63), jt = (int)((e >> 6) & 31), dir = (int)((e >> 11) & 1), g = (int)(e >> 12);
            const int ai = (dir * 32 + g) * 64 + pp;
            const float are = a_re[ai], aim = a_im[ai], dt = __expf(ldt[dir * 32 + g]);
            const Cx coef = zoh_coef(are, aim, dt);
            {
                const Cx w = cmul(lam_pow(are, aim, dt, (float)(dir == 0 ? 31 - jt : jt)), coef);
                bf16_t* zr = Zt + ((long)(g * 256 + dir * 128 + pp)) * 512 + jt * 16;
                bf16_t* zi = zr + 64 * 512;
#pragma unroll
                for (int h = 0; h < 16; ++h) {
                    const Cx bb = {b_re[(g * 64 + pp) * 16 + h], b_im[(g * 64 + pp) * 16 + h]};
                    const Cx wb = cmul(w, bb);
                    zr[h] = f2bf(wb.re); zi[h] = f2bf(wb.im);
                }
            }
            {
                const Cx lp = lam_pow(are, aim, dt, (float)(dir == 0 ? jt + 1 : 32 - jt));
#pragma unroll
                for (int h = 0; h < 16; ++h) {
                    const int ci = ((dir * 32 + g) * 16 + h) * 64 + pp;
                    const Cx c = cmul((Cx){c_re[ci], c_im[ci]}, lp);
                    bf16_t* bp = Bt + ((long)(g * 512 + jt * 16 + h)) * 768 + 512 + dir * 128 + pp;
                    bp[0] = f2bf(c.re); bp[64] = f2bf(-c.im);
                }
            }
        }
        for (int u = blockIdx.x; u < 2 * 32 * 32; u += gridDim.x) {
            const int tau = u & 31, g = (u >> 5) & 31, dir = u >> 10;
            __syncthreads();
            if (tid < 64) {
                const int ai = (dir * 32 + g) * 64 + tid;
                const float are = a_re[ai], aim = a_im[ai], dt = __expf(ldt[dir * 32 + g]);
                const Cx w = cmul(lam_pow(are, aim, dt, (float)tau), zoh_coef(are, aim, dt));
                tl[2 * tid] = w.re; tl[2 * tid + 1] = w.im;
            }
            __syncthreads();
            const int hp = (tid >> 4) & 15, h = tid & 15;
            float acc = 0.f;
            if (tid < 256)
            for (int pp = 0; pp < 64; ++pp) {
                const Cx w = {tl[2 * pp], tl[2 * pp + 1]};
                const Cx bb = {b_re[(g * 64 + pp) * 16 + h], b_im[(g * 64 + pp) * 16 + h]};
                const Cx wb = cmul(w, bb);
                const int ci = ((dir * 32 + g) * 16 + hp) * 64 + pp;
                acc += c_re[ci] * wb.re - c_im[ci] * wb.im;
            }
            if (tid < 256) KT[((long)((dir * 32 + g) * 32 + tau)) * 256 + tid] = acc;
        }
    }
}

DEVI void phase_prologue_b(const Params& p) {
    unsigned char* ws = ows(p);
    const long gtid = (long)blockIdx.x * NTHREADS + otid(), gsz = (long)gridDim.x * NTHREADS;
    for (int layer = 0; layer < 2; ++layer) {
        unsigned char* sl = ws + OFF_S5 + layer * S5_LAYER;
        bf16_t* Bt = (bf16_t*)(sl + S5_BT);
        const float* KT = (const float*)(sl + S5_KTAB);
        const float* dsk = p.in[12] + layer * 32 * 16;
        for (long e = gtid; e < 32L * 512 * 64; e += gsz) {
            const int kc = (int)(e & 63), n = (int)((e >> 6) & 511), g = (int)(e >> 15);
            const int j = kc >> 1, h0 = (kc & 1) * 8, t = n >> 4, hp = n & 15;
            float v[8];
            if (j < t) {
                const float* k = KT + ((long)((0 * 32 + g) * 32 + (t - j))) * 256 + hp * 16 + h0;
#pragma unroll
                for (int i = 0; i < 8; ++i) v[i] = k[i];
            } else if (j > t) {
                const float* k = KT + ((long)((1 * 32 + g) * 32 + (j - t))) * 256 + hp * 16 + h0;
#pragma unroll
                for (int i = 0; i < 8; ++i) v[i] = k[i];
            } else {
                const float* kf = KT + ((long)((0 * 32 + g) * 32)) * 256 + hp * 16 + h0;
                const float* kb = KT + ((long)((1 * 32 + g) * 32)) * 256 + hp * 16 + h0;
#pragma unroll
                for (int i = 0; i < 8; ++i) v[i] = kf[i] + kb[i] + ((h0 + i == hp) ? dsk[g * 16 + hp] : 0.f);
            }
            u32x4 w; w.x = pk_bf16(v[0], v[1]); w.y = pk_bf16(v[2], v[3]); w.z = pk_bf16(v[4], v[5]); w.w = pk_bf16(v[6], v[7]);
            *(u32x4*)(Bt + ((long)(g * 512 + n)) * 768 + kc * 8) = w;
        }
    }
}


DEVI void grid_barrier(unsigned* ctr, unsigned target) {
    asm volatile("s_waitcnt vmcnt(0) lgkmcnt(0)" ::: "memory");
    __syncthreads();
    if (threadIdx.x == 0) {
        __builtin_amdgcn_fence(__ATOMIC_RELEASE, "agent");
        asm volatile("s_waitcnt vmcnt(0)" ::: "memory");
        __hip_atomic_fetch_add(ctr, 1u, __ATOMIC_RELAXED, __HIP_MEMORY_SCOPE_AGENT);
        while (__hip_atomic_load(ctr, __ATOMIC_RELAXED, __HIP_MEMORY_SCOPE_AGENT) < target) __builtin_amdgcn_s_sleep(2);
        __builtin_amdgcn_fence(__ATOMIC_ACQUIRE, "agent");
        asm volatile("s_waitcnt vmcnt(0)" ::: "memory");
    }
    __syncthreads();
}

constexpr int PH_PER_LAYER = 6;
constexpr int N_PHASES = 2 + PH_PER_LAYER * 2;
__global__ void __launch_bounds__(NTHREADS, 2) fwd_kernel(Params p) {
    extern __shared__ __attribute__((aligned(16))) unsigned char lds_raw[];
    bf16_t* lds = (bf16_t*)lds_raw;
    unsigned char* ws = ows(p);
    for (int ph = p.ph_lo; ph < p.ph_hi; ++ph) {
        if (ph == 0) phase_prologue_a(p, lds);
        else if (ph == 1) phase_prologue_b(p);
        else {
            const int layer = (ph - 2) / PH_PER_LAYER, sub = (ph - 2) % PH_PER_LAYER;
            switch (sub) {
            case 0: phase_inproj(p, layer, lds); break;
            case 1: phase_mixers(p, layer, lds); break;
            case 2: phase_merge(p, layer, lds); break;
            case 3: phase_res_gemm_ln((const bf16_t*)(ws + OFF_MERGED), DM, (const bf16_t*)(ws + OFF_W + layer * W_LAYER + W_OUT), nullptr, (bf16_t*)(ws + OFF_XB),
                                      p.in[16] + layer * DM, p.in[17] + layer * DM, (f32x2*)(ws + OFF_STATS), (unsigned*)(ws + OFF_CTL) + 1024 + (layer * 2) * 128, lds); break;
            case 4: phase_ffn_up(p, layer, lds); break;
            default: phase_res_gemm_ln((const bf16_t*)(ws + OFF_H), FFN, (const bf16_t*)(ws + OFF_W + layer * W_LAYER + W_DN), layer == 1 ? p.out : nullptr, (bf16_t*)(ws + OFF_XB),
                                      p.in[20] + layer * DM, p.in[21] + layer * DM, (f32x2*)(ws + OFF_STATS), (unsigned*)(ws + OFF_CTL) + 1024 + (layer * 2 + 1) * 128, lds, true); break;
            }
        }
        if (ph + 1 < p.ph_hi) {
            if (ph == p.ph_lo) cg::this_grid().sync();
            else grid_barrier((unsigned*)(ws + OFF_CTL), (unsigned)(ph - p.ph_lo) * gridDim.x);
        }
    }
}

extern "C" void kernel_launch(void* const* d_in, const int* in_sizes, int n_in, void* d_out, int out_size, void* d_ws, size_t ws_size, hipStream_t stream) {
    static int grid = 0;
    if (grid == 0) {
        if (n_in != 22 || ws_size < WS_END) { fprintf(stderr, "kernel_launch: unexpected n_in %d / ws_size %zu\n", n_in, ws_size); grid = -1; return; }
        int dev = 0, cus = 0, per_cu = 0;
        hipGetDevice(&dev);
        hipDeviceGetAttribute(&cus, hipDeviceAttributeMultiprocessorCount, dev);
        hipFuncSetAttribute((const void*)fwd_kernel, hipFuncAttributeMaxDynamicSharedMemorySize, LDS_BYTES);
        hipOccupancyMaxActiveBlocksPerMultiprocessor(&per_cu, (const void*)fwd_kernel, NTHREADS, LDS_BYTES);
        if (per_cu < 1) per_cu = 1;
        if (per_cu > 1) per_cu = 1;
        grid = cus * per_cu;
        fprintf(stderr, "kernel_launch: grid %d (%d CUs x %d)\n", grid, cus, per_cu);
    }
    if (grid < 0) return;
    Params p{};
    for (int i = 0; i < 22; ++i) p.in[i] = (const float*)d_in[i];
    p.out = (float*)d_out; p.ws = (unsigned char*)d_ws;
#if SINGLE_LAUNCH
    hipMemsetAsync((unsigned char*)d_ws + OFF_CTL, 0, 8192, stream);
    p.ph_lo = 0; p.ph_hi = N_PHASES;
    void* args[] = {&p};
    hipError_t e = hipLaunchCooperativeKernel((const void*)fwd_kernel, dim3(grid), dim3(NTHREADS), args, LDS_BYTES, stream);
    if (e != hipSuccess) fprintf(stderr, "cooperative launch failed: %s (grid %d)\n", hipGetErrorString(e), grid);
#else
    for (int ph = 0; ph < N_PHASES; ++ph) {
        p.ph_lo = ph; p.ph_hi = ph + 1;
        hipLaunchKernelGGL(fwd_kernel, dim3(grid), dim3(NTHREADS), LDS_BYTES, stream, p);
    }
#endif
}
```

```cpp
#include <hip/hip_runtime.h>
#include <hip/hip_cooperative_groups.h>
#include <cstdio>
namespace cg = cooperative_groups;

#ifndef SINGLE_LAUNCH
#define SINGLE_LAUNCH 1
#endif

typedef unsigned short bf16_t;
typedef short bf16x8 __attribute__((ext_vector_type(8)));
typedef float f32x16 __attribute__((ext_vector_type(16)));
typedef float f32x4 __attribute__((ext_vector_type(4)));
typedef float f32x2 __attribute__((ext_vector_type(2)));
typedef unsigned u32x4 __attribute__((ext_vector_type(4)));
typedef unsigned u32x2 __attribute__((ext_vector_type(2)));
#define DEVI __device__ __forceinline__

constexpr int DM = 1024, SEQ = 8192, NB = 4, MTOK = NB * SEQ, FFN = 4096, INW = 5888;
constexpr int PW = 2816;
constexpr int CQ = 0, CK = 512, CNQ = 768, CNK = 1280, CSU = 2304;
constexpr float ALPHA = 1.4142135623730951f;
constexpr float LOG2E = 1.4426950408889634f;
constexpr int NTHREADS = 512, NWAVES = 8;
constexpr int LSTR = 72;
constexpr int LDS_BYTES = 2 * (256 + 256) * LSTR * 2;

constexpr size_t MiB = 1u << 20;
constexpr size_t OFF_P = 0, OFF_H = 0, OFF_ZB = 176 * MiB, OFF_MERGED = 176 * MiB, OFF_NVT = 208 * MiB, OFF_VT = 240 * MiB;
constexpr size_t OFF_ZS = 256 * MiB, OFF_SPREV = 288 * MiB;
constexpr size_t OFF_W = 304 * MiB, W_LAYER = 34 * MiB;
constexpr size_t W_IN = 0, W_GLU = 12 * MiB, W_BR = 13 * MiB, W_OUT = 16 * MiB, W_UP = 18 * MiB, W_DN = 26 * MiB;
constexpr size_t OFF_S5 = 372 * MiB, S5_LAYER = 35 * MiB;
constexpr size_t S5_BT = 0, S5_ZT = 24 * MiB, S5_KTAB = 32 * MiB, S5_LAMT = 34 * MiB;
constexpr size_t OFF_XB = 442 * MiB;
constexpr size_t OFF_CTL = 506 * MiB;
constexpr size_t OFF_STATS = 507 * MiB;
constexpr size_t WS_END = 509 * MiB;

struct Params {
    const float* in[22];
    float* out;
    unsigned char* ws;
    int ph_lo, ph_hi;
};

DEVI unsigned char* ows(const Params& p) { unsigned char* w = p.ws; asm volatile("" : "+s"(w)); return w; }
#define GAS __attribute__((address_space(1)))
DEVI u32x4 gld16(const void* p) { return *(const GAS u32x4*)(const GAS char*)p; }
DEVI bf16x8 gld16b(const void* p) { return *(const GAS bf16x8*)(const GAS char*)p; }
DEVI void gst8(void* base, unsigned off, u32x2 v) { *(GAS u32x2*)((GAS char*)base + off) = v; }
DEVI void gst2(void* base, unsigned off, bf16_t v) { *(GAS bf16_t*)((GAS char*)base + off) = v; }
DEVI int otid() { int t = threadIdx.x; asm volatile("" : "+v"(t)); return t; }
typedef __bf16 bf16x2_t __attribute__((ext_vector_type(2)));
DEVI unsigned pk_bf16_m(float lo, float hi) { const f32x2 v = {lo, hi}; const bf16x2_t b = __builtin_convertvector(v, bf16x2_t); return __builtin_bit_cast(unsigned, b); }
DEVI unsigned pk_bf16(float lo, float hi) { unsigned r; asm("v_cvt_pk_bf16_f32 %0, %1, %2" : "=v"(r) : "v"(lo), "v"(hi)); return r; }
DEVI bf16_t f2bf(float f) { return (bf16_t)(pk_bf16(f, 0.f) & 0xffffu); }
DEVI float bf2f(unsigned v) { return __uint_as_float(v << 16); }
DEVI float fexp2(float x) { return __builtin_amdgcn_exp2f(x); }
DEVI float sigmoidf_(float x) { return 1.0f / (1.0f + fexp2(-x * LOG2E)); }
DEVI float gelu_tanh(float y) {
    const float u = 0.7978845608028654f * (y + 0.044715f * y * y * y);
    return y * sigmoidf_(2.0f * u);
}
DEVI f32x16 mfma32(bf16x8 a, bf16x8 b, f32x16 c) { return __builtin_amdgcn_mfma_f32_32x32x16_bf16(a, b, c, 0, 0, 0); }
DEVI float xhalf(float v) { return __shfl_xor(v, 32); }

#define LAS __attribute__((address_space(3)))
#define SB() __builtin_amdgcn_sched_barrier(0)
template <int NT, int MT, class XF>
DEVI void gemm_kloop(f32x16 (&acc)[NT][MT], const bf16_t* wbase, int ldw, const bf16_t* xbase, const XF& xf, int K, bf16_t* lds) {
    const int tid = otid(), lane = tid & 63;
    const int wave = __builtin_amdgcn_readfirstlane(tid >> 6);
    const int wn = wave & 1, wm = wave >> 1, l32 = lane & 31, hi = lane >> 5;
    constexpr int WR = 64 * NT, XR = 128 * MT, WI = WR / 64, XI = XR / 64, STAGE = (WR + XR) * 64, NP = WI + XI;
    const int nk = K >> 6;
    const int lrow = wave * 8 + (lane >> 3);
    const int lc = ((lane & 7) ^ ((lrow >> 1) & 7)) * 8;
    const unsigned woff0 = ((unsigned)lrow * (unsigned)ldw + (unsigned)lc) * 2u;
    const unsigned wstep = 64u * (unsigned)ldw * 2u;
    unsigned xoff[XI];
#pragma unroll
    for (int j = 0; j < XI; ++j) xoff[j] = xf.off((unsigned)(lrow + 64 * j), (unsigned)lc) * 2u;
    const GAS char* wp = (const GAS char*)wbase;
    const GAS char* xp = (const GAS char*)xbase;
    const unsigned xstep = (unsigned)xf.kstep() * 2u;
    LAS bf16_t* L = (LAS bf16_t*)lds;
    const int sw = (l32 >> 1) & 7;
    int koff[4];
#pragma unroll
    for (int kk = 0; kk < 4; ++kk) koff[kk] = ((kk * 2 + hi) ^ sw) * 8;
#define GEMM_PIECE(bufi, pi) do { \
        LAS bf16_t* _d = L + (bufi) * STAGE + wave * 8 * 64; \
        if ((pi) < WI) __builtin_amdgcn_global_load_lds((const GAS unsigned*)(wp + woff0 + (pi) * wstep), (LAS unsigned*)(_d + (pi) * 64 * 64), 16, 0, 0); \
        else if ((pi) < NP) __builtin_amdgcn_global_load_lds((const GAS unsigned*)(xp + xoff[((pi) - WI) < XI ? ((pi) - WI) : 0]), (LAS unsigned*)(_d + (WR + ((pi) - WI) * 64) * 64), 16, 0, 0); \
    } while (0)
#define GEMM_RFR(set, kk) do { \
        _Pragma("unroll") for (int mt = 0; mt < MT; ++mt) fb[set][mt] = *(const LAS bf16x8*)(xsb + mt * 32 * 64 + koff[kk]); \
        _Pragma("unroll") for (int nt = 0; nt < NT; ++nt) fa[set][nt] = *(const LAS bf16x8*)(wsb + nt * 32 * 64 + koff[kk]); \
    } while (0)
#define GEMM_MMA(set, nlo, nhi) do { \
        __builtin_amdgcn_s_setprio(1); \
        _Pragma("unroll") for (int nt = (nlo); nt < (nhi); ++nt) \
        _Pragma("unroll") for (int mt = 0; mt < MT; ++mt) acc[nt][mt] = mfma32(fa[set][nt], fb[set][mt], acc[nt][mt]); \
        __builtin_amdgcn_s_setprio(0); \
    } while (0)
    asm volatile("s_waitcnt vmcnt(0)" ::: "memory");
    __builtin_amdgcn_s_barrier();
#pragma unroll
    for (int pi = 0; pi < NP; ++pi) GEMM_PIECE(0, pi);
#pragma unroll 1
    for (int kt = 0; kt < nk; ++kt) {
        const int buf = kt & 1;
        const bool more = (kt + 1 < nk);
        asm volatile("s_waitcnt vmcnt(0) lgkmcnt(0)" ::: "memory");
        __builtin_amdgcn_s_barrier();
        const LAS bf16_t* wsb = L + buf * STAGE + (wn * 32 * NT + l32) * 64;
        const LAS bf16_t* xsb = L + buf * STAGE + (WR + wm * 32 * MT + l32) * 64;
        bf16x8 fa[2][NT], fb[2][MT];
        GEMM_RFR(0, 0);
        SB();
        if (more) { wp += 128; xp += xstep; }
#pragma unroll
        for (int kk = 0; kk < 4; ++kk) {
            if (kk < 3) { GEMM_RFR((kk + 1) & 1, kk + 1); }
            SB();
            if (more && kk < 2) { GEMM_PIECE(buf ^ 1, 4 * kk); GEMM_PIECE(buf ^ 1, 4 * kk + 1); }
            SB();
            GEMM_MMA(kk & 1, 0, NT / 2);
            SB();
            if (more && kk < 2) { GEMM_PIECE(buf ^ 1, 4 * kk + 2); GEMM_PIECE(buf ^ 1, 4 * kk + 3); }
            SB();
            GEMM_MMA(kk & 1, NT / 2, NT);
            SB();
        }
    }
#undef GEMM_PIECE
#undef GEMM_RFR
#undef GEMM_MMA
}

template <int NT, int MT> DEVI void zero_acc(f32x16 (&acc)[NT][MT]) {
#pragma unroll
    for (int nt = 0; nt < NT; ++nt)
#pragma unroll
        for (int mt = 0; mt < MT; ++mt)
#pragma unroll
            for (int i = 0; i < 16; ++i) acc[nt][mt][i] = 0.f;
}
DEVI int vblock() { const int G = gridDim.x, b = blockIdx.x; return (G % 8 == 0) ? (b % 8) * (G / 8) + b / 8 : b; }

struct XRow {
    int ld;
    DEVI unsigned off(unsigned r, unsigned kc) const { return r * (unsigned)ld + kc; }
    DEVI int kstep() const { return 64; }
};
struct XS5 {
    DEVI unsigned off(unsigned r, unsigned kc) const { return (r * 32u + (kc >> 4)) * (unsigned)PW + (kc & 15u); }
    DEVI int kstep() const { return 4 * PW; }
};


template <int NT> DEVI void wave_rows_out(const bf16_t* wl, bf16_t* gbase, long ld, int lane) {
    constexpr int RS = NT * 32 + 8, CPR = NT * 4, RPI = 64 / CPR;
    asm volatile("s_waitcnt lgkmcnt(0)" ::: "memory");
    const bf16_t* lp = wl + (lane / CPR) * RS + (lane % CPR) * 8;
    const unsigned loff = ((unsigned)(lane / CPR) * (unsigned)ld + (unsigned)(lane % CPR) * 8u) * 2u;
    GAS char* gp = (GAS char*)gbase;
    const unsigned gstep = (unsigned)RPI * (unsigned)ld * 2u;
#pragma unroll 4
    for (int j = 0; j < NT * 4; ++j) {
        const u32x4 v = *(const u32x4*)(lp);
        *(GAS u32x4*)(gp + loff) = v;
        gp += gstep; lp += RPI * RS;
    }
}

DEVI void phase_inproj(const Params& p, int layer, bf16_t* lds) {
    unsigned char* ws = ows(p);
    const bf16_t* xb = (const bf16_t*)(ws + OFF_XB);
    const bf16_t* wt = (const bf16_t*)(ws + OFF_W + layer * W_LAYER + W_IN);
    bf16_t* P = (bf16_t*)(ws + OFF_P);
    bf16_t* VT = (bf16_t*)(ws + OFF_VT);
    bf16_t* NVT = (bf16_t*)(ws + OFF_NVT);
    const float* qg = p.in[2] + layer * 64;
    const float* kg = p.in[3] + layer * 64;
    const int tid0 = otid();
    const int wave = __builtin_amdgcn_readfirstlane(tid0 >> 6), wn = wave & 1, wm = wave >> 1;
    constexpr int NT_N = PW / 256, NT_M = MTOK / 256;
    for (int t = vblock(); t < NT_N * NT_M; t += gridDim.x) {
        const int tm = t / NT_N, tn = t % NT_N;
        const int n0 = tn * 256, m0 = tm * 256;
        f32x16 acc[4][2];
        zero_acc<4, 2>(acc);
        gemm_kloop<4, 2>(acc, wt + (long)n0 * DM, DM, xb + (long)m0 * DM, XRow{DM}, DM, lds);
        __syncthreads();
        bf16_t* wl = lds + wave * (64 * 136);
        int lane = tid0 & 63; asm volatile("" : "+v"(lane));
        const int l32 = lane & 31, hi = lane >> 5;
        const int nbw = n0 + wn * 128;
        const int mw = m0 + wm * 64;
        bf16_t* pbase = P + (long)mw * PW + nbw;
        if (nbw < 640) {
            const float* gain = (nbw < 512) ? qg : kg;
#pragma unroll
            for (int hp = 0; hp < 2; ++hp)
#pragma unroll
            for (int mt = 0; mt < 2; ++mt) {
                const int tpos = (mw + mt * 32 + l32) & (SEQ - 1);
                float ss = 0.f;
#pragma unroll
                for (int nt = 0; nt < 2; ++nt)
#pragma unroll
                    for (int i = 0; i < 16; ++i) ss += acc[2 * hp + nt][mt][i] * acc[2 * hp + nt][mt][i];
                ss += xhalf(ss);
                const float rs = rsqrtf(ss * (1.0f / 64.0f) + 1e-6f) * ((nbw < 512) ? 0.125f * LOG2E : 1.0f);
#pragma unroll
                for (int nt = 0; nt < 2; ++nt) {
                    const float pos = (float)(nt == 0 ? (tpos >> 6) : (tpos & 63));
                    float v[16];
#pragma unroll
                    for (int q = 0; q < 4; ++q) {
                        const f32x4 g4 = *(const GAS f32x4*)(const GAS float*)(gain + nt * 32 + 8 * q + 4 * hi);
                        v[4 * q] = acc[2 * hp + nt][mt][4 * q] * rs * g4.x; v[4 * q + 1] = acc[2 * hp + nt][mt][4 * q + 1] * rs * g4.y;
                        v[4 * q + 2] = acc[2 * hp + nt][mt][4 * q + 2] * rs * g4.z; v[4 * q + 3] = acc[2 * hp + nt][mt][4 * q + 3] * rs * g4.w;
                    }
#pragma unroll
                    for (int i = 0; i < 8; ++i) {
                        const int j = 8 * (i >> 2) + 4 * hi + (i & 3);
                        const float inv = fexp2(-(float)j * 0.8304820237218406f);
                        const float ang = pos * inv;
                        const float c = __cosf(ang), sn = __sinf(ang);
                        const float x1 = v[i], x2 = v[i + 8];
                        v[i] = x1 * c - x2 * sn;
                        v[i + 8] = x2 * c + x1 * sn;
                    }
#pragma unroll
                    for (int q = 0; q < 4; ++q) {
                        u32x2 w; w.x = pk_bf16(v[4 * q], v[4 * q + 1]); w.y = pk_bf16(v[4 * q + 2], v[4 * q + 3]);
                        *(u32x2*)(wl + (mt * 32 + l32) * 136 + hp * 64 + nt * 32 + 8 * q + 4 * hi) = w;
                    }
                    __builtin_amdgcn_sched_barrier(0);
                }
            }
            wave_rows_out<4>(wl, pbase, PW, lane);
        } else if (nbw == 640 || (nbw >= 1792 && nbw < 2304)) {
            const int b = mw >> 13, tpos0 = mw & (SEQ - 1);
            bf16_t* base = (nbw == 640) ? VT + ((long)(b * 2) * 64) * SEQ + tpos0 : NVT + ((long)(b * 8 + ((nbw - 1792) >> 6)) * 64) * SEQ + tpos0;
            const unsigned voff = (unsigned)(4 * hi * SEQ + l32) * 2u;
#pragma unroll
            for (int mt = 0; mt < 2; ++mt)
#pragma unroll
                for (int nt = 0; nt < 4; ++nt)
#pragma unroll
                    for (int i = 0; i < 16; ++i)
                        gst2(base, voff + (unsigned)(((nt * 32 + 8 * (i >> 2) + (i & 3)) * SEQ + mt * 32) * 2), f2bf(acc[nt][mt][i]));
        } else {
#pragma unroll
            for (int mt = 0; mt < 2; ++mt)
#pragma unroll
                for (int nt = 0; nt < 4; ++nt)
#pragma unroll
                    for (int q = 0; q < 4; ++q) {
                        u32x2 w; w.x = pk_bf16(acc[nt][mt][4 * q], acc[nt][mt][4 * q + 1]); w.y = pk_bf16(acc[nt][mt][4 * q + 2], acc[nt][mt][4 * q + 3]);
                        *(u32x2*)(wl + (mt * 32 + l32) * 136 + nt * 32 + 8 * q + 4 * hi) = w;
                    }
            wave_rows_out<4>(wl, pbase, PW, lane);
        }
    }
}

DEVI void online_softmax(f32x16 (&s)[2], f32x16 (&o)[2], float& mrun, float& lrun, bf16x8 (&pb)[2][2]) {
    float mx = s[0][0];
#pragma unroll
    for (int kt = 0; kt < 2; ++kt)
#pragma unroll
        for (int i = 0; i < 16; ++i) mx = fmaxf(mx, s[kt][i]);
    mx = fmaxf(mx, xhalf(mx));
    const float mnew = fmaxf(mrun, mx);
    const float alpha = fexp2(mrun - mnew);
    mrun = mnew;
    float ps = 0.f;
#pragma unroll
    for (int kt = 0; kt < 2; ++kt)
#pragma unroll
        for (int i = 0; i < 16; ++i) { const float e = fexp2(s[kt][i] - mnew); s[kt][i] = e; ps += e; }
    lrun = lrun * alpha + ps;
#pragma unroll
    for (int dt = 0; dt < 2; ++dt)
#pragma unroll
        for (int i = 0; i < 16; ++i) o[dt][i] *= alpha;
#pragma unroll
    for (int kt = 0; kt < 2; ++kt)
#pragma unroll
        for (int sl = 0; sl < 2; ++sl) {
            u32x4 w;
            w.x = pk_bf16_m(s[kt][8 * sl + 0], s[kt][8 * sl + 1]); w.y = pk_bf16_m(s[kt][8 * sl + 2], s[kt][8 * sl + 3]);
            w.z = pk_bf16_m(s[kt][8 * sl + 4], s[kt][8 * sl + 5]); w.w = pk_bf16_m(s[kt][8 * sl + 6], s[kt][8 * sl + 7]);
            pb[kt][sl] = __builtin_bit_cast(bf16x8, w);
        }
}
DEVI int kperm(int r) { return (r & 16) + 8 * ((r >> 2) & 1) + 4 * ((r >> 3) & 1) + (r & 3); }

DEVI void gqa_unit(const Params& p, int layer, int unit, bf16_t* lds) {
    unsigned char* ws = ows(p);
    bf16_t* P = (bf16_t*)(ws + OFF_P);
    const bf16_t* VT = (const bf16_t*)(ws + OFF_VT);
    const int tid = otid(), lane = tid & 63, wave = tid >> 6, l32 = lane & 31, hi = lane >> 5;
    const int qb = unit & 31, h = (unit >> 5) & 7, b = unit >> 8, kvh = h >> 2;
    const int qrow = qb * 256 + wave * 32 + l32;
    bf16_t* Ks = lds;
    bf16_t* Vs = lds + 2 * 64 * LSTR;
    bf16x8 qf[4];
    {
        const bf16_t* qp = P + ((long)(b * SEQ + qrow)) * PW + CQ + h * 64 + hi * 8;
#pragma unroll
        for (int kk = 0; kk < 4; ++kk) qf[kk] = *(const bf16x8*)(qp + kk * 16);
    }
    float mb;
    {
        float gq = fabsf(p.in[2][layer * 64 + lane]), gk = fabsf(p.in[3][layer * 64 + lane]);
#pragma unroll
        for (int o2 = 1; o2 < 64; o2 <<= 1) { gq = fmaxf(gq, __shfl_xor(gq, o2)); gk = fmaxf(gk, __shfl_xor(gk, o2)); }
        mb = 8.0f * gq * gk * LOG2E * 1.01f;
    }
    const bf16_t* kbase = P + ((long)b * SEQ) * PW + CK + kvh * 64;
    const bf16_t* vbase = VT + ((long)(b * 2 + kvh) * 64) * SEQ;
    f32x16 o[2];
#pragma unroll
    for (int dt = 0; dt < 2; ++dt)
#pragma unroll
        for (int i = 0; i < 16; ++i) o[dt][i] = 0.f;
    float lrun = 0.f;
    u32x4 kreg[1], vreg[1];
#pragma unroll
    for (int i = 0; i < 1; ++i) {
        const int c = tid, r = c >> 3, cc = (c & 7) * 8;
        kreg[i] = gld16(kbase + (long)r * PW + cc);
        vreg[i] = gld16(vbase + (long)r * SEQ + cc);
    }
#pragma unroll
    for (int i = 0; i < 1; ++i) {
        const int c = tid, r = c >> 3, cc = (c & 7) * 8;
        *(u32x4*)(Ks + r * LSTR + cc) = kreg[i];
        *(u32x4*)(Vs + r * LSTR + cc) = vreg[i];
    }
    __syncthreads();
    const int kr = kperm(l32);
    for (int kt0 = 0; kt0 < SEQ / 64; ++kt0) {
        const int buf = kt0 & 1;
        const bool more = (kt0 + 1 < SEQ / 64);
        if (more) {
            const int key0 = (kt0 + 1) * 64;
#pragma unroll
            for (int i = 0; i < 1; ++i) {
                const int c = tid, r = c >> 3, cc = (c & 7) * 8;
                kreg[i] = gld16(kbase + (long)(key0 + r) * PW + cc);
                vreg[i] = gld16(vbase + (long)r * SEQ + key0 + cc);
            }
        }
        f32x16 s[2];
        bf16x8 kf[2][4], vf[2][2][2];
#pragma unroll
        for (int kt = 0; kt < 2; ++kt) {
            const bf16_t* kp = Ks + (buf * 64 + kt * 32 + kr) * LSTR + hi * 8;
#pragma unroll
            for (int kk = 0; kk < 4; ++kk) kf[kt][kk] = *(const bf16x8*)(kp + kk * 16);
        }
#pragma unroll
        for (int dt = 0; dt < 2; ++dt) {
            const bf16_t* vp = Vs + (buf * 64 + dt * 32 + l32) * LSTR + hi * 8;
#pragma unroll
            for (int kt = 0; kt < 2; ++kt)
#pragma unroll
                for (int sl = 0; sl < 2; ++sl) vf[dt][kt][sl] = *(const bf16x8*)(vp + kt * 32 + sl * 16);
        }
        __builtin_amdgcn_sched_barrier(0);
        __builtin_amdgcn_s_setprio(1);
#pragma unroll
        for (int kt = 0; kt < 2; ++kt) {
#pragma unroll
            for (int i = 0; i < 16; ++i) s[kt][i] = -mb;
#pragma unroll
            for (int kk = 0; kk < 4; ++kk) s[kt] = mfma32(kf[kt][kk], qf[kk], s[kt]);
        }
        __builtin_amdgcn_s_setprio(0);
        bf16x8 pb[2][2];
#pragma unroll
        for (int kt = 0; kt < 2; ++kt) {
#pragma unroll
            for (int i = 0; i < 16; ++i) { const float e = fexp2(s[kt][i]); s[kt][i] = e; lrun += e; }
#pragma unroll
            for (int sl = 0; sl < 2; ++sl) {
                u32x4 w;
                w.x = pk_bf16_m(s[kt][8 * sl + 0], s[kt][8 * sl + 1]); w.y = pk_bf16_m(s[kt][8 * sl + 2], s[kt][8 * sl + 3]);
                w.z = pk_bf16_m(s[kt][8 * sl + 4], s[kt][8 * sl + 5]); w.w = pk_bf16_m(s[kt][8 * sl + 6], s[kt][8 * sl + 7]);
                pb[kt][sl] = __builtin_bit_cast(bf16x8, w);
            }
        }
#pragma unroll
        for (int dt = 0; dt < 2; ++dt)
#pragma unroll
            for (int kt = 0; kt < 2; ++kt)
#pragma unroll
                for (int sl = 0; sl < 2; ++sl) o[dt] = mfma32(vf[dt][kt][sl], pb[kt][sl], o[dt]);
        if (more) {
            const int nb = buf ^ 1;
#pragma unroll
            for (int i = 0; i < 1; ++i) {
                const int c = tid, r = c >> 3, cc = (c & 7) * 8;
                *(u32x4*)(Ks + (nb * 64 + r) * LSTR + cc) = kreg[i];
                *(u32x4*)(Vs + (nb * 64 + r) * LSTR + cc) = vreg[i];
            }
        }
        __syncthreads();
    }
    lrun += xhalf(lrun);
    const float inv = 1.0f / lrun;
    bf16_t* op = P + ((long)(b * SEQ + qrow)) * PW + CQ + h * 64;
#pragma unroll
    for (int dt = 0; dt < 2; ++dt)
#pragma unroll
        for (int q = 0; q < 4; ++q) {
            u32x2 w; w.x = pk_bf16(o[dt][4 * q] * inv, o[dt][4 * q + 1] * inv); w.y = pk_bf16(o[dt][4 * q + 2] * inv, o[dt][4 * q + 3] * inv);
            *(u32x2*)(op + dt * 32 + 8 * q + 4 * hi) = w;
        }
}

DEVI void nat_block_unit(const Params& p, int layer, int unit, bf16_t* lds) {
    unsigned char* ws = ows(p);
    bf16_t* P = (bf16_t*)(ws + OFF_P);
    const bf16_t* NVT = (const bf16_t*)(ws + OFF_NVT);
    const float* bias = p.in[4] + (long)layer * 8 * 15 * 31;
    const int tid = otid(), lane = tid & 63, wave = __builtin_amdgcn_readfirstlane(tid >> 6), l32 = lane & 31, hi = lane >> 5;
    const int wu = unit * NWAVES + wave;
    const int qt = wu & 1, h = (wu >> 1) & 7, r = (wu >> 4) & 127, b = wu >> 11;
    const int h0 = (unit * 4) & 7;
    float* bl = (float*)lds;
    for (int e = tid; e < 4 * 465; e += NTHREADS) bl[e] = bias[h0 * 465 + e];
    __syncthreads();
    const float* bh = bl + (h - h0) * 465;
    int rs = r - 4; rs = rs < 0 ? 0 : (rs > 120 ? 120 : rs);
    const int qc = qt * 32 + l32;
    int cs = qc - 8; cs = cs < 0 ? 0 : (cs > 48 ? 48 : cs);
    const long tok0 = (long)b * SEQ;
    bf16x8 qf[4];
    {
        const bf16_t* qp = P + (tok0 + r * 64 + qc) * PW + CNQ + h * 64 + hi * 8;
#pragma unroll
        for (int kk = 0; kk < 4; ++kk) qf[kk] = gld16b(qp + kk * 16);
    }
    f32x16 o[2];
#pragma unroll
    for (int dt = 0; dt < 2; ++dt)
#pragma unroll
        for (int i = 0; i < 16; ++i) o[dt][i] = 0.f;
    float mrun = -INFINITY, lrun = 0.f;
    const int kr = kperm(l32);
    constexpr float C = 0.125f * LOG2E;
    const bf16_t* kbase = P + (tok0 + kr) * PW + CNK + h * 64 + hi * 8;
    const bf16_t* vbase = NVT + ((long)(b * 8 + h) * 64 + l32) * SEQ + hi * 8;
    bf16_t* wl = (bf16_t*)((unsigned char*)lds + 8192) + wave * (64 * LSTR);
    const int srow = lane >> 3, scol = (lane & 7) * 8;
    const bf16_t* kg = P + (tok0 + srow) * PW + CNK + h * 64 + scol;
    const bf16_t* vg = NVT + ((long)(b * 8 + h) * 64 + srow) * SEQ + scol;
    u32x4 kst[8], vst[8];
#define NAT_LOADK(krow) do { _Pragma("unroll") for (int i = 0; i < 8; ++i) kst[i] = gld16(kg + (long)((krow) * 64 + 8 * i) * PW); } while (0)
#define NAT_LOADV(krow) do { _Pragma("unroll") for (int i = 0; i < 8; ++i) vst[i] = gld16(vg + (long)(8 * i) * SEQ + (krow) * 64); } while (0)
    NAT_LOADK(rs);
    NAT_LOADV(rs);
#pragma unroll 1
    for (int ir = 0; ir < 8; ++ir) {
        const int krow = rs + ir;
        const int nrow = (ir < 7) ? krow + 1 : krow;
        const float* brow = bh + (krow - r + 7) * 31 + 15 - qc;
        bf16x8 kf[2][4], vf[2][2][2];
#pragma unroll
        for (int i = 0; i < 8; ++i) *(u32x4*)(wl + (srow + 8 * i) * LSTR + scol) = kst[i];
        __builtin_amdgcn_sched_barrier(0);
#pragma unroll
        for (int kt = 0; kt < 2; ++kt)
#pragma unroll
            for (int kk = 0; kk < 4; ++kk) kf[kt][kk] = *(const bf16x8*)(wl + (kt * 32 + kr) * LSTR + hi * 8 + kk * 16);
        __builtin_amdgcn_sched_barrier(0);
        NAT_LOADK(nrow);
        f32x16 s[2];
#pragma unroll
        for (int kt = 0; kt < 2; ++kt) {
#pragma unroll
            for (int i = 0; i < 16; ++i) s[kt][i] = 0.f;
#pragma unroll
            for (int kk = 0; kk < 4; ++kk) s[kt] = mfma32(kf[kt][kk], qf[kk], s[kt]);
        }
        __builtin_amdgcn_sched_barrier(0);
#pragma unroll
        for (int i = 0; i < 8; ++i) *(u32x4*)(wl + (srow + 8 * i) * LSTR + scol) = vst[i];
        __builtin_amdgcn_sched_barrier(0);
#pragma unroll
        for (int dt = 0; dt < 2; ++dt)
#pragma unroll
            for (int kt = 0; kt < 2; ++kt)
#pragma unroll
                for (int sl = 0; sl < 2; ++sl) vf[dt][kt][sl] = *(const bf16x8*)(wl + (dt * 32 + l32) * LSTR + hi * 8 + kt * 32 + sl * 16);
        __builtin_amdgcn_sched_barrier(0);
        NAT_LOADV(nrow);
        float mx = -INFINITY;
#pragma unroll
        for (int g4 = 0; g4 < 4; ++g4) {
            const int kt = g4 >> 1, sl = g4 & 1;
            const bool dead = (g4 == 3 && qt == 0) || (g4 == 0 && qt == 1);
            if (!dead) {
#pragma unroll
                for (int e = 0; e < 8; ++e) {
                    const int i = sl * 8 + e;
                    const int kc = kt * 32 + 16 * sl + 8 * hi + e;
                    const bool valid = (kc >= cs) && (kc < cs + 16);
                    const float bv = brow[valid ? kc : qc];
                    const float v = valid ? (s[kt][i] * C + bv * LOG2E) : -INFINITY;
                    s[kt][i] = v; mx = fmaxf(mx, v);
                }
            }
        }
        mx = fmaxf(mx, xhalf(mx));
        const float mnew = fmaxf(mrun, mx);
        const float alpha = fexp2(mrun - mnew);
        mrun = mnew;
        float ps = 0.f;
        bf16x8 pb[2][2];
#pragma unroll
        for (int g4 = 0; g4 < 4; ++g4) {
            const int kt = g4 >> 1, sl = g4 & 1;
            const bool dead = (g4 == 3 && qt == 0) || (g4 == 0 && qt == 1);
            if (!dead) {
                float pe[8];
#pragma unroll
                for (int e = 0; e < 8; ++e) { pe[e] = fexp2(s[kt][sl * 8 + e] - mnew); ps += pe[e]; }
                u32x4 w;
                w.x = pk_bf16_m(pe[0], pe[1]); w.y = pk_bf16_m(pe[2], pe[3]); w.z = pk_bf16_m(pe[4], pe[5]); w.w = pk_bf16_m(pe[6], pe[7]);
                pb[kt][sl] = __builtin_bit_cast(bf16x8, w);
            }
        }
        lrun = lrun * alpha + ps;
#pragma unroll
        for (int dt = 0; dt < 2; ++dt)
#pragma unroll
            for (int i = 0; i < 16; ++i) o[dt][i] *= alpha;
#pragma unroll
        for (int g4 = 0; g4 < 4; ++g4) {
            const int kt = g4 >> 1, sl = g4 & 1;
            const bool dead = (g4 == 3 && qt == 0) || (g4 == 0 && qt == 1);
            if (!dead) {
#pragma unroll
                for (int dt = 0; dt < 2; ++dt) o[dt] = mfma32(vf[dt][kt][sl], pb[kt][sl], o[dt]);
            }
        }
        __builtin_amdgcn_sched_barrier(0);
    }
#undef NAT_LOADK
#undef NAT_LOADV
    lrun += xhalf(lrun);
    const float inv = 1.0f / lrun;
    bf16_t* op = P + (tok0 + r * 64 + qc) * PW + CNQ + h * 64;
#pragma unroll
    for (int dt = 0; dt < 2; ++dt)
#pragma unroll
        for (int q = 0; q < 4; ++q) {
            u32x2 w; w.x = pk_bf16(o[dt][4 * q] * inv, o[dt][4 * q + 1] * inv); w.y = pk_bf16(o[dt][4 * q + 2] * inv, o[dt][4 * q + 3] * inv);
            *(u32x2*)(op + dt * 32 + 8 * q + 4 * hi) = w;
        }
}

DEVI void s5z_tile(const Params& p, int layer, int t, bf16_t* lds) {
    unsigned char* ws = ows(p);
    const bf16_t* P = (const bf16_t*)(ws + OFF_P);
    const bf16_t* Zt = (const bf16_t*)(ws + OFF_S5 + layer * S5_LAYER + S5_ZT);
    float* ZS = (float*)(ws + OFF_ZS);
    const int lane = otid() & 63, wave = __builtin_amdgcn_readfirstlane(otid() >> 6), wn = wave & 1, wm = wave >> 1, l32 = lane & 31, hi = lane >> 5;
    const int g = t >> 2, tm = t & 3;
    const int m0 = tm * 256;
    f32x16 acc[4][2];
    zero_acc<4, 2>(acc);
    gemm_kloop<4, 2>(acc, Zt + ((long)g * 256) * 512, 512, P + ((long)m0 * 32) * PW + CSU + g * 16, XS5{}, 512, lds);
#pragma unroll
    for (int mt = 0; mt < 2; ++mt) {
        const int R = m0 + wm * 64 + mt * 32 + l32, b = R >> 8, c = R & 255;
        float* zp = ZS + ((long)((b * 32 + g) * 256 + c)) * 256 + wn * 128;
#pragma unroll
        for (int nt = 0; nt < 4; ++nt)
#pragma unroll
            for (int q = 0; q < 4; ++q) {
                f32x4 v = {acc[nt][mt][4 * q], acc[nt][mt][4 * q + 1], acc[nt][mt][4 * q + 2], acc[nt][mt][4 * q + 3]};
                *(f32x4*)(zp + nt * 32 + 8 * q + 4 * hi) = v;
            }
    }
}


DEVI void scan_wave_unit(const Params& p, int layer, int b, int g, int dir) {
    unsigned char* ws = ows(p);
    const float* ZS = (const float*)(ws + OFF_ZS);
    bf16_t* SP = (bf16_t*)(ws + OFF_SPREV);
    const f32x2* LT = (const f32x2*)(ws + OFF_S5 + layer * S5_LAYER + S5_LAMT);
    const int lane = otid() & 63;
    const f32x2 lt = LT[(dir * 32 + g) * 64 + lane];
    const long base = ((long)(b * 32 + g) * 256) * 256 + dir * 128 + lane;
    float sr = 0.f, si = 0.f;
    for (int cb = 0; cb < 16; ++cb) {
        float zr[16], zi[16];
#pragma unroll
        for (int i = 0; i < 16; ++i) {
            const int cc = cb * 16 + i, c = dir ? 255 - cc : cc;
            zr[i] = ZS[base + (long)c * 256]; zi[i] = ZS[base + (long)c * 256 + 64];
        }
#pragma unroll
        for (int i = 0; i < 16; ++i) {
            const int cc = cb * 16 + i, c = dir ? 255 - cc : cc;
            SP[base + (long)c * 256] = f2bf(sr); SP[base + (long)c * 256 + 64] = f2bf(si);
            const float nr = lt.x * sr - lt.y * si + zr[i], ni = lt.x * si + lt.y * sr + zi[i];
            sr = nr; si = ni;
        }
    }
}

DEVI void s5c_tile(const Params& p, int layer, int t, bf16_t* lds) {
    unsigned char* ws = ows(p);
    const bf16_t* P = (const bf16_t*)(ws + OFF_P);
    const bf16_t* SP = (const bf16_t*)(ws + OFF_SPREV);
    const bf16_t* Bt = (const bf16_t*)(ws + OFF_S5 + layer * S5_LAYER + S5_BT);
    bf16_t* ZB = (bf16_t*)(ws + OFF_ZB);
    const int lane = otid() & 63, wave = __builtin_amdgcn_readfirstlane(otid() >> 6), wn = wave & 1, wm = wave >> 1, l32 = lane & 31, hi = lane >> 5;
    {
        const int g = t >> 3, tm = (t >> 1) & 3, tn = t & 1;
        const int n0 = tn * 256, m0 = tm * 256;
        f32x16 acc[4][2];
        zero_acc<4, 2>(acc);
        gemm_kloop<4, 2>(acc, Bt + ((long)g * 512 + n0) * 768, 768, P + ((long)m0 * 32) * PW + CSU + g * 16, XS5{}, 512, lds);
        gemm_kloop<4, 2>(acc, Bt + ((long)g * 512 + n0) * 768 + 512, 768, SP + ((long)(((m0 >> 8) * 32 + g) * 256)) * 256, XRow{256}, 256, lds);
#pragma unroll
        for (int mt = 0; mt < 2; ++mt) {
            const int R = m0 + wm * 64 + mt * 32 + l32;
#pragma unroll
            for (int nt = 0; nt < 4; ++nt)
#pragma unroll
                for (int q = 0; q < 4; ++q) {
                    const int n = n0 + wn * 128 + nt * 32 + 8 * q + 4 * hi;
                    u32x2 w;
                    w.x = pk_bf16(gelu_tanh(acc[nt][mt][4 * q]), gelu_tanh(acc[nt][mt][4 * q + 1]));
                    w.y = pk_bf16(gelu_tanh(acc[nt][mt][4 * q + 2]), gelu_tanh(acc[nt][mt][4 * q + 3]));
                    *(u32x2*)(ZB + ((long)R * 32 + (n >> 4)) * 512 + g * 16 + (n & 15)) = w;
                }
        }
    }
}

DEVI void glu_tile(const Params& p, int layer, int t, bf16_t* lds) {
    unsigned char* ws = ows(p);
    bf16_t* P = (bf16_t*)(ws + OFF_P);
    const bf16_t* ZB = (const bf16_t*)(ws + OFF_ZB);
    const bf16_t* wt = (const bf16_t*)(ws + OFF_W + layer * W_LAYER + W_GLU);
    const int lane = otid() & 63, wave = __builtin_amdgcn_readfirstlane(otid() >> 6), wn = wave & 1, wm = wave >> 1, l32 = lane & 31, hi = lane >> 5;
    {
        const int tm = t >> 1, tn = t & 1;
        const int n0 = tn * 256, m0 = tm * 256;
        f32x16 acc[4][2];
        zero_acc<4, 2>(acc);
        gemm_kloop<4, 2>(acc, wt + (long)n0 * 512, 512, ZB + (long)m0 * 512, XRow{512}, 512, lds);
#pragma unroll
        for (int mt = 0; mt < 2; ++mt) {
            const int m = m0 + wm * 64 + mt * 32 + l32;
#pragma unroll
            for (int nt = 0; nt < 4; ++nt)
#pragma unroll
                for (int q = 0; q < 4; ++q) {
                    const int n = n0 + wn * 128 + nt * 32 + 8 * q + 4 * hi;
                    const u32x2 zz = *(const u32x2*)(ZB + (long)m * 512 + n);
                    const float z0 = bf2f(zz.x & 0xffffu), z1 = bf2f(zz.x >> 16), z2 = bf2f(zz.y & 0xffffu), z3 = bf2f(zz.y >> 16);
                    u32x2 w;
                    w.x = pk_bf16(z0 * sigmoidf_(acc[nt][mt][4 * q]), z1 * sigmoidf_(acc[nt][mt][4 * q + 1]));
                    w.y = pk_bf16(z2 * sigmoidf_(acc[nt][mt][4 * q + 2]), z3 * sigmoidf_(acc[nt][mt][4 * q + 3]));
                    *(u32x2*)(P + (long)m * PW + CSU + n) = w;
                }
        }
    }
}

DEVI int queue_grab(unsigned* ctr, volatile unsigned* slot, int tid) {
    asm volatile("s_waitcnt vmcnt(0)" ::: "memory");
    __syncthreads();
    if (tid == 0) *slot = __hip_atomic_fetch_add(ctr, 1u, __ATOMIC_RELAXED, __HIP_MEMORY_SCOPE_AGENT);
    __syncthreads();
    return (int)*slot;
}
DEVI void phase_mixers(const Params& p, int layer, bf16_t* lds) {
    unsigned char* ws = ows(p);
    unsigned* ctl = (unsigned*)(ws + OFF_CTL);
    unsigned* q = ctl + 64 + layer * 320;
    unsigned* done = ctl + 704 + layer * 64;
    volatile unsigned* slot = (volatile unsigned*)((unsigned char*)lds + LDS_BYTES - 16);
    const int tid = otid();
    const int wave = __builtin_amdgcn_readfirstlane(tid >> 6);
    const int xcd = (int)(__builtin_amdgcn_s_getreg((3 << 11) | 20) & 7u);
    int u;
    while ((u = queue_grab(q, slot, tid)) < 128) {
        const int g = u >> 2, b = u & 3;
        s5z_tile(p, layer, u, lds);
        asm volatile("s_waitcnt vmcnt(0)" ::: "memory");
        __syncthreads();
        __builtin_amdgcn_fence(__ATOMIC_ACQUIRE, "agent");
        if (wave < 2) scan_wave_unit(p, layer, b, g, wave);
        asm volatile("s_waitcnt vmcnt(0)" ::: "memory");
        __syncthreads();
        __builtin_amdgcn_fence(__ATOMIC_ACQUIRE, "agent");
        s5c_tile(p, layer, (g << 3) + (b << 1), lds);
        s5c_tile(p, layer, (g << 3) + (b << 1) + 1, lds);
        asm volatile("s_waitcnt vmcnt(0)" ::: "memory");
        __syncthreads();
        if (tid == 0) {
            __builtin_amdgcn_fence(__ATOMIC_RELEASE, "agent");
            asm volatile("s_waitcnt vmcnt(0)" ::: "memory");
            __hip_atomic_fetch_add(done + b * 16, 1u, __ATOMIC_RELAXED, __HIP_MEMORY_SCOPE_AGENT);
        }
    }
#pragma unroll 1
    for (int j8 = 0; j8 < 8; ++j8) {
        const int xs = (xcd + j8) & 7;
        while ((u = queue_grab(q + 16 * (1 + xs), slot, tid)) < 128)
            gqa_unit(p, layer, ((xs >> 1) << 8) | ((((xs & 1) << 2) | (u & 3)) << 5) | (u >> 2), lds);
    }
    while ((u = queue_grab(q + 16 * 9, slot, tid)) < 256) {
        const int b = u >> 6;
        if (tid == 0) {
            while (__hip_atomic_load(done + b * 16, __ATOMIC_RELAXED, __HIP_MEMORY_SCOPE_AGENT) < 32u) __builtin_amdgcn_s_sleep(8);
            __builtin_amdgcn_fence(__ATOMIC_ACQUIRE, "agent");
            asm volatile("s_waitcnt vmcnt(0)" ::: "memory");
        }
        __syncthreads();
        glu_tile(p, layer, u, lds);
    }
#pragma unroll 1
    for (int j8 = 0; j8 < 8; ++j8) {
        const int xs = (xcd + j8) & 7;
        while ((u = queue_grab(q + 16 * (10 + xs), slot, tid)) < 128)
            nat_block_unit(p, layer, ((xs >> 1) << 8) | (u << 1) | (xs & 1), lds);
    }
}

DEVI void phase_merge(const Params& p, int layer, bf16_t* lds) {
    unsigned char* ws = ows(p);
    const bf16_t* P = (const bf16_t*)(ws + OFF_P);
    const bf16_t* xb = (const bf16_t*)(ws + OFF_XB);
    const bf16_t* wg = (const bf16_t*)(ws + OFF_W + layer * W_LAYER + W_IN) + (long)PW * DM;
    const bf16_t* wbr = (const bf16_t*)(ws + OFF_W + layer * W_LAYER + W_BR);
    bf16_t* MG = (bf16_t*)(ws + OFF_MERGED);
    const int lane = otid() & 63, wave = __builtin_amdgcn_readfirstlane(otid() >> 6), wn = wave & 1, wm = wave >> 1, l32 = lane & 31, hi = lane >> 5;
    for (int t = vblock(); t < 8 * 128; t += gridDim.x) {
        const int tm = t >> 3, tn = t & 7;
        const int n0 = tn * 128, m0 = tm * 256;
        f32x16 mg[2][2];
        zero_acc<2, 2>(mg);
#pragma unroll 1
        for (int br = 0; br < 3; ++br) {
            const int bcol = (br == 0) ? CQ : (br == 1 ? CNQ : CSU);
            f32x16 acc[2][2];
            unsigned sg[2][2][8];
            zero_acc<2, 2>(acc);
            gemm_kloop<2, 2>(acc, wg + ((long)br * DM + n0) * DM, DM, xb + (long)m0 * DM, XRow{DM}, DM, lds);
#pragma unroll
            for (int nt = 0; nt < 2; ++nt)
#pragma unroll
                for (int mt = 0; mt < 2; ++mt)
#pragma unroll
                    for (int i = 0; i < 8; ++i) sg[nt][mt][i] = pk_bf16(sigmoidf_(acc[nt][mt][2 * i]), sigmoidf_(acc[nt][mt][2 * i + 1]));
            zero_acc<2, 2>(acc);
            gemm_kloop<2, 2>(acc, wbr + ((long)br * DM + n0) * 512, 512, P + (long)m0 * PW + bcol, XRow{PW}, 512, lds);
#pragma unroll
            for (int nt = 0; nt < 2; ++nt)
#pragma unroll
                for (int mt = 0; mt < 2; ++mt)
#pragma unroll
                    for (int i = 0; i < 8; ++i) {
                        mg[nt][mt][2 * i] += bf2f(sg[nt][mt][i] & 0xffffu) * acc[nt][mt][2 * i];
                        mg[nt][mt][2 * i + 1] += bf2f(sg[nt][mt][i] >> 16) * acc[nt][mt][2 * i + 1];
                    }
        }
        __syncthreads();
        bf16_t* wl = lds + wave * (64 * 72);
#pragma unroll
        for (int mt = 0; mt < 2; ++mt)
#pragma unroll
            for (int nt = 0; nt < 2; ++nt)
#pragma unroll
                for (int q = 0; q < 4; ++q) {
                    u32x2 w; w.x = pk_bf16(mg[nt][mt][4 * q], mg[nt][mt][4 * q + 1]); w.y = pk_bf16(mg[nt][mt][4 * q + 2], mg[nt][mt][4 * q + 3]);
                    *(u32x2*)(wl + (mt * 32 + l32) * 72 + nt * 32 + 8 * q + 4 * hi) = w;
                }
        wave_rows_out<2>(wl, MG + (long)(m0 + wm * 64) * DM + n0 + wn * 64, DM, lane);
    }
}

DEVI void phase_res_gemm_ln(const bf16_t* A, int K, const bf16_t* wt, float* out, bf16_t* xb, const float* gain, const float* bias,
                            f32x2* stats, unsigned* cnt, bf16_t* lds, bool rev = false) {
    const int tid = otid(), lane = tid & 63, wave = __builtin_amdgcn_readfirstlane(tid >> 6), wn = wave & 1, wm = wave >> 1, l32 = lane & 31, hi = lane >> 5;
    for (int t = vblock(); t < 4 * 128; t += gridDim.x) {
        const int tm = rev ? 127 - (t >> 2) : (t >> 2), tn = t & 3;
        const int n0 = tn * 256, m0 = tm * 256;
        f32x16 acc[4][2];
        zero_acc<4, 2>(acc);
        gemm_kloop<4, 2>(acc, wt + (long)n0 * K, K, A + (long)m0 * K, XRow{K}, K, lds);
#pragma unroll
        for (int mt = 0; mt < 2; ++mt) {
            const int m = m0 + wm * 64 + mt * 32 + l32;
            float s1 = 0.f, s2 = 0.f;
#pragma unroll
            for (int nt = 0; nt < 4; ++nt)
#pragma unroll
                for (int q = 0; q < 4; ++q) {
                    const long idx = (long)m * DM + n0 + wn * 128 + nt * 32 + 8 * q + 4 * hi;
                    const u32x2 rr = *(const u32x2*)(xb + idx);
                    const float r[4] = {bf2f(rr.x & 0xffffu), bf2f(rr.x >> 16), bf2f(rr.y & 0xffffu), bf2f(rr.y >> 16)};
#pragma unroll
                    for (int e = 0; e < 4; ++e) {
                        const float v = ALPHA * r[e] + acc[nt][mt][4 * q + e];
                        acc[nt][mt][4 * q + e] = v; s1 += v; s2 += v * v;
                    }
                }
            s1 += xhalf(s1); s2 += xhalf(s2);
            if (hi == 0) stats[(long)m * 8 + tn * 2 + wn] = (f32x2){s1, s2};
        }
        asm volatile("s_waitcnt vmcnt(0)" ::: "memory");
        __syncthreads();
        if (tid == 0) {
            __builtin_amdgcn_fence(__ATOMIC_RELEASE, "agent");
            asm volatile("s_waitcnt vmcnt(0)" ::: "memory");
            __hip_atomic_fetch_add(cnt + tm, 1u, __ATOMIC_RELAXED, __HIP_MEMORY_SCOPE_AGENT);
            while (__hip_atomic_load(cnt + tm, __ATOMIC_RELAXED, __HIP_MEMORY_SCOPE_AGENT) < 4u) __builtin_amdgcn_s_sleep(1);
            __builtin_amdgcn_fence(__ATOMIC_ACQUIRE, "agent");
            asm volatile("s_waitcnt vmcnt(0)" ::: "memory");
        }
        __syncthreads();
        float mu[2], rstd[2];
#pragma unroll
        for (int mt = 0; mt < 2; ++mt) {
            const int m = m0 + wm * 64 + mt * 32 + l32;
            float s1 = 0.f, s2 = 0.f;
#pragma unroll
            for (int j = 0; j < 8; ++j) { const f32x2 pj = *(const GAS f32x2*)(const GAS void*)(stats + (long)m * 8 + j); s1 += pj.x; s2 += pj.y; }
            mu[mt] = s1 * (1.0f / DM);
            const float var = fmaxf(s2 * (1.0f / DM) - mu[mt] * mu[mt], 0.f);
            rstd[mt] = rsqrtf(var + 1e-5f);
        }
#pragma unroll
        for (int nt = 0; nt < 4; ++nt) {
#pragma unroll
            for (int q = 0; q < 4; ++q) {
                const int n = n0 + wn * 128 + nt * 32 + 8 * q + 4 * hi;
                const f32x4 g4 = *(const GAS f32x4*)(const GAS float*)(gain + n), b4 = *(const GAS f32x4*)(const GAS float*)(bias + n);
#pragma unroll
                for (int mt = 0; mt < 2; ++mt) {
                    acc[nt][mt][4 * q] = (acc[nt][mt][4 * q] - mu[mt]) * rstd[mt] * g4.x + b4.x; acc[nt][mt][4 * q + 1] = (acc[nt][mt][4 * q + 1] - mu[mt]) * rstd[mt] * g4.y + b4.y;
                    acc[nt][mt][4 * q + 2] = (acc[nt][mt][4 * q + 2] - mu[mt]) * rstd[mt] * g4.z + b4.z; acc[nt][mt][4 * q + 3] = (acc[nt][mt][4 * q + 3] - mu[mt]) * rstd[mt] * g4.w + b4.w;
                }
            }
            __builtin_amdgcn_sched_barrier(0);
        }
        __builtin_amdgcn_sched_barrier(0);
        if (out) {
#pragma unroll
            for (int mt = 0; mt < 2; ++mt) {
                float* orow = out + (long)(m0 + wm * 64 + mt * 32 + l32) * DM + n0 + wn * 128 + 4 * hi;
#pragma unroll
                for (int nt = 0; nt < 4; ++nt)
#pragma unroll
                    for (int q = 0; q < 4; ++q)
                        *(f32x4*)(orow + nt * 32 + 8 * q) = (f32x4){acc[nt][mt][4 * q], acc[nt][mt][4 * q + 1], acc[nt][mt][4 * q + 2], acc[nt][mt][4 * q + 3]};
            }
        } else {
            bf16_t* wl = lds + wave * (64 * 136);
#pragma unroll
            for (int mt = 0; mt < 2; ++mt)
#pragma unroll
                for (int nt = 0; nt < 4; ++nt)
#pragma unroll
                    for (int q = 0; q < 4; ++q) {
                        u32x2 w; w.x = pk_bf16(acc[nt][mt][4 * q], acc[nt][mt][4 * q + 1]); w.y = pk_bf16(acc[nt][mt][4 * q + 2], acc[nt][mt][4 * q + 3]);
                        *(u32x2*)(wl + (mt * 32 + l32) * 136 + nt * 32 + 8 * q + 4 * hi) = w;
                    }
            wave_rows_out<4>(wl, xb + (long)(m0 + wm * 64) * DM + n0 + wn * 128, DM, lane);
        }
    }
}

DEVI void phase_ffn_up(const Params& p, int layer, bf16_t* lds) {
    unsigned char* ws = ows(p);
    const bf16_t* xb = (const bf16_t*)(ws + OFF_XB);
    const bf16_t* wt = (const bf16_t*)(ws + OFF_W + layer * W_LAYER + W_UP);
    bf16_t* H = (bf16_t*)(ws + OFF_H);
    const int lane = otid() & 63, wave = __builtin_amdgcn_readfirstlane(otid() >> 6), wn = wave & 1, wm = wave >> 1, l32 = lane & 31, hi = lane >> 5;
    for (int t = vblock(); t < 16 * 128; t += gridDim.x) {
        const int tm = t >> 4, tn = t & 15;
        const int n0 = tn * 256, m0 = tm * 256;
        f32x16 acc[4][2];
        zero_acc<4, 2>(acc);
        gemm_kloop<4, 2>(acc, wt + (long)n0 * DM, DM, xb + (long)m0 * DM, XRow{DM}, DM, lds);
        __syncthreads();
        bf16_t* wl = lds + wave * (64 * 136);
#pragma unroll
        for (int mt = 0; mt < 2; ++mt)
#pragma unroll
            for (int nt = 0; nt < 4; ++nt)
#pragma unroll
                for (int q = 0; q < 4; ++q) {
                    float v[4];
#pragma unroll
                    for (int e = 0; e < 4; ++e) { const float a = fmaxf(acc[nt][mt][4 * q + e], 0.f); v[e] = a * a; }
                    u32x2 w; w.x = pk_bf16(v[0], v[1]); w.y = pk_bf16(v[2], v[3]);
                    *(u32x2*)(wl + (mt * 32 + l32) * 136 + nt * 32 + 8 * q + 4 * hi) = w;
                }
        wave_rows_out<4>(wl, H + (long)(m0 + wm * 64) * FFN + n0 + wn * 128, FFN, lane);
    }
}

DEVI void phase_ln(const float* src, float* dst, bf16_t* xb, const float* gain, const float* bias) {
    const int lane = otid() & 63, wave = otid() >> 6;
    for (int row = blockIdx.x * NWAVES + wave; row < MTOK; row += gridDim.x * NWAVES) {
        const float* s = src + (long)row * DM;
        f32x4 v[4];
#pragma unroll
        for (int i = 0; i < 4; ++i) v[i] = *(const f32x4*)(s + i * 256 + lane * 4);
        float sum = 0.f;
#pragma unroll
        for (int i = 0; i < 4; ++i) sum += v[i].x + v[i].y + v[i].z + v[i].w;
#pragma unroll
        for (int o = 1; o < 64; o <<= 1) sum += __shfl_xor(sum, o);
        const float mu = sum * (1.0f / DM);
        float sq = 0.f;
#pragma unroll
        for (int i = 0; i < 4; ++i) { v[i].x -= mu; v[i].y -= mu; v[i].z -= mu; v[i].w -= mu; sq += v[i].x * v[i].x + v[i].y * v[i].y + v[i].z * v[i].z + v[i].w * v[i].w; }
#pragma unroll
        for (int o = 1; o < 64; o <<= 1) sq += __shfl_xor(sq, o);
        const float rstd = rsqrtf(sq * (1.0f / DM) + 1e-5f);
#pragma unroll
        for (int i = 0; i < 4; ++i) {
            const int c = i * 256 + lane * 4;
            const f32x4 g = *(const f32x4*)(gain + c), bb = *(const f32x4*)(bias + c);
            f32x4 y;
            y.x = v[i].x * rstd * g.x + bb.x; y.y = v[i].y * rstd * g.y + bb.y; y.z = v[i].z * rstd * g.z + bb.z; y.w = v[i].w * rstd * g.w + bb.w;
            *(f32x4*)(dst + (long)row * DM + c) = y;
            u32x2 w; w.x = pk_bf16(y.x, y.y); w.y = pk_bf16(y.z, y.w);
            *(u32x2*)(xb + (long)row * DM + c) = w;
        }
    }
}

DEVI void transpose_mat(const float* src, int K, int N, bf16_t* dst, float* tl) {
    const int tid = otid();
    const int tk = K / 64, tn = N / 64;
    for (int t = blockIdx.x; t < tk * tn; t += gridDim.x) {
        const int k0 = (t / tn) * 64, n0 = (t % tn) * 64;
        __syncthreads();
#pragma unroll
        for (int i = 0; i < 2; ++i) {
            const int e = tid + 512 * i, r = e >> 4, c4 = (e & 15) * 4;
            const f32x4 v = *(const f32x4*)(src + (long)(k0 + r) * N + n0 + c4);
            tl[r * 65 + c4] = v.x; tl[r * 65 + c4 + 1] = v.y; tl[r * 65 + c4 + 2] = v.z; tl[r * 65 + c4 + 3] = v.w;
        }
        __syncthreads();
#pragma unroll
        for (int i = 0; i < 1; ++i) {
            const int e = tid, n = e >> 3, kc = (e & 7) * 8;
            u32x4 w;
            w.x = pk_bf16(tl[(kc + 0) * 65 + n], tl[(kc + 1) * 65 + n]); w.y = pk_bf16(tl[(kc + 2) * 65 + n], tl[(kc + 3) * 65 + n]);
            w.z = pk_bf16(tl[(kc + 4) * 65 + n], tl[(kc + 5) * 65 + n]); w.w = pk_bf16(tl[(kc + 6) * 65 + n], tl[(kc + 7) * 65 + n]);
            *(u32x4*)(dst + (long)(n0 + n) * K + k0 + kc) = w;
        }
    }
}

struct Cx { float re, im; };
DEVI Cx cmul(Cx a, Cx b) { return {a.re * b.re - a.im * b.im, a.re * b.im + a.im * b.re}; }
DEVI Cx lam_pow(float are, float aim, float dt, float n) {
    const float mag = fexp2(are * dt * n * LOG2E);
    const float ph = (aim * dt) * n;
    return {mag * __cosf(ph), mag * __sinf(ph)};
}
DEVI Cx zoh_coef(float are, float aim, float dt) {
    const Cx lam = lam_pow(are, aim, dt, 1.0f);
    const float den = are * are + aim * aim, nr = lam.re - 1.0f;
    return {(nr * are + lam.im * aim) / den, (lam.im * are - nr * aim) / den};
}

DEVI void phase_prologue_a(const Params& p, bf16_t* lds) {
    unsigned char* ws = ows(p);
    float* tl = (float*)lds;
    const int tid = otid();
    const long gtid = (long)blockIdx.x * NTHREADS + tid, gsz = (long)gridDim.x * NTHREADS;
    {
        const float* x = p.in[0];
        bf16_t* xb = (bf16_t*)(ws + OFF_XB);
        for (long e = gtid; e < (long)MTOK * DM / 4; e += gsz) {
            const f32x4 v = *(const f32x4*)(x + e * 4);
            u32x2 w; w.x = pk_bf16(v.x, v.y); w.y = pk_bf16(v.z, v.w);
            *(u32x2*)(xb + e * 4) = w;
        }
    }
    for (int layer = 0; layer < 2; ++layer) {
        unsigned char* wl = ws + OFF_W + layer * W_LAYER;
        transpose_mat(p.in[1] + (long)layer * DM * INW, DM, INW, (bf16_t*)(wl + W_IN), tl);
        transpose_mat(p.in[13] + (long)layer * 512 * 512, 512, 512, (bf16_t*)(wl + W_GLU), tl);
        for (int br = 0; br < 3; ++br)
            transpose_mat(p.in[14] + ((long)layer * 3 + br) * 512 * DM, 512, DM, (bf16_t*)(wl + W_BR) + (long)br * DM * 512, tl);
        transpose_mat(p.in[15] + (long)layer * DM * DM, DM, DM, (bf16_t*)(wl + W_OUT), tl);
        transpose_mat(p.in[18] + (long)layer * DM * FFN, DM, FFN, (bf16_t*)(wl + W_UP), tl);
        transpose_mat(p.in[19] + (long)layer * FFN * DM, FFN, DM, (bf16_t*)(wl + W_DN), tl);

        unsigned char* sl = ws + OFF_S5 + layer * S5_LAYER;
        bf16_t* Bt = (bf16_t*)(sl + S5_BT);
        bf16_t* Zt = (bf16_t*)(sl + S5_ZT);
        float* KT = (float*)(sl + S5_KTAB);
        f32x2* LT = (f32x2*)(sl + S5_LAMT);
        const float* a_re = p.in[5] + layer * 2 * 32 * 64;
        const float* a_im = p.in[6] + layer * 2 * 32 * 64;
        const float* ldt = p.in[7] + layer * 2 * 32;
        const float* b_re = p.in[8] + (long)layer * 32 * 64 * 16;
        const float* b_im = p.in[9] + (long)layer * 32 * 64 * 16;
        const float* c_re = p.in[10] + (long)layer * 2 * 32 * 16 * 64;
        const float* c_im = p.in[11] + (long)layer * 2 * 32 * 16 * 64;
        for (long e = gtid; e < 2 * 32 * 64; e += gsz) {
            const int dg = (int)(e >> 6);
            const float dt = __expf(ldt[dg]);
            const Cx l = lam_pow(a_re[e], a_im[e], dt, 32.0f);
            LT[e] = (f32x2){l.re, l.im};
        }
        for (long e = gtid; e < 32 * 2 * 32 * 64; e += gsz) {
            const int pp = (int)(e & 63), jt = (int)((e >> 6) & 31), dir = (int)((e >> 11) & 1), g = (int)(e >> 12);
            const int ai = (dir * 32 + g) * 64 + pp;
            const float are = a_re[ai], aim = a_im[ai], dt = __expf(ldt[dir * 32 + g]);
            const Cx coef = zoh_coef(are, aim, dt);
            {
                const Cx w = cmul(lam_pow(are, aim, dt, (float)(dir == 0 ? 31 - jt : jt)), coef);
                bf16_t* zr = Zt + ((long)(g * 256 + dir * 128 + pp)) * 512 + jt * 16;
                bf16_t* zi = zr + 64 * 512;
#pragma unroll
                for (int h = 0; h < 16; ++h) {
                    const Cx bb = {b_re[(g * 64 + pp) * 16 + h], b_im[(g * 64 + pp) * 16 + h]};
                    const Cx wb = cmul(w, bb);
                    zr[h] = f2bf(wb.re); zi[h] = f2bf(wb.im);
                }
            }
            {
                const Cx lp = lam_pow(are, aim, dt, (float)(dir == 0 ? jt + 1 : 32 - jt));
#pragma unroll
                for (int h = 0; h < 16; ++h) {
                    const int ci = ((dir * 32 + g) * 16 + h) * 64 + pp;
                    const Cx c = cmul((Cx){c_re[ci], c_im[ci]}, lp);
                    bf16_t* bp = Bt + ((long)(g * 512 + jt * 16 + h)) * 768 + 512 + dir * 128 + pp;
                    bp[0] = f2bf(c.re); bp[64] = f2bf(-c.im);
                }
            }
        }
        for (int u = blockIdx.x; u < 2 * 32 * 32; u += gridDim.x) {
            const int tau = u & 31, g = (u >> 5) & 31, dir = u >> 10;
            __syncthreads();
            if (tid < 64) {
                const int ai = (dir * 32 + g) * 64 + tid;
                const float are = a_re[ai], aim = a_im[ai], dt = __expf(ldt[dir * 32 + g]);
                const Cx w = cmul(lam_pow(are, aim, dt, (float)tau), zoh_coef(are, aim, dt));
                tl[2 * tid] = w.re; tl[2 * tid + 1] = w.im;
            }
            __syncthreads();
            const int hp = (tid >> 4) & 15, h = tid & 15;
            float acc = 0.f;
            if (tid < 256)
            for (int pp = 0; pp < 64; ++pp) {
                const Cx w = {tl[2 * pp], tl[2 * pp + 1]};
                const Cx bb = {b_re[(g * 64 + pp) * 16 + h], b_im[(g * 64 + pp) * 16 + h]};
                const Cx wb = cmul(w, bb);
                const int ci = ((dir * 32 + g) * 16 + hp) * 64 + pp;
                acc += c_re[ci] * wb.re - c_im[ci] * wb.im;
            }
            if (tid < 256) KT[((long)((dir * 32 + g) * 32 + tau)) * 256 + tid] = acc;
        }
    }
}

DEVI void phase_prologue_b(const Params& p) {
    unsigned char* ws = ows(p);
    const long gtid = (long)blockIdx.x * NTHREADS + otid(), gsz = (long)gridDim.x * NTHREADS;
    for (int layer = 0; layer < 2; ++layer) {
        unsigned char* sl = ws + OFF_S5 + layer * S5_LAYER;
        bf16_t* Bt = (bf16_t*)(sl + S5_BT);
        const float* KT = (const float*)(sl + S5_KTAB);
        const float* dsk = p.in[12] + layer * 32 * 16;
        for (long e = gtid; e < 32L * 512 * 64; e += gsz) {
            const int kc = (int)(e & 63), n = (int)((e >> 6) & 511), g = (int)(e >> 15);
            const int j = kc >> 1, h0 = (kc & 1) * 8, t = n >> 4, hp = n & 15;
            float v[8];
            if (j < t) {
                const float* k = KT + ((long)((0 * 32 + g) * 32 + (t - j))) * 256 + hp * 16 + h0;
#pragma unroll
                for (int i = 0; i < 8; ++i) v[i] = k[i];
            } else if (j > t) {
                const float* k = KT + ((long)((1 * 32 + g) * 32 + (j - t))) * 256 + hp * 16 + h0;
#pragma unroll
                for (int i = 0; i < 8; ++i) v[i] = k[i];
            } else {
                const float* kf = KT + ((long)((0 * 32 + g) * 32)) * 256 + hp * 16 + h0;
                const float* kb = KT + ((long)((1 * 32 + g) * 32)) * 256 + hp * 16 + h0;
#pragma unroll
                for (int i = 0; i < 8; ++i) v[i] = kf[i] + kb[i] + ((h0 + i == hp) ? dsk[g * 16 + hp] : 0.f);
            }
            u32x4 w; w.x = pk_bf16(v[0], v[1]); w.y = pk_bf16(v[2], v[3]); w.z = pk_bf16(v[4], v[5]); w.w = pk_bf16(v[6], v[7]);
            *(u32x4*)(Bt + ((long)(g * 512 + n)) * 768 + kc * 8) = w;
        }
    }
}


DEVI void grid_barrier(unsigned* ctr, unsigned target) {
    asm volatile("s_waitcnt vmcnt(0) lgkmcnt(0)" ::: "memory");
    __syncthreads();
    if (threadIdx.x == 0) {
        __builtin_amdgcn_fence(__ATOMIC_RELEASE, "agent");
        asm volatile("s_waitcnt vmcnt(0)" ::: "memory");
        __hip_atomic_fetch_add(ctr, 1u, __ATOMIC_RELAXED, __HIP_MEMORY_SCOPE_AGENT);
        while (__hip_atomic_load(ctr, __ATOMIC_RELAXED, __HIP_MEMORY_SCOPE_AGENT) < target) __builtin_amdgcn_s_sleep(2);
        __builtin_amdgcn_fence(__ATOMIC_ACQUIRE, "agent");
        asm volatile("s_waitcnt vmcnt(0)" ::: "memory");
    }
    __syncthreads();
}

constexpr int PH_PER_LAYER = 6;
constexpr int N_PHASES = 2 + PH_PER_LAYER * 2;
__global__ void __launch_bounds__(NTHREADS, 2) fwd_kernel(Params p) {
    extern __shared__ __attribute__((aligned(16))) unsigned char lds_raw[];
    bf16_t* lds = (bf16_t*)lds_raw;
    unsigned char* ws = ows(p);
    for (int ph = p.ph_lo; ph < p.ph_hi; ++ph) {
        if (ph == 0) phase_prologue_a(p, lds);
        else if (ph == 1) phase_prologue_b(p);
        else {
            const int layer = (ph - 2) / PH_PER_LAYER, sub = (ph - 2) % PH_PER_LAYER;
            switch (sub) {
            case 0: phase_inproj(p, layer, lds); break;
            case 1: phase_mixers(p, layer, lds); break;
            case 2: phase_merge(p, layer, lds); break;
            case 3: phase_res_gemm_ln((const bf16_t*)(ws + OFF_MERGED), DM, (const bf16_t*)(ws + OFF_W + layer * W_LAYER + W_OUT), nullptr, (bf16_t*)(ws + OFF_XB),
                                      p.in[16] + layer * DM, p.in[17] + layer * DM, (f32x2*)(ws + OFF_STATS), (unsigned*)(ws + OFF_CTL) + 1024 + (layer * 2) * 128, lds); break;
            case 4: phase_ffn_up(p, layer, lds); break;
            default: phase_res_gemm_ln((const bf16_t*)(ws + OFF_H), FFN, (const bf16_t*)(ws + OFF_W + layer * W_LAYER + W_DN), layer == 1 ? p.out : nullptr, (bf16_t*)(ws + OFF_XB),
                                      p.in[20] + layer * DM, p.in[21] + layer * DM, (f32x2*)(ws + OFF_STATS), (unsigned*)(ws + OFF_CTL) + 1024 + (layer * 2 + 1) * 128, lds, true); break;
            }
        }
        if (ph + 1 < p.ph_hi) {
            if (ph == p.ph_lo) cg::this_grid().sync();
            else grid_barrier((unsigned*)(ws + OFF_CTL), (unsigned)(ph - p.ph_lo) * gridDim.x);
        }
    }
}

extern "C" void kernel_launch(void* const* d_in, const int* in_sizes, int n_in, void* d_out, int out_size, void* d_ws, size_t ws_size, hipStream_t stream) {
    static int grid = 0;
    if (grid == 0) {
        if (n_in != 22 || ws_size < WS_END) { fprintf(stderr, "kernel_launch: unexpected n_in %d / ws_size %zu\n", n_in, ws_size); grid = -1; return; }
        int dev = 0, cus = 0, per_cu = 0;
        hipGetDevice(&dev);
        hipDeviceGetAttribute(&cus, hipDeviceAttributeMultiprocessorCount, dev);
        hipFuncSetAttribute((const void*)fwd_kernel, hipFuncAttributeMaxDynamicSharedMemorySize, LDS_BYTES);
        hipOccupancyMaxActiveBlocksPerMultiprocessor(&per_cu, (const void*)fwd_kernel, NTHREADS, LDS_BYTES);
        if (per_cu < 1) per_cu = 1;
        if (per_cu > 1) per_cu = 1;
        grid = cus * per_cu;
        fprintf(stderr, "kernel_launch: grid %d (%d CUs x %d)\n", grid, cus, per_cu);
    }
    if (grid < 0) return;
    Params p{};
    for (int i = 0; i < 22; ++i) p.in[i] = (const float*)d_in[i];
    p.out = (float*)d_out; p.ws = (unsigned char*)d_ws;
#if SINGLE_LAUNCH
    hipMemsetAsync((unsigned char*)d_ws + OFF_CTL, 0, 8192, stream);
    p.ph_lo = 0; p.ph_hi = N_PHASES;
    void* args[] = {&p};
    hipError_t e = hipLaunchCooperativeKernel((const void*)fwd_kernel, dim3(grid), dim3(NTHREADS), args, LDS_BYTES, stream);
    if (e != hipSuccess) fprintf(stderr, "cooperative launch failed: %s (grid %d)\n", hipGetErrorString(e), grid);
#else
    for (int ph = 0; ph < N_PHASES; ++ph) {
        p.ph_lo = ph; p.ph_hi = ph + 1;
        hipLaunchKernelGGL(fwd_kernel, dim3(grid), dim3(NTHREADS), LDS_BYTES, stream, p);
    }
#endif
}
```

```cpp
#include <hip/hip_runtime.h>
#include <hip/hip_cooperative_groups.h>
#include <cstdio>
namespace cg = cooperative_groups;

#ifndef SINGLE_LAUNCH
#define SINGLE_LAUNCH 1
#endif

typedef unsigned short bf16_t;
typedef short bf16x8 __attribute__((ext_vector_type(8)));
typedef float f32x16 __attribute__((ext_vector_type(16)));
typedef float f32x4 __attribute__((ext_vector_type(4)));
typedef float f32x2 __attribute__((ext_vector_type(2)));
typedef unsigned u32x4 __attribute__((ext_vector_type(4)));
typedef unsigned u32x2 __attribute__((ext_vector_type(2)));
#define DEVI __device__ __forceinline__

constexpr int DM = 1024, SEQ = 8192, NB = 4, MTOK = NB * SEQ, FFN = 4096, INW = 5888;
constexpr int PW = 2816;
constexpr int CQ = 0, CK = 512, CNQ = 768, CNK = 1280, CSU = 2304;
constexpr float ALPHA = 1.4142135623730951f;
constexpr float LOG2E = 1.4426950408889634f;
constexpr int NTHREADS = 512, NWAVES = 8;
constexpr int LSTR = 72;
constexpr int LDS_BYTES = 2 * (256 + 256) * LSTR * 2;

constexpr size_t MiB = 1u << 20;
constexpr size_t OFF_P = 0, OFF_H = 0, OFF_ZB = 176 * MiB, OFF_MERGED = 176 * MiB, OFF_NVT = 208 * MiB, OFF_VT = 240 * MiB;
constexpr size_t OFF_ZS = 256 * MiB, OFF_SPREV = 288 * MiB;
constexpr size_t OFF_W = 304 * MiB, W_LAYER = 34 * MiB;
constexpr size_t W_IN = 0, W_GLU = 12 * MiB, W_BR = 13 * MiB, W_OUT = 16 * MiB, W_UP = 18 * MiB, W_DN = 26 * MiB;
constexpr size_t OFF_S5 = 372 * MiB, S5_LAYER = 35 * MiB;
constexpr size_t S5_BT = 0, S5_ZT = 24 * MiB, S5_KTAB = 32 * MiB, S5_LAMT = 34 * MiB;
constexpr size_t OFF_XB = 442 * MiB;
constexpr size_t OFF_CTL = 506 * MiB;
constexpr size_t OFF_STATS = 507 * MiB;
constexpr size_t WS_END = 509 * MiB;

struct Params {
    const float* in[22];
    float* out;
    unsigned char* ws;
    int ph_lo, ph_hi;
};

DEVI unsigned char* ows(const Params& p) { unsigned char* w = p.ws; asm volatile("" : "+s"(w)); return w; }
#define GAS __attribute__((address_space(1)))
DEVI u32x4 gld16(const void* p) { return *(const GAS u32x4*)(const GAS char*)p; }
DEVI bf16x8 gld16b(const void* p) { return *(const GAS bf16x8*)(const GAS char*)p; }
DEVI void gst8(void* base, unsigned off, u32x2 v) { *(GAS u32x2*)((GAS char*)base + off) = v; }
DEVI void gst2(void* base, unsigned off, bf16_t v) { *(GAS bf16_t*)((GAS char*)base + off) = v; }
DEVI int otid() { int t = threadIdx.x; asm volatile("" : "+v"(t)); return t; }
typedef __bf16 bf16x2_t __attribute__((ext_vector_type(2)));
DEVI unsigned pk_bf16_m(float lo, float hi) { const f32x2 v = {lo, hi}; const bf16x2_t b = __builtin_convertvector(v, bf16x2_t); return __builtin_bit_cast(unsigned, b); }
DEVI unsigned pk_bf16(float lo, float hi) { unsigned r; asm("v_cvt_pk_bf16_f32 %0, %1, %2" : "=v"(r) : "v"(lo), "v"(hi)); return r; }
DEVI bf16_t f2bf(float f) { return (bf16_t)(pk_bf16(f, 0.f) & 0xffffu); }
DEVI float bf2f(unsigned v) { return __uint_as_float(v << 16); }
DEVI float fexp2(float x) { return __builtin_amdgcn_exp2f(x); }
DEVI float sigmoidf_(float x) { return 1.0f / (1.0f + fexp2(-x * LOG2E)); }
DEVI float gelu_tanh(float y) {
    const float u = 0.7978845608028654f * (y + 0.044715f * y * y * y);
    return y * sigmoidf_(2.0f * u);
}
DEVI f32x16 mfma32(bf16x8 a, bf16x8 b, f32x16 c) { return __builtin_amdgcn_mfma_f32_32x32x16_bf16(a, b, c, 0, 0, 0); }
DEVI float xhalf(float v) { return __shfl_xor(v, 32); }

#define LAS __attribute__((address_space(3)))
#define SB() __builtin_amdgcn_sched_barrier(0)
template <int NT, int MT, class XF>
DEVI void gemm_kloop(f32x16 (&acc)[NT][MT], const bf16_t* wbase, int ldw, const bf16_t* xbase, const XF& xf, int K, bf16_t* lds) {
    const int tid = otid(), lane = tid & 63;
    const int wave = __builtin_amdgcn_readfirstlane(tid >> 6);
    const int wn = wave & 1, wm = wave >> 1, l32 = lane & 31, hi = lane >> 5;
    constexpr int WR = 64 * NT, XR = 128 * MT, WI = WR / 64, XI = XR / 64, STAGE = (WR + XR) * 64, NP = WI + XI;
    const int nk = K >> 6;
    const int lrow = wave * 8 + (lane >> 3);
    const int lc = ((lane & 7) ^ ((lrow >> 1) & 7)) * 8;
    const unsigned woff0 = ((unsigned)lrow * (unsigned)ldw + (unsigned)lc) * 2u;
    const unsigned wstep = 64u * (unsigned)ldw * 2u;
    unsigned xoff[XI];
#pragma unroll
    for (int j = 0; j < XI; ++j) xoff[j] = xf.off((unsigned)(lrow + 64 * j), (unsigned)lc) * 2u;
    const GAS char* wp = (const GAS char*)wbase;
    const GAS char* xp = (const GAS char*)xbase;
    const unsigned xstep = (unsigned)xf.kstep() * 2u;
    LAS bf16_t* L = (LAS bf16_t*)lds;
    const int sw = (l32 >> 1) & 7;
    int koff[4];
#pragma unroll
    for (int kk = 0; kk < 4; ++kk) koff[kk] = ((kk * 2 + hi) ^ sw) * 8;
#define GEMM_PIECE(bufi, pi) do { \
        LAS bf16_t* _d = L + (bufi) * STAGE + wave * 8 * 64; \
        if ((pi) < WI) __builtin_amdgcn_global_load_lds((const GAS unsigned*)(wp + woff0 + (pi) * wstep), (LAS unsigned*)(_d + (pi) * 64 * 64), 16, 0, 0); \
        else if ((pi) < NP) __builtin_amdgcn_global_load_lds((const GAS unsigned*)(xp + xoff[((pi) - WI) < XI ? ((pi) - WI) : 0]), (LAS unsigned*)(_d + (WR + ((pi) - WI) * 64) * 64), 16, 0, 0); \
    } while (0)
#define GEMM_RFR(set, kk) do { \
        _Pragma("unroll") for (int mt = 0; mt < MT; ++mt) fb[set][mt] = *(const LAS bf16x8*)(xsb + mt * 32 * 64 + koff[kk]); \
        _Pragma("unroll") for (int nt = 0; nt < NT; ++nt) fa[set][nt] = *(const LAS bf16x8*)(wsb + nt * 32 * 64 + koff[kk]); \
    } while (0)
#define GEMM_MMA(set, nlo, nhi) do { \
        __builtin_amdgcn_s_setprio(1); \
        _Pragma("unroll") for (int nt = (nlo); nt < (nhi); ++nt) \
        _Pragma("unroll") for (int mt = 0; mt < MT; ++mt) acc[nt][mt] = mfma32(fa[set][nt], fb[set][mt], acc[nt][mt]); \
        __builtin_amdgcn_s_setprio(0); \
    } while (0)
    asm volatile("s_waitcnt vmcnt(0)" ::: "memory");
    __builtin_amdgcn_s_barrier();
#pragma unroll
    for (int pi = 0; pi < NP; ++pi) GEMM_PIECE(0, pi);
#pragma unroll 1
    for (int kt = 0; kt < nk; ++kt) {
        const int buf = kt & 1;
        const bool more = (kt + 1 < nk);
        asm volatile("s_waitcnt vmcnt(0) lgkmcnt(0)" ::: "memory");
        __builtin_amdgcn_s_barrier();
        const LAS bf16_t* wsb = L + buf * STAGE + (wn * 32 * NT + l32) * 64;
        const LAS bf16_t* xsb = L + buf * STAGE + (WR + wm * 32 * MT + l32) * 64;
        bf16x8 fa[2][NT], fb[2][MT];
        GEMM_RFR(0, 0);
        SB();
        if (more) { wp += 128; xp += xstep; }
#pragma unroll
        for (int kk = 0; kk < 4; ++kk) {
            if (kk < 3) { GEMM_RFR((kk + 1) & 1, kk + 1); }
            SB();
            if (more && kk < 2) { GEMM_PIECE(buf ^ 1, 4 * kk); GEMM_PIECE(buf ^ 1, 4 * kk + 1); }
            SB();
            GEMM_MMA(kk & 1, 0, NT / 2);
            SB();
            if (more && kk < 2) { GEMM_PIECE(buf ^ 1, 4 * kk + 2); GEMM_PIECE(buf ^ 1, 4 * kk + 3); }
            SB();
            GEMM_MMA(kk & 1, NT / 2, NT);
            SB();
        }
    }
#undef GEMM_PIECE
#undef GEMM_RFR
#undef GEMM_MMA
}

template <int NT, int MT> DEVI void zero_acc(f32x16 (&acc)[NT][MT]) {
#pragma unroll
    for (int nt = 0; nt < NT; ++nt)
#pragma unroll
        for (int mt = 0; mt < MT; ++mt)
#pragma unroll
            for (int i = 0; i < 16; ++i) acc[nt][mt][i] = 0.f;
}
DEVI int vblock() { const int G = gridDim.x, b = blockIdx.x; return (G % 8 == 0) ? (b % 8) * (G / 8) + b / 8 : b; }

struct XRow {
    int ld;
    DEVI unsigned off(unsigned r, unsigned kc) const { return r * (unsigned)ld + kc; }
    DEVI int kstep() const { return 64; }
};
struct XS5 {
    DEVI unsigned off(unsigned r, unsigned kc) const { return (r * 32u + (kc >> 4)) * (unsigned)PW + (kc & 15u); }
    DEVI int kstep() const { return 4 * PW; }
};


template <int NT> DEVI void wave_rows_out(const bf16_t* wl, bf16_t* gbase, long ld, int lane) {
    constexpr int RS = NT * 32 + 8, CPR = NT * 4, RPI = 64 / CPR;
    asm volatile("s_waitcnt lgkmcnt(0)" ::: "memory");
    const bf16_t* lp = wl + (lane / CPR) * RS + (lane % CPR) * 8;
    const unsigned loff = ((unsigned)(lane / CPR) * (unsigned)ld + (unsigned)(lane % CPR) * 8u) * 2u;
    GAS char* gp = (GAS char*)gbase;
    const unsigned gstep = (unsigned)RPI * (unsigned)ld * 2u;
#pragma unroll 4
    for (int j = 0; j < NT * 4; ++j) {
        const u32x4 v = *(const u32x4*)(lp);
        *(GAS u32x4*)(gp + loff) = v;
        gp += gstep; lp += RPI * RS;
    }
}

DEVI void phase_inproj(const Params& p, int layer, bf16_t* lds) {
    unsigned char* ws = ows(p);
    const bf16_t* xb = (const bf16_t*)(ws + OFF_XB);
    const bf16_t* wt = (const bf16_t*)(ws + OFF_W + layer * W_LAYER + W_IN);
    bf16_t* P = (bf16_t*)(ws + OFF_P);
    bf16_t* VT = (bf16_t*)(ws + OFF_VT);
    bf16_t* NVT = (bf16_t*)(ws + OFF_NVT);
    const float* qg = p.in[2] + layer * 64;
    const float* kg = p.in[3] + layer * 64;
    const int tid0 = otid();
    const int wave = __builtin_amdgcn_readfirstlane(tid0 >> 6), wn = wave & 1, wm = wave >> 1;
    constexpr int NT_N = PW / 256, NT_M = MTOK / 256;
    for (int t = vblock(); t < NT_N * NT_M; t += gridDim.x) {
        const int tm = t / NT_N, tn = t % NT_N;
        const int n0 = tn * 256, m0 = tm * 256;
        f32x16 acc[4][2];
        zero_acc<4, 2>(acc);
        gemm_kloop<4, 2>(acc, wt + (long)n0 * DM, DM, xb + (long)m0 * DM, XRow{DM}, DM, lds);
        __syncthreads();
        bf16_t* wl = lds + wave * (64 * 136);
        int lane = tid0 & 63; asm volatile("" : "+v"(lane));
        const int l32 = lane & 31, hi = lane >> 5;
        const int nbw = n0 + wn * 128;
        const int mw = m0 + wm * 64;
        bf16_t* pbase = P + (long)mw * PW + nbw;
        if (nbw < 640) {
            const float* gain = (nbw < 512) ? qg : kg;
#pragma unroll
            for (int hp = 0; hp < 2; ++hp)
#pragma unroll
            for (int mt = 0; mt < 2; ++mt) {
                const int tpos = (mw + mt * 32 + l32) & (SEQ - 1);
                float ss = 0.f;
#pragma unroll
                for (int nt = 0; nt < 2; ++nt)
#pragma unroll
                    for (int i = 0; i < 16; ++i) ss += acc[2 * hp + nt][mt][i] * acc[2 * hp + nt][mt][i];
                ss += xhalf(ss);
                const float rs = rsqrtf(ss * (1.0f / 64.0f) + 1e-6f) * ((nbw < 512) ? 0.125f * LOG2E : 1.0f);
#pragma unroll
                for (int nt = 0; nt < 2; ++nt) {
                    const float pos = (float)(nt == 0 ? (tpos >> 6) : (tpos & 63));
                    float v[16];
#pragma unroll
                    for (int q = 0; q < 4; ++q) {
                        const f32x4 g4 = *(const GAS f32x4*)(const GAS float*)(gain + nt * 32 + 8 * q + 4 * hi);
                        v[4 * q] = acc[2 * hp + nt][mt][4 * q] * rs * g4.x; v[4 * q + 1] = acc[2 * hp + nt][mt][4 * q + 1] * rs * g4.y;
                        v[4 * q + 2] = acc[2 * hp + nt][mt][4 * q + 2] * rs * g4.z; v[4 * q + 3] = acc[2 * hp + nt][mt][4 * q + 3] * rs * g4.w;
                    }
#pragma unroll
                    for (int i = 0; i < 8; ++i) {
                        const int j = 8 * (i >> 2) + 4 * hi + (i & 3);
                        const float inv = fexp2(-(float)j * 0.8304820237218406f);
                        const float ang = pos * inv;
                        const float c = __cosf(ang), sn = __sinf(ang);
                        const float x1 = v[i], x2 = v[i + 8];
                        v[i] = x1 * c - x2 * sn;
                        v[i + 8] = x2 * c + x1 * sn;
                    }
#pragma unroll
                    for (int q = 0; q < 4; ++q) {
                        u32x2 w; w.x = pk_bf16(v[4 * q], v[4 * q + 1]); w.y = pk_bf16(v[4 * q + 2], v[4 * q + 3]);
                        *(u32x2*)(wl + (mt * 32 + l32) * 136 + hp * 64 + nt * 32 + 8 * q + 4 * hi) = w;
                    }
                    __builtin_amdgcn_sched_barrier(0);
                }
            }
            wave_rows_out<4>(wl, pbase, PW, lane);
        } else if (nbw == 640 || (nbw >= 1792 && nbw < 2304)) {
            const int b = mw >> 13, tpos0 = mw & (SEQ - 1);
            bf16_t* base = (nbw == 640) ? VT + ((long)(b * 2) * 64) * SEQ + tpos0 : NVT + ((long)(b * 8 + ((nbw - 1792) >> 6)) * 64) * SEQ + tpos0;
            const unsigned voff = (unsigned)(4 * hi * SEQ + l32) * 2u;
#pragma unroll
            for (int mt = 0; mt < 2; ++mt)
#pragma unroll
                for (int nt = 0; nt < 4; ++nt)
#pragma unroll
                    for (int i = 0; i < 16; ++i)
                        gst2(base, voff + (unsigned)(((nt * 32 + 8 * (i >> 2) + (i & 3)) * SEQ + mt * 32) * 2), f2bf(acc[nt][mt][i]));
        } else {
#pragma unroll
            for (int mt = 0; mt < 2; ++mt)
#pragma unroll
                for (int nt = 0; nt < 4; ++nt)
#pragma unroll
                    for (int q = 0; q < 4; ++q) {
                        u32x2 w; w.x = pk_bf16(acc[nt][mt][4 * q], acc[nt][mt][4 * q + 1]); w.y = pk_bf16(acc[nt][mt][4 * q + 2], acc[nt][mt][4 * q + 3]);
                        *(u32x2*)(wl + (mt * 32 + l32) * 136 + nt * 32 + 8 * q + 4 * hi) = w;
                    }
            wave_rows_out<4>(wl, pbase, PW, lane);
        }
    }
}

DEVI void online_softmax(f32x16 (&s)[2], f32x16 (&o)[2], float& mrun, float& lrun, bf16x8 (&pb)[2][2]) {
    float mx = s[0][0];
#pragma unroll
    for (int kt = 0; kt < 2; ++kt)
#pragma unroll
        for (int i = 0; i < 16; ++i) mx = fmaxf(mx, s[kt][i]);
    mx = fmaxf(mx, xhalf(mx));
    const float mnew = fmaxf(mrun, mx);
    const float alpha = fexp2(mrun - mnew);
    mrun = mnew;
    float ps = 0.f;
#pragma unroll
    for (int kt = 0; kt < 2; ++kt)
#pragma unroll
        for (int i = 0; i < 16; ++i) { const float e = fexp2(s[kt][i] - mnew); s[kt][i] = e; ps += e; }
    lrun = lrun * alpha + ps;
#pragma unroll
    for (int dt = 0; dt < 2; ++dt)
#pragma unroll
        for (int i = 0; i < 16; ++i) o[dt][i] *= alpha;
#pragma unroll
    for (int kt = 0; kt < 2; ++kt)
#pragma unroll
        for (int sl = 0; sl < 2; ++sl) {
            u32x4 w;
            w.x = pk_bf16_m(s[kt][8 * sl + 0], s[kt][8 * sl + 1]); w.y = pk_bf16_m(s[kt][8 * sl + 2], s[kt][8 * sl + 3]);
            w.z = pk_bf16_m(s[kt][8 * sl + 4], s[kt][8 * sl + 5]); w.w = pk_bf16_m(s[kt][8 * sl + 6], s[kt][8 * sl + 7]);
            pb[kt][sl] = __builtin_bit_cast(bf16x8, w);
        }
}
DEVI int kperm(int r) { return (r & 16) + 8 * ((r >> 2) & 1) + 4 * ((r >> 3) & 1) + (r & 3); }

DEVI void gqa_unit(const Params& p, int layer, int unit, bf16_t* lds) {
    unsigned char* ws = ows(p);
    bf16_t* P = (bf16_t*)(ws + OFF_P);
    const bf16_t* VT = (const bf16_t*)(ws + OFF_VT);
    const int tid = otid(), lane = tid & 63, wave = tid >> 6, l32 = lane & 31, hi = lane >> 5;
    const int qb = unit & 31, h = (unit >> 5) & 7, b = unit >> 8, kvh = h >> 2;
    const int qrow = qb * 256 + wave * 32 + l32;
    bf16_t* Ks = lds;
    bf16_t* Vs = lds + 2 * 64 * LSTR;
    bf16x8 qf[4];
    {
        const bf16_t* qp = P + ((long)(b * SEQ + qrow)) * PW + CQ + h * 64 + hi * 8;
#pragma unroll
        for (int kk = 0; kk < 4; ++kk) qf[kk] = *(const bf16x8*)(qp + kk * 16);
    }
    float mb;
    {
        float gq = fabsf(p.in[2][layer * 64 + lane]), gk = fabsf(p.in[3][layer * 64 + lane]);
#pragma unroll
        for (int o2 = 1; o2 < 64; o2 <<= 1) { gq = fmaxf(gq, __shfl_xor(gq, o2)); gk = fmaxf(gk, __shfl_xor(gk, o2)); }
        mb = 8.0f * gq * gk * LOG2E * 1.01f;
    }
    const bf16_t* kbase = P + ((long)b * SEQ) * PW + CK + kvh * 64;
    const bf16_t* vbase = VT + ((long)(b * 2 + kvh) * 64) * SEQ;
    f32x16 o[2];
#pragma unroll
    for (int dt = 0; dt < 2; ++dt)
#pragma unroll
        for (int i = 0; i < 16; ++i) o[dt][i] = 0.f;
    float lrun = 0.f;
    u32x4 kreg[1], vreg[1];
#pragma unroll
    for (int i = 0; i < 1; ++i) {
        const int c = tid, r = c >> 3, cc = (c & 7) * 8;
        kreg[i] = gld16(kbase + (long)r * PW + cc);
        vreg[i] = gld16(vbase + (long)r * SEQ + cc);
    }
#pragma unroll
    for (int i = 0; i < 1; ++i) {
        const int c = tid, r = c >> 3, cc = (c & 7) * 8;
        *(u32x4*)(Ks + r * LSTR + cc) = kreg[i];
        *(u32x4*)(Vs + r * LSTR + cc) = vreg[i];
    }
    __syncthreads();
    const int kr = kperm(l32);
    for (int kt0 = 0; kt0 < SEQ / 64; ++kt0) {
        const int buf = kt0 & 1;
        const bool more = (kt0 + 1 < SEQ / 64);
        if (more) {
            const int key0 = (kt0 + 1) * 64;
#pragma unroll
            for (int i = 0; i < 1; ++i) {
                const int c = tid, r = c >> 3, cc = (c & 7) * 8;
                kreg[i] = gld16(kbase + (long)(key0 + r) * PW + cc);
                vreg[i] = gld16(vbase + (long)r * SEQ + key0 + cc);
            }
        }
        f32x16 s[2];
        bf16x8 kf[2][4], vf[2][2][2];
#pragma unroll
        for (int kt = 0; kt < 2; ++kt) {
            const bf16_t* kp = Ks + (buf * 64 + kt * 32 + kr) * LSTR + hi * 8;
#pragma unroll
            for (int kk = 0; kk < 4; ++kk) kf[kt][kk] = *(const bf16x8*)(kp + kk * 16);
        }
#pragma unroll
        for (int dt = 0; dt < 2; ++dt) {
            const bf16_t* vp = Vs + (buf * 64 + dt * 32 + l32) * LSTR + hi * 8;
#pragma unroll
            for (int kt = 0; kt < 2; ++kt)
#pragma unroll
                for (int sl = 0; sl < 2; ++sl) vf[dt][kt][sl] = *(const bf16x8*)(vp + kt * 32 + sl * 16);
        }
        __builtin_amdgcn_sched_barrier(0);
        __builtin_amdgcn_s_setprio(1);
#pragma unroll
        for (int kt = 0; kt < 2; ++kt) {
#pragma unroll
            for (int i = 0; i < 16; ++i) s[kt][i] = -mb;
#pragma unroll
            for (int kk = 0; kk < 4; ++kk) s[kt] = mfma32(kf[kt][kk], qf[kk], s[kt]);
        }
        __builtin_amdgcn_s_setprio(0);
        bf16x8 pb[2][2];
#pragma unroll
        for (int kt = 0; kt < 2; ++kt) {
#pragma unroll
            for (int i = 0; i < 16; ++i) { const float e = fexp2(s[kt][i]); s[kt][i] = e; lrun += e; }
#pragma unroll
            for (int sl = 0; sl < 2; ++sl) {
                u32x4 w;
                w.x = pk_bf16_m(s[kt][8 * sl + 0], s[kt][8 * sl + 1]); w.y = pk_bf16_m(s[kt][8 * sl + 2], s[kt][8 * sl + 3]);
                w.z = pk_bf16_m(s[kt][8 * sl + 4], s[kt][8 * sl + 5]); w.w = pk_bf16_m(s[kt][8 * sl + 6], s[kt][8 * sl + 7]);
                pb[kt][sl] = __builtin_bit_cast(bf16x8, w);
            }
        }
#pragma unroll
        for (int dt = 0; dt < 2; ++dt)
#pragma unroll
            for (int kt = 0; kt < 2; ++kt)
#pragma unroll
                for (int sl = 0; sl < 2; ++sl) o[dt] = mfma32(vf[dt][kt][sl], pb[kt][sl], o[dt]);
        if (more) {
            const int nb = buf ^ 1;
#pragma unroll
            for (int i = 0; i < 1; ++i) {
                const int c = tid, r = c >> 3, cc = (c & 7) * 8;
                *(u32x4*)(Ks + (nb * 64 + r) * LSTR + cc) = kreg[i];
                *(u32x4*)(Vs + (nb * 64 + r) * LSTR + cc) = vreg[i];
            }
        }
        __syncthreads();
    }
    lrun += xhalf(lrun);
    const float inv = 1.0f / lrun;
    bf16_t* op = P + ((long)(b * SEQ + qrow)) * PW + CQ + h * 64;
#pragma unroll
    for (int dt = 0; dt < 2; ++dt)
#pragma unroll
        for (int q = 0; q < 4; ++q) {
            u32x2 w; w.x = pk_bf16(o[dt][4 * q] * inv, o[dt][4 * q + 1] * inv); w.y = pk_bf16(o[dt][4 * q + 2] * inv, o[dt][4 * q + 3] * inv);
            *(u32x2*)(op + dt * 32 + 8 * q + 4 * hi) = w;
        }
}

DEVI void nat_block_unit(const Params& p, int layer, int unit, bf16_t* lds) {
    unsigned char* ws = ows(p);
    bf16_t* P = (bf16_t*)(ws + OFF_P);
    const bf16_t* NVT = (const bf16_t*)(ws + OFF_NVT);
    const float* bias = p.in[4] + (long)layer * 8 * 15 * 31;
    const int tid = otid(), lane = tid & 63, wave = __builtin_amdgcn_readfirstlane(tid >> 6), l32 = lane & 31, hi = lane >> 5;
    const int wu = unit * NWAVES + wave;
    const int qt = wu & 1, h = (wu >> 1) & 7, r = (wu >> 4) & 127, b = wu >> 11;
    const int h0 = (unit * 4) & 7;
    float* bl = (float*)lds;
    for (int e = tid; e < 4 * 465; e += NTHREADS) bl[e] = bias[h0 * 465 + e];
    __syncthreads();
    const float* bh = bl + (h - h0) * 465;
    int rs = r - 4; rs = rs < 0 ? 0 : (rs > 120 ? 120 : rs);
    const int qc = qt * 32 + l32;
    int cs = qc - 8; cs = cs < 0 ? 0 : (cs > 48 ? 48 : cs);
    const long tok0 = (long)b * SEQ;
    bf16x8 qf[4];
    {
        const bf16_t* qp = P + (tok0 + r * 64 + qc) * PW + CNQ + h * 64 + hi * 8;
#pragma unroll
        for (int kk = 0; kk < 4; ++kk) qf[kk] = gld16b(qp + kk * 16);
    }
    f32x16 o[2];
#pragma unroll
    for (int dt = 0; dt < 2; ++dt)
#pragma unroll
        for (int i = 0; i < 16; ++i) o[dt][i] = 0.f;
    float mrun = -INFINITY, lrun = 0.f;
    const int kr = kperm(l32);
    constexpr float C = 0.125f * LOG2E;
    const bf16_t* kbase = P + (tok0 + kr) * PW + CNK + h * 64 + hi * 8;
    const bf16_t* vbase = NVT + ((long)(b * 8 + h) * 64 + l32) * SEQ + hi * 8;
    bf16_t* wl = (bf16_t*)((unsigned char*)lds + 8192) + wave * (64 * LSTR);
    const int srow = lane >> 3, scol = (lane & 7) * 8;
    const bf16_t* kg = P + (tok0 + srow) * PW + CNK + h * 64 + scol;
    const bf16_t* vg = NVT + ((long)(b * 8 + h) * 64 + srow) * SEQ + scol;
    u32x4 kst[8], vst[8];
#define NAT_LOADK(krow) do { _Pragma("unroll") for (int i = 0; i < 8; ++i) kst[i] = gld16(kg + (long)((krow) * 64 + 8 * i) * PW); } while (0)
#define NAT_LOADV(krow) do { _Pragma("unroll") for (int i = 0; i < 8; ++i) vst[i] = gld16(vg + (long)(8 * i) * SEQ + (krow) * 64); } while (0)
    NAT_LOADK(rs);
    NAT_LOADV(rs);
#pragma unroll 1
    for (int ir = 0; ir < 8; ++ir) {
        const int krow = rs + ir;
        const int nrow = (ir < 7) ? krow + 1 : krow;
        const float* brow = bh + (krow - r + 7) * 31 + 15 - qc;
        bf16x8 kf[2][4], vf[2][2][2];
#pragma unroll
        for (int i = 0; i < 8; ++i) *(u32x4*)(wl + (srow + 8 * i) * LSTR + scol) = kst[i];
        __builtin_amdgcn_sched_barrier(0);
#pragma unroll
        for (int kt = 0; kt < 2; ++kt)
#pragma unroll
            for (int kk = 0; kk < 4; ++kk) kf[kt][kk] = *(const bf16x8*)(wl + (kt * 32 + kr) * LSTR + hi * 8 + kk * 16);
        __builtin_amdgcn_sched_barrier(0);
        NAT_LOADK(nrow);
        f32x16 s[2];
#pragma unroll
        for (int kt = 0; kt < 2; ++kt) {
#pragma unroll
            for (int i = 0; i < 16; ++i) s[kt][i] = 0.f;
#pragma unroll
            for (int kk = 0; kk < 4; ++kk) s[kt] = mfma32(kf[kt][kk], qf[kk], s[kt]);
        }
        __builtin_amdgcn_sched_barrier(0);
#pragma unroll
        for (int i = 0; i < 8; ++i) *(u32x4*)(wl + (srow + 8 * i) * LSTR + scol) = vst[i];
        __builtin_amdgcn_sched_barrier(0);
#pragma unroll
        for (int dt = 0; dt < 2; ++dt)
#pragma unroll
            for (int kt = 0; kt < 2; ++kt)
#pragma unroll
                for (int sl = 0; sl < 2; ++sl) vf[dt][kt][sl] = *(const bf16x8*)(wl + (dt * 32 + l32) * LSTR + hi * 8 + kt * 32 + sl * 16);
        __builtin_amdgcn_sched_barrier(0);
        NAT_LOADV(nrow);
        float mx = -INFINITY;
#pragma unroll
        for (int g4 = 0; g4 < 4; ++g4) {
            const int kt = g4 >> 1, sl = g4 & 1;
            const bool dead = (g4 == 3 && qt == 0) || (g4 == 0 && qt == 1);
            if (!dead) {
#pragma unroll
                for (int e = 0; e < 8; ++e) {
                    const int i = sl * 8 + e;
                    const int kc = kt * 32 + 16 * sl + 8 * hi + e;
                    const bool valid = (kc >= cs) && (kc < cs + 16);
                    const float bv = brow[valid ? kc : qc];
                    const float v = valid ? (s[kt][i] * C + bv * LOG2E) : -INFINITY;
                    s[kt][i] = v; mx = fmaxf(mx, v);
                }
            }
        }
        mx = fmaxf(mx, xhalf(mx));
        const float mnew = fmaxf(mrun, mx);
        const float alpha = fexp2(mrun - mnew);
        mrun = mnew;
        float ps = 0.f;
        bf16x8 pb[2][2];
#pragma unroll
        for (int g4 = 0; g4 < 4; ++g4) {
            const int kt = g4 >> 1, sl = g4 & 1;
            const bool dead = (g4 == 3 && qt == 0) || (g4 == 0 && qt == 1);
            if (!dead) {
                float pe[8];
#pragma unroll
                for (int e = 0; e < 8; ++e) { pe[e] = fexp2(s[kt][sl * 8 + e] - mnew); ps += pe[e]; }
                u32x4 w;
                w.x = pk_bf16_m(pe[0], pe[1]); w.y = pk_bf16_m(pe[2], pe[3]); w.z = pk_bf16_m(pe[4], pe[5]); w.w = pk_bf16_m(pe[6], pe[7]);
                pb[kt][sl] = __builtin_bit_cast(bf16x8, w);
            }
        }
        lrun = lrun * alpha + ps;
#pragma unroll
        for (int dt = 0; dt < 2; ++dt)
#pragma unroll
            for (int i = 0; i < 16; ++i) o[dt][i] *= alpha;
#pragma unroll
        for (int g4 = 0; g4 < 4; ++g4) {
            const int kt = g4 >> 1, sl = g4 & 1;
            const bool dead = (g4 == 3 && qt == 0) || (g4 == 0 && qt == 1);
            if (!dead) {
#pragma unroll
                for (int dt = 0; dt < 2; ++dt) o[dt] = mfma32(vf[dt][kt][sl], pb[kt][sl], o[dt]);
            }
        }
        __builtin_amdgcn_sched_barrier(0);
    }
#undef NAT_LOADK
#undef NAT_LOADV
    lrun += xhalf(lrun);
    const float inv = 1.0f / lrun;
    bf16_t* op = P + (tok0 + r * 64 + qc) * PW + CNQ + h * 64;
#pragma unroll
    for (int dt = 0; dt < 2; ++dt)
#pragma unroll
        for (int q = 0; q < 4; ++q) {
            u32x2 w; w.x = pk_bf16(o[dt][4 * q] * inv, o[dt][4 * q + 1] * inv); w.y = pk_bf16(o[dt][4 * q + 2] * inv, o[dt][4 * q + 3] * inv);
            *(u32x2*)(op + dt * 32 + 8 * q + 4 * hi) = w;
        }
}

DEVI void s5z_tile(const Params& p, int layer, int t, bf16_t* lds) {
    unsigned char* ws = ows(p);
    const bf16_t* P = (const bf16_t*)(ws + OFF_P);
    const bf16_t* Zt = (const bf16_t*)(ws + OFF_S5 + layer * S5_LAYER + S5_ZT);
    float* ZS = (float*)(ws + OFF_ZS);
    const int lane = otid() & 63, wave = __builtin_amdgcn_readfirstlane(otid() >> 6), wn = wave & 1, wm = wave >> 1, l32 = lane & 31, hi = lane >> 5;
    const int g = t >> 2, tm = t & 3;
    const int m0 = tm * 256;
    f32x16 acc[4][2];
    zero_acc<4, 2>(acc);
    gemm_kloop<4, 2>(acc, Zt + ((long)g * 256) * 512, 512, P + ((long)m0 * 32) * PW + CSU + g * 16, XS5{}, 512, lds);
#pragma unroll
    for (int mt = 0; mt < 2; ++mt) {
        const int R = m0 + wm * 64 + mt * 32 + l32, b = R >> 8, c = R & 255;
        float* zp = ZS + ((long)((b * 32 + g) * 256 + c)) * 256 + wn * 128;
#pragma unroll
        for (int nt = 0; nt < 4; ++nt)
#pragma unroll
            for (int q = 0; q < 4; ++q) {
                f32x4 v = {acc[nt][mt][4 * q], acc[nt][mt][4 * q + 1], acc[nt][mt][4 * q + 2], acc[nt][mt][4 * q + 3]};
                *(f32x4*)(zp + nt * 32 + 8 * q + 4 * hi) = v;
            }
    }
}


DEVI void scan_wave_unit(const Params& p, int layer, int b, int g, int dir) {
    unsigned char* ws = ows(p);
    const float* ZS = (const float*)(ws + OFF_ZS);
    bf16_t* SP = (bf16_t*)(ws + OFF_SPREV);
    const f32x2* LT = (const f32x2*)(ws + OFF_S5 + layer * S5_LAYER + S5_LAMT);
    const int lane = otid() & 63;
    const f32x2 lt = LT[(dir * 32 + g) * 64 + lane];
    const long base = ((long)(b * 32 + g) * 256) * 256 + dir * 128 + lane;
    float sr = 0.f, si = 0.f;
    for (int cb = 0; cb < 16; ++cb) {
        float zr[16], zi[16];
#pragma unroll
        for (int i = 0; i < 16; ++i) {
            const int cc = cb * 16 + i, c = dir ? 255 - cc : cc;
            zr[i] = ZS[base + (long)c * 256]; zi[i] = ZS[base + (long)c * 256 + 64];
        }
#pragma unroll
        for (int i = 0; i < 16; ++i) {
            const int cc = cb * 16 + i, c = dir ? 255 - cc : cc;
            SP[base + (long)c * 256] = f2bf(sr); SP[base + (long)c * 256 + 64] = f2bf(si);
            const float nr = lt.x * sr - lt.y * si + zr[i], ni = lt.x * si + lt.y * sr + zi[i];
            sr = nr; si = ni;
        }
    }
}

DEVI void s5c_tile(const Params& p, int layer, int t, bf16_t* lds) {
    unsigned char* ws = ows(p);
    const bf16_t* P = (const bf16_t*)(ws + OFF_P);
    const bf16_t* SP = (const bf16_t*)(ws + OFF_SPREV);
    const bf16_t* Bt = (const bf16_t*)(ws + OFF_S5 + layer * S5_LAYER + S5_BT);
    bf16_t* ZB = (bf16_t*)(ws + OFF_ZB);
    const int lane = otid() & 63, wave = __builtin_amdgcn_readfirstlane(otid() >> 6), wn = wave & 1, wm = wave >> 1, l32 = lane & 31, hi = lane >> 5;
    {
        const int g = t >> 3, tm = (t >> 1) & 3, tn = t & 1;
        const int n0 = tn * 256, m0 = tm * 256;
        f32x16 acc[4][2];
        zero_acc<4, 2>(acc);
        gemm_kloop<4, 2>(acc, Bt + ((long)g * 512 + n0) * 768, 768, P + ((long)m0 * 32) * PW + CSU + g * 16, XS5{}, 512, lds);
        gemm_kloop<4, 2>(acc, Bt + ((long)g * 512 + n0) * 768 + 512, 768, SP + ((long)(((m0 >> 8) * 32 + g) * 256)) * 256, XRow{256}, 256, lds);
#pragma unroll
        for (int mt = 0; mt < 2; ++mt) {
            const int R = m0 + wm * 64 + mt * 32 + l32;
#pragma unroll
            for (int nt = 0; nt < 4; ++nt)
#pragma unroll
                for (int q = 0; q < 4; ++q) {
                    const int n = n0 + wn * 128 + nt * 32 + 8 * q + 4 * hi;
                    u32x2 w;
                    w.x = pk_bf16(gelu_tanh(acc[nt][mt][4 * q]), gelu_tanh(acc[nt][mt][4 * q + 1]));
                    w.y = pk_bf16(gelu_tanh(acc[nt][mt][4 * q + 2]), gelu_tanh(acc[nt][mt][4 * q + 3]));
                    *(u32x2*)(ZB + ((long)R * 32 + (n >> 4)) * 512 + g * 16 + (n & 15)) = w;
                }
        }
    }
}

DEVI void glu_tile(const Params& p, int layer, int t, bf16_t* lds) {
    unsigned char* ws = ows(p);
    bf16_t* P = (bf16_t*)(ws + OFF_P);
    const bf16_t* ZB = (const bf16_t*)(ws + OFF_ZB);
    const bf16_t* wt = (const bf16_t*)(ws + OFF_W + layer * W_LAYER + W_GLU);
    const int lane = otid() & 63, wave = __builtin_amdgcn_readfirstlane(otid() >> 6), wn = wave & 1, wm = wave >> 1, l32 = lane & 31, hi = lane >> 5;
    {
        const int tm = t >> 1, tn = t & 1;
        const int n0 = tn * 256, m0 = tm * 256;
        f32x16 acc[4][2];
        zero_acc<4, 2>(acc);
        gemm_kloop<4, 2>(acc, wt + (long)n0 * 512, 512, ZB + (long)m0 * 512, XRow{512}, 512, lds);
#pragma unroll
        for (int mt = 0; mt < 2; ++mt) {
            const int m = m0 + wm * 64 + mt * 32 + l32;
#pragma unroll
            for (int nt = 0; nt < 4; ++nt)
#pragma unroll
                for (int q = 0; q < 4; ++q) {
                    const int n = n0 + wn * 128 + nt * 32 + 8 * q + 4 * hi;
                    const u32x2 zz = *(const u32x2*)(ZB + (long)m * 512 + n);
                    const float z0 = bf2f(zz.x & 0xffffu), z1 = bf2f(zz.x >> 16), z2 = bf2f(zz.y & 0xffffu), z3 = bf2f(zz.y >> 16);
                    u32x2 w;
                    w.x = pk_bf16(z0 * sigmoidf_(acc[nt][mt][4 * q]), z1 * sigmoidf_(acc[nt][mt][4 * q + 1]));
                    w.y = pk_bf16(z2 * sigmoidf_(acc[nt][mt][4 * q + 2]), z3 * sigmoidf_(acc[nt][mt][4 * q + 3]));
                    *(u32x2*)(P + (long)m * PW + CSU + n) = w;
                }
        }
    }
}

DEVI int queue_grab(unsigned* ctr, volatile unsigned* slot, int tid) {
    asm volatile("s_waitcnt vmcnt(0)" ::: "memory");
    __syncthreads();
    if (tid == 0) *slot = __hip_atomic_fetch_add(ctr, 1u, __ATOMIC_RELAXED, __HIP_MEMORY_SCOPE_AGENT);
    __syncthreads();
    return (int)*slot;
}
DEVI void phase_mixers(const Params& p, int layer, bf16_t* lds) {
    unsigned char* ws = ows(p);
    unsigned* ctl = (unsigned*)(ws + OFF_CTL);
    unsigned* q = ctl + 64 + layer * 320;
    unsigned* done = ctl + 704 + layer * 64;
    volatile unsigned* slot = (volatile unsigned*)((unsigned char*)lds + LDS_BYTES - 16);
    const int tid = otid();
    const int wave = __builtin_amdgcn_readfirstlane(tid >> 6);
    const int xcd = (int)(__builtin_amdgcn_s_getreg((3 << 11) | 20) & 7u);
    int u;
    while ((u = queue_grab(q, slot, tid)) < 128) {
        const int g = u >> 2, b = u & 3;
        s5z_tile(p, layer, u, lds);
        asm volatile("s_waitcnt vmcnt(0)" ::: "memory");
        __syncthreads();
        __builtin_amdgcn_fence(__ATOMIC_ACQUIRE, "agent");
        if (wave < 2) scan_wave_unit(p, layer, b, g, wave);
        asm volatile("s_waitcnt vmcnt(0)" ::: "memory");
        __syncthreads();
        __builtin_amdgcn_fence(__ATOMIC_ACQUIRE, "agent");
        s5c_tile(p, layer, (g << 3) + (b << 1), lds);
        s5c_tile(p, layer, (g << 3) + (b << 1) + 1, lds);
        asm volatile("s_waitcnt vmcnt(0)" ::: "memory");
        __syncthreads();
        if (tid == 0) {
            __builtin_amdgcn_fence(__ATOMIC_RELEASE, "agent");
            asm volatile("s_waitcnt vmcnt(0)" ::: "memory");
            __hip_atomic_fetch_add(done + b * 16, 1u, __ATOMIC_RELAXED, __HIP_MEMORY_SCOPE_AGENT);
        }
    }
#pragma unroll 1
    for (int j8 = 0; j8 < 8; ++j8) {
        const int xs = (xcd + j8) & 7;
        while ((u = queue_grab(q + 16 * (1 + xs), slot, tid)) < 128)
            gqa_unit(p, layer, ((xs >> 1) << 8) | ((((xs & 1) << 2) | (u & 3)) << 5) | (u >> 2), lds);
    }
    while ((u = queue_grab(q + 16 * 9, slot, tid)) < 256) {
        const int b = u >> 6;
        if (tid == 0) {
            while (__hip_atomic_load(done + b * 16, __ATOMIC_RELAXED, __HIP_MEMORY_SCOPE_AGENT) < 32u) __builtin_amdgcn_s_sleep(8);
            __builtin_amdgcn_fence(__ATOMIC_ACQUIRE, "agent");
            asm volatile("s_waitcnt vmcnt(0)" ::: "memory");
        }
        __syncthreads();
        glu_tile(p, layer, u, lds);
    }
#pragma unroll 1
    for (int j8 = 0; j8 < 8; ++j8) {
        const int xs = (xcd + j8) & 7;
        while ((u = queue_grab(q + 16 * (10 + xs), slot, tid)) < 128)
            nat_block_unit(p, layer, ((xs >> 1) << 8) | (u << 1) | (xs & 1), lds);
    }
}

DEVI void phase_merge(const Params& p, int layer, bf16_t* lds) {
    unsigned char* ws = ows(p);
    const bf16_t* P = (const bf16_t*)(ws + OFF_P);
    const bf16_t* xb = (const bf16_t*)(ws + OFF_XB);
    const bf16_t* wg = (const bf16_t*)(ws + OFF_W + layer * W_LAYER + W_IN) + (long)PW * DM;
    const bf16_t* wbr = (const bf16_t*)(ws + OFF_W + layer * W_LAYER + W_BR);
    bf16_t* MG = (bf16_t*)(ws + OFF_MERGED);
    const int lane = otid() & 63, wave = __builtin_amdgcn_readfirstlane(otid() >> 6), wn = wave & 1, wm = wave >> 1, l32 = lane & 31, hi = lane >> 5;
    for (int t = vblock(); t < 8 * 128; t += gridDim.x) {
        const int tm = t >> 3, tn = t & 7;
        const int n0 = tn * 128, m0 = tm * 256;
        f32x16 mg[2][2];
        zero_acc<2, 2>(mg);
#pragma unroll 1
        for (int br = 0; br < 3; ++br) {
            const int bcol = (br == 0) ? CQ : (br == 1 ? CNQ : CSU);
            f32x16 acc[2][2];
            unsigned sg[2][2][8];
            zero_acc<2, 2>(acc);
            gemm_kloop<2, 2>(acc, wg + ((long)br * DM + n0) * DM, DM, xb + (long)m0 * DM, XRow{DM}, DM, lds);
#pragma unroll
            for (int nt = 0; nt < 2; ++nt)
#pragma unroll
                for (int mt = 0; mt < 2; ++mt)
#pragma unroll
                    for (int i = 0; i < 8; ++i) sg[nt][mt][i] = pk_bf16(sigmoidf_(acc[nt][mt][2 * i]), sigmoidf_(acc[nt][mt][2 * i + 1]));
            zero_acc<2, 2>(acc);
            gemm_kloop<2, 2>(acc, wbr + ((long)br * DM + n0) * 512, 512, P + (long)m0 * PW + bcol, XRow{PW}, 512, lds);
#pragma unroll
            for (int nt = 0; nt < 2; ++nt)
#pragma unroll
                for (int mt = 0; mt < 2; ++mt)
#pragma unroll
                    for (int i = 0; i < 8; ++i) {
                        mg[nt][mt][2 * i] += bf2f(sg[nt][mt][i] & 0xffffu) * acc[nt][mt][2 * i];
                        mg[nt][mt][2 * i + 1] += bf2f(sg[nt][mt][i] >> 16) * acc[nt][mt][2 * i + 1];
                    }
        }
        __syncthreads();
        bf16_t* wl = lds + wave * (64 * 72);
#pragma unroll
        for (int mt = 0; mt < 2; ++mt)
#pragma unroll
            for (int nt = 0; nt < 2; ++nt)
#pragma unroll
                for (int q = 0; q < 4; ++q) {
                    u32x2 w; w.x = pk_bf16(mg[nt][mt][4 * q], mg[nt][mt][4 * q + 1]); w.y = pk_bf16(mg[nt][mt][4 * q + 2], mg[nt][mt][4 * q + 3]);
                    *(u32x2*)(wl + (mt * 32 + l32) * 72 + nt * 32 + 8 * q + 4 * hi) = w;
                }
        wave_rows_out<2>(wl, MG + (long)(m0 + wm * 64) * DM + n0 + wn * 64, DM, lane);
    }
}

DEVI void phase_res_gemm_ln(const bf16_t* A, int K, const bf16_t* wt, float* out, bf16_t* xb, const float* gain, const float* bias,
                            f32x2* stats, unsigned* cnt, bf16_t* lds, bool rev = false) {
    const int tid = otid(), lane = tid & 63, wave = __builtin_amdgcn_readfirstlane(tid >> 6), wn = wave & 1, wm = wave >> 1, l32 = lane & 31, hi = lane >> 5;
    for (int t = vblock(); t < 4 * 128; t += gridDim.x) {
        const int tm = rev ? 127 - (t >> 2) : (t >> 2), tn = t & 3;
        const int n0 = tn * 256, m0 = tm * 256;
        f32x16 acc[4][2];
        zero_acc<4, 2>(acc);
        gemm_kloop<4, 2>(acc, wt + (long)n0 * K, K, A + (long)m0 * K, XRow{K}, K, lds);
#pragma unroll
        for (int mt = 0; mt < 2; ++mt) {
            const int m = m0 + wm * 64 + mt * 32 + l32;
            float s1 = 0.f, s2 = 0.f;
#pragma unroll
            for (int nt = 0; nt < 4; ++nt)
#pragma unroll
                for (int q = 0; q < 4; ++q) {
                    const long idx = (long)m * DM + n0 + wn * 128 + nt * 32 + 8 * q + 4 * hi;
                    const u32x2 rr = *(const u32x2*)(xb + idx);
                    const float r[4] = {bf2f(rr.x & 0xffffu), bf2f(rr.x >> 16), bf2f(rr.y & 0xffffu), bf2f(rr.y >> 16)};
#pragma unroll
                    for (int e = 0; e < 4; ++e) {
                        const float v = ALPHA * r[e] + acc[nt][mt][4 * q + e];
                        acc[nt][mt][4 * q + e] = v; s1 += v; s2 += v * v;
                    }
                }
            s1 += xhalf(s1); s2 += xhalf(s2);
            if (hi == 0) stats[(long)m * 8 + tn * 2 + wn] = (f32x2){s1, s2};
        }
        asm volatile("s_waitcnt vmcnt(0)" ::: "memory");
        __syncthreads();
        if (tid == 0) {
            __builtin_amdgcn_fence(__ATOMIC_RELEASE, "agent");
            asm volatile("s_waitcnt vmcnt(0)" ::: "memory");
            __hip_atomic_fetch_add(cnt + tm, 1u, __ATOMIC_RELAXED, __HIP_MEMORY_SCOPE_AGENT);
            while (__hip_atomic_load(cnt + tm, __ATOMIC_RELAXED, __HIP_MEMORY_SCOPE_AGENT) < 4u) __builtin_amdgcn_s_sleep(1);
            __builtin_amdgcn_fence(__ATOMIC_ACQUIRE, "agent");
            asm volatile("s_waitcnt vmcnt(0)" ::: "memory");
        }
        __syncthreads();
        float mu[2], rstd[2];
#pragma unroll
        for (int mt = 0; mt < 2; ++mt) {
            const int m = m0 + wm * 64 + mt * 32 + l32;
            float s1 = 0.f, s2 = 0.f;
#pragma unroll
            for (int j = 0; j < 8; ++j) { const f32x2 pj = *(const GAS f32x2*)(const GAS void*)(stats + (long)m * 8 + j); s1 += pj.x; s2 += pj.y; }
            mu[mt] = s1 * (1.0f / DM);
            const float var = fmaxf(s2 * (1.0f / DM) - mu[mt] * mu[mt], 0.f);
            rstd[mt] = rsqrtf(var + 1e-5f);
        }
#pragma unroll
        for (int nt = 0; nt < 4; ++nt) {
#pragma unroll
            for (int q = 0; q < 4; ++q) {
                const int n = n0 + wn * 128 + nt * 32 + 8 * q + 4 * hi;
                const f32x4 g4 = *(const GAS f32x4*)(const GAS float*)(gain + n), b4 = *(const GAS f32x4*)(const GAS float*)(bias + n);
#pragma unroll
                for (int mt = 0; mt < 2; ++mt) {
                    acc[nt][mt][4 * q] = (acc[nt][mt][4 * q] - mu[mt]) * rstd[mt] * g4.x + b4.x; acc[nt][mt][4 * q + 1] = (acc[nt][mt][4 * q + 1] - mu[mt]) * rstd[mt] * g4.y + b4.y;
                    acc[nt][mt][4 * q + 2] = (acc[nt][mt][4 * q + 2] - mu[mt]) * rstd[mt] * g4.z + b4.z; acc[nt][mt][4 * q + 3] = (acc[nt][mt][4 * q + 3] - mu[mt]) * rstd[mt] * g4.w + b4.w;
                }
            }
            __builtin_amdgcn_sched_barrier(0);
        }
        __builtin_amdgcn_sched_barrier(0);
        if (out) {
#pragma unroll
            for (int mt = 0; mt < 2; ++mt) {
                float* orow = out + (long)(m0 + wm * 64 + mt * 32 + l32) * DM + n0 + wn * 128 + 4 * hi;
#pragma unroll
                for (int nt = 0; nt < 4; ++nt)
#pragma unroll
                    for (int q = 0; q < 4; ++q)
                        *(f32x4*)(orow + nt * 32 + 8 * q) = (f32x4){acc[nt][mt][4 * q], acc[nt][mt][4 * q + 1], acc[nt][mt][4 * q + 2], acc[nt][mt][4 * q + 3]};
            }
        } else {
            bf16_t* wl = lds + wave * (64 * 136);
#pragma unroll
            for (int mt = 0; mt < 2; ++mt)
#pragma unroll
                for (int nt = 0; nt < 4; ++nt)
#pragma unroll
                    for (int q = 0; q < 4; ++q) {
                        u32x2 w; w.x = pk_bf16(acc[nt][mt][4 * q], acc[nt][mt][4 * q + 1]); w.y = pk_bf16(acc[nt][mt][4 * q + 2], acc[nt][mt][4 * q + 3]);
                        *(u32x2*)(wl + (mt * 32 + l32) * 136 + nt * 32 + 8 * q + 4 * hi) = w;
                    }
            wave_rows_out<4>(wl, xb + (long)(m0 + wm * 64) * DM + n0 + wn * 128, DM, lane);
        }
    }
}

DEVI void phase_ffn_up(const Params& p, int layer, bf16_t* lds) {
    unsigned char* ws = ows(p);
    const bf16_t* xb = (const bf16_t*)(ws + OFF_XB);
    const bf16_t* wt = (const bf16_t*)(ws + OFF_W + layer * W_LAYER + W_UP);
    bf16_t* H = (bf16_t*)(ws + OFF_H);
    const int lane = otid() & 63, wave = __builtin_amdgcn_readfirstlane(otid() >> 6), wn = wave & 1, wm = wave >> 1, l32 = lane & 31, hi = lane >> 5;
    for (int t = vblock(); t < 16 * 128; t += gridDim.x) {
        const int v8 = t & 255, grp = v8 >> 5, w5 = v8 & 31;
        const int tm = (t >> 8) * 16 + (grp & 3) * 4 + (w5 & 3), tn = (grp >> 2) * 8 + (w5 >> 2);
        const int n0 = tn * 256, m0 = tm * 256;
        f32x16 acc[4][2];
        zero_acc<4, 2>(acc);
        gemm_kloop<4, 2>(acc, wt + (long)n0 * DM, DM, xb + (long)m0 * DM, XRow{DM}, DM, lds);
        __syncthreads();
        bf16_t* wl = lds + wave * (64 * 136);
#pragma unroll
        for (int mt = 0; mt < 2; ++mt)
#pragma unroll
            for (int nt = 0; nt < 4; ++nt)
#pragma unroll
                for (int q = 0; q < 4; ++q) {
                    float v[4];
#pragma unroll
                    for (int e = 0; e < 4; ++e) { const float a = fmaxf(acc[nt][mt][4 * q + e], 0.f); v[e] = a * a; }
                    u32x2 w; w.x = pk_bf16(v[0], v[1]); w.y = pk_bf16(v[2], v[3]);
                    *(u32x2*)(wl + (mt * 32 + l32) * 136 + nt * 32 + 8 * q + 4 * hi) = w;
                }
        wave_rows_out<4>(wl, H + (long)(m0 + wm * 64) * FFN + n0 + wn * 128, FFN, lane);
    }
}

DEVI void phase_ln(const float* src, float* dst, bf16_t* xb, const float* gain, const float* bias) {
    const int lane = otid() & 63, wave = otid() >> 6;
    for (int row = blockIdx.x * NWAVES + wave; row < MTOK; row += gridDim.x * NWAVES) {
        const float* s = src + (long)row * DM;
        f32x4 v[4];
#pragma unroll
        for (int i = 0; i < 4; ++i) v[i] = *(const f32x4*)(s + i * 256 + lane * 4);
        float sum = 0.f;
#pragma unroll
        for (int i = 0; i < 4; ++i) sum += v[i].x + v[i].y + v[i].z + v[i].w;
#pragma unroll
        for (int o = 1; o < 64; o <<= 1) sum += __shfl_xor(sum, o);
        const float mu = sum * (1.0f / DM);
        float sq = 0.f;
#pragma unroll
        for (int i = 0; i < 4; ++i) { v[i].x -= mu; v[i].y -= mu; v[i].z -= mu; v[i].w -= mu; sq += v[i].x * v[i].x + v[i].y * v[i].y + v[i].z * v[i].z + v[i].w * v[i].w; }
#pragma unroll
        for (int o = 1; o < 64; o <<= 1) sq += __shfl_xor(sq, o);
        const float rstd = rsqrtf(sq * (1.0f / DM) + 1e-5f);
#pragma unroll
        for (int i = 0; i < 4; ++i) {
            const int c = i * 256 + lane * 4;
            const f32x4 g = *(const f32x4*)(gain + c), bb = *(const f32x4*)(bias + c);
            f32x4 y;
            y.x = v[i].x * rstd * g.x + bb.x; y.y = v[i].y * rstd * g.y + bb.y; y.z = v[i].z * rstd * g.z + bb.z; y.w = v[i].w * rstd * g.w + bb.w;
            *(f32x4*)(dst + (long)row * DM + c) = y;
            u32x2 w; w.x = pk_bf16(y.x, y.y); w.y = pk_bf16(y.z, y.w);
            *(u32x2*)(xb + (long)row * DM + c) = w;
        }
    }
}

DEVI void transpose_mat(const float* src, int K, int N, bf16_t* dst, float* tl) {
    const int tid = otid();
    const int tk = K / 64, tn = N / 64;
    for (int t = blockIdx.x; t < tk * tn; t += gridDim.x) {
        const int k0 = (t / tn) * 64, n0 = (t % tn) * 64;
        __syncthreads();
#pragma unroll
        for (int i = 0; i < 2; ++i) {
            const int e = tid + 512 * i, r = e >> 4, c4 = (e & 15) * 4;
            const f32x4 v = *(const f32x4*)(src + (long)(k0 + r) * N + n0 + c4);
            tl[r * 65 + c4] = v.x; tl[r * 65 + c4 + 1] = v.y; tl[r * 65 + c4 + 2] = v.z; tl[r * 65 + c4 + 3] = v.w;
        }
        __syncthreads();
#pragma unroll
        for (int i = 0; i < 1; ++i) {
            const int e = tid, n = e >> 3, kc = (e & 7) * 8;
            u32x4 w;
            w.x = pk_bf16(tl[(kc + 0) * 65 + n], tl[(kc + 1) * 65 + n]); w.y = pk_bf16(tl[(kc + 2) * 65 + n], tl[(kc + 3) * 65 + n]);
            w.z = pk_bf16(tl[(kc + 4) * 65 + n], tl[(kc + 5) * 65 + n]); w.w = pk_bf16(tl[(kc + 6) * 65 + n], tl[(kc + 7) * 65 + n]);
            *(u32x4*)(dst + (long)(n0 + n) * K + k0 + kc) = w;
        }
    }
}

struct Cx { float re, im; };
DEVI Cx cmul(Cx a, Cx b) { return {a.re * b.re - a.im * b.im, a.re * b.im + a.im * b.re}; }
DEVI Cx lam_pow(float are, float aim, float dt, float n) {
    const float mag = fexp2(are * dt * n * LOG2E);
    const float ph = (aim * dt) * n;
    return {mag * __cosf(ph), mag * __sinf(ph)};
}
DEVI Cx zoh_coef(float are, float aim, float dt) {
    const Cx lam = lam_pow(are, aim, dt, 1.0f);
    const float den = are * are + aim * aim, nr = lam.re - 1.0f;
    return {(nr * are + lam.im * aim) / den, (lam.im * are - nr * aim) / den};
}

DEVI void phase_prologue_a(const Params& p, bf16_t* lds) {
    unsigned char* ws = ows(p);
    float* tl = (float*)lds;
    const int tid = otid();
    const long gtid = (long)blockIdx.x * NTHREADS + tid, gsz = (long)gridDim.x * NTHREADS;
    {
        const float* x = p.in[0];
        bf16_t* xb = (bf16_t*)(ws + OFF_XB);
        for (long e = gtid; e < (long)MTOK * DM / 4; e += gsz) {
            const f32x4 v = *(const f32x4*)(x + e * 4);
            u32x2 w; w.x = pk_bf16(v.x, v.y); w.y = pk_bf16(v.z, v.w);
            *(u32x2*)(xb + e * 4) = w;
        }
    }
    for (int layer = 0; layer < 2; ++layer) {
        unsigned char* wl = ws + OFF_W + layer * W_LAYER;
        transpose_mat(p.in[1] + (long)layer * DM * INW, DM, INW, (bf16_t*)(wl + W_IN), tl);
        transpose_mat(p.in[13] + (long)layer * 512 * 512, 512, 512, (bf16_t*)(wl + W_GLU), tl);
        for (int br = 0; br < 3; ++br)
            transpose_mat(p.in[14] + ((long)layer * 3 + br) * 512 * DM, 512, DM, (bf16_t*)(wl + W_BR) + (long)br * DM * 512, tl);
        transpose_mat(p.in[15] + (long)layer * DM * DM, DM, DM, (bf16_t*)(wl + W_OUT), tl);
        transpose_mat(p.in[18] + (long)layer * DM * FFN, DM, FFN, (bf16_t*)(wl + W_UP), tl);
        transpose_mat(p.in[19] + (long)layer * FFN * DM, FFN, DM, (bf16_t*)(wl + W_DN), tl);

        unsigned char* sl = ws + OFF_S5 + layer * S5_LAYER;
        bf16_t* Bt = (bf16_t*)(sl + S5_BT);
        bf16_t* Zt = (bf16_t*)(sl + S5_ZT);
        float* KT = (float*)(sl + S5_KTAB);
        f32x2* LT = (f32x2*)(sl + S5_LAMT);
        const float* a_re = p.in[5] + layer * 2 * 32 * 64;
        const float* a_im = p.in[6] + layer * 2 * 32 * 64;
        const float* ldt = p.in[7] + layer * 2 * 32;
        const float* b_re = p.in[8] + (long)layer * 32 * 64 * 16;
        const float* b_im = p.in[9] + (long)layer * 32 * 64 * 16;
        const float* c_re = p.in[10] + (long)layer * 2 * 32 * 16 * 64;
        const float* c_im = p.in[11] + (long)layer * 2 * 32 * 16 * 64;
        for (long e = gtid; e < 2 * 32 * 64; e += gsz) {
            const int dg = (int)(e >> 6);
            const float dt = __expf(ldt[dg]);
            const Cx l = lam_pow(a_re[e], a_im[e], dt, 32.0f);
            LT[e] = (f32x2){l.re, l.im};
        }
        for (long e = gtid; e < 32 * 2 * 32 * 64; e += gsz) {
            const int pp = (int)(e & 63), jt = (int)((e >> 6) & 31), dir = (int)((e >> 11) & 1), g = (int)(e >> 12);
            const int ai = (dir * 32 + g) * 64 + pp;
            const float are = a_re[ai], aim = a_im[ai], dt = __expf(ldt[dir * 32 + g]);
            const Cx coef = zoh_coef(are, aim, dt);
            {
                const Cx w = cmul(lam_pow(are, aim, dt, (float)(dir == 0 ? 31 - jt : jt)), coef);
                bf16_t* zr = Zt + ((long)(g * 256 + dir * 128 + pp)) * 512 + jt * 16;
                bf16_t* zi = zr + 64 * 512;
#pragma unroll
                for (int h = 0; h < 16; ++h) {
                    const Cx bb = {b_re[(g * 64 + pp) * 16 + h], b_im[(g * 64 + pp) * 16 + h]};
                    const Cx wb = cmul(w, bb);
                    zr[h] = f2bf(wb.re); zi[h] = f2bf(wb.im);
                }
            }
            {
                const Cx lp = lam_pow(are, aim, dt, (float)(dir == 0 ? jt + 1 : 32 - jt));
#pragma unroll
                for (int h = 0; h < 16; ++h) {
                    const int ci = ((dir * 32 + g) * 16 + h) * 64 + pp;
                    const Cx c = cmul((Cx){c_re[ci], c_im[ci]}, lp);
                    bf16_t* bp = Bt + ((long)(g * 512 + jt * 16 + h)) * 768 + 512 + dir * 128 + pp;
                    bp[0] = f2bf(c.re); bp[64] = f2bf(-c.im);
                }
            }
        }
        for (int u = blockIdx.x; u < 2 * 32 * 32; u += gridDim.x) {
            const int tau = u & 31, g = (u >> 5) & 31, dir = u >> 10;
            __syncthreads();
            if (tid < 64) {
                const int ai = (dir * 32 + g) * 64 + tid;
                const float are = a_re[ai], aim = a_im[ai], dt = __expf(ldt[dir * 32 + g]);
                const Cx w = cmul(lam_pow(are, aim, dt, (float)tau), zoh_coef(are, aim, dt));
                tl[2 * tid] = w.re; tl[2 * tid + 1] = w.im;
            }
            __syncthreads();
            const int hp = (tid >> 4) & 15, h = tid & 15;
            float acc = 0.f;
            if (tid < 256)
            for (int pp = 0; pp < 64; ++pp) {
                const Cx w = {tl[2 * pp], tl[2 * pp + 1]};
                const Cx bb = {b_re[(g * 64 + pp) * 16 + h], b_im[(g * 64 + pp) * 16 + h]};
                const Cx wb = cmul(w, bb);
                const int ci = ((dir * 32 + g) * 16 + hp) * 64 + pp;
                acc += c_re[ci] * wb.re - c_im[ci] * wb.im;
            }
            if (tid < 256) KT[((long)((dir * 32 + g) * 32 + tau)) * 256 + tid] = acc;
        }
    }
}

DEVI void phase_prologue_b(const Params& p) {
    unsigned char* ws = ows(p);
    const long gtid = (long)blockIdx.x * NTHREADS + otid(), gsz = (long)gridDim.x * NTHREADS;
    for (int layer = 0; layer < 2; ++layer) {
        unsigned char* sl = ws + OFF_S5 + layer * S5_LAYER;
        bf16_t* Bt = (bf16_t*)(sl + S5_BT);
        const float* KT = (const float*)(sl + S5_KTAB);
        const float* dsk = p.in[12] + layer * 32 * 16;
        for (long e = gtid; e < 32L * 512 * 64; e += gsz) {
            const int kc = (int)(e & 63), n = (int)((e >> 6) & 511), g = (int)(e >> 15);
            const int j = kc >> 1, h0 = (kc & 1) * 8, t = n >> 4, hp = n & 15;
            float v[8];
            if (j < t) {
                const float* k = KT + ((long)((0 * 32 + g) * 32 + (t - j))) * 256 + hp * 16 + h0;
#pragma unroll
                for (int i = 0; i < 8; ++i) v[i] = k[i];
            } else if (j > t) {
                const float* k = KT + ((long)((1 * 32 + g) * 32 + (j - t))) * 256 + hp * 16 + h0;
#pragma unroll
                for (int i = 0; i < 8; ++i) v[i] = k[i];
            } else {
                const float* kf = KT + ((long)((0 * 32 + g) * 32)) * 256 + hp * 16 + h0;
                const float* kb = KT + ((long)((1 * 32 + g) * 32)) * 256 + hp * 16 + h0;
#pragma unroll
                for (int i = 0; i < 8; ++i) v[i] = kf[i] + kb[i] + ((h0 + i == hp) ? dsk[g * 16 + hp] : 0.f);
            }
            u32x4 w; w.x = pk_bf16(v[0], v[1]); w.y = pk_bf16(v[2], v[3]); w.z = pk_bf16(v[4], v[5]); w.w = pk_bf16(v[6], v[7]);
            *(u32x4*)(Bt + ((long)(g * 512 + n)) * 768 + kc * 8) = w;
        }
    }
}


DEVI void grid_barrier(unsigned* ctr, unsigned target) {
    asm volatile("s_waitcnt vmcnt(0) lgkmcnt(0)" ::: "memory");
    __syncthreads();
    if (threadIdx.x == 0) {
        __builtin_amdgcn_fence(__ATOMIC_RELEASE, "agent");
        asm volatile("s_waitcnt vmcnt(0)" ::: "memory");
        __hip_atomic_fetch_add(ctr, 1u, __ATOMIC_RELAXED, __HIP_MEMORY_SCOPE_AGENT);
        while (__hip_atomic_load(ctr, __ATOMIC_RELAXED, __HIP_MEMORY_SCOPE_AGENT) < target) __builtin_amdgcn_s_sleep(2);
        __builtin_amdgcn_fence(__ATOMIC_ACQUIRE, "agent");
        asm volatile("s_waitcnt vmcnt(0)" ::: "memory");
    }
    __syncthreads();
}

constexpr int PH_PER_LAYER = 6;
constexpr int N_PHASES = 2 + PH_PER_LAYER * 2;
__global__ void __launch_bounds__(NTHREADS, 2) fwd_kernel(Params p) {
    extern __shared__ __attribute__((aligned(16))) unsigned char lds_raw[];
    bf16_t* lds = (bf16_t*)lds_raw;
    unsigned char* ws = ows(p);
    for (int ph = p.ph_lo; ph < p.ph_hi; ++ph) {
        if (ph == 0) phase_prologue_a(p, lds);
        else if (ph == 1) phase_prologue_b(p);
        else {
            const int layer = (ph - 2) / PH_PER_LAYER, sub = (ph - 2) % PH_PER_LAYER;
            switch (sub) {
            case 0: phase_inproj(p, layer, lds); break;
            case 1: phase_mixers(p, layer, lds); break;
            case 2: phase_merge(p, layer, lds); break;
            case 3: phase_res_gemm_ln((const bf16_t*)(ws + OFF_MERGED), DM, (const bf16_t*)(ws + OFF_W + layer * W_LAYER + W_OUT), nullptr, (bf16_t*)(ws + OFF_XB),
                                      p.in[16] + layer * DM, p.in[17] + layer * DM, (f32x2*)(ws + OFF_STATS), (unsigned*)(ws + OFF_CTL) + 1024 + (layer * 2) * 128, lds); break;
            case 4: phase_ffn_up(p, layer, lds); break;
            default: phase_res_gemm_ln((const bf16_t*)(ws + OFF_H), FFN, (const bf16_t*)(ws + OFF_W + layer * W_LAYER + W_DN), layer == 1 ? p.out : nullptr, (bf16_t*)(ws + OFF_XB),
                                      p.in[20] + layer * DM, p.in[21] + layer * DM, (f32x2*)(ws + OFF_STATS), (unsigned*)(ws + OFF_CTL) + 1024 + (layer * 2 + 1) * 128, lds, true); break;
            }
        }
        if (ph + 1 < p.ph_hi) {
            if (ph == p.ph_lo) cg::this_grid().sync();
            else grid_barrier((unsigned*)(ws + OFF_CTL), (unsigned)(ph - p.ph_lo) * gridDim.x);
        }
    }
}

extern "C" void kernel_launch(void* const* d_in, const int* in_sizes, int n_in, void* d_out, int out_size, void* d_ws, size_t ws_size, hipStream_t stream) {
    static int grid = 0;
    if (grid == 0) {
        if (n_in != 22 || ws_size < WS_END) { fprintf(stderr, "kernel_launch: unexpected n_in %d / ws_size %zu\n", n_in, ws_size); grid = -1; return; }
        int dev = 0, cus = 0, per_cu = 0;
        hipGetDevice(&dev);
        hipDeviceGetAttribute(&cus, hipDeviceAttributeMultiprocessorCount, dev);
        hipFuncSetAttribute((const void*)fwd_kernel, hipFuncAttributeMaxDynamicSharedMemorySize, LDS_BYTES);
        hipOccupancyMaxActiveBlocksPerMultiprocessor(&per_cu, (const void*)fwd_kernel, NTHREADS, LDS_BYTES);
        if (per_cu < 1) per_cu = 1;
        if (per_cu > 1) per_cu = 1;
        grid = cus * per_cu;
        fprintf(stderr, "kernel_launch: grid %d (%d CUs x %d)\n", grid, cus, per_cu);
    }
    if (grid < 0) return;
    Params p{};
    for (int i = 0; i < 22; ++i) p.in[i] = (const float*)d_in[i];
    p.out = (float*)d_out; p.ws = (unsigned char*)d_ws;
#if SINGLE_LAUNCH
    hipMemsetAsync((unsigned char*)d_ws + OFF_CTL, 0, 8192, stream);
    p.ph_lo = 0; p.ph_hi = N_PHASES;
    void* args[] = {&p};
    hipError_t e = hipLaunchCooperativeKernel((const void*)fwd_kernel, dim3(grid), dim3(NTHREADS), args, LDS_BYTES, stream);
    if (e != hipSuccess) fprintf(stderr, "cooperative launch failed: %s (grid %d)\n", hipGetErrorString(e), grid);
#else
    for (int ph = 0; ph < N_PHASES; ++ph) {
        p.ph_lo = ph; p.ph_hi = ph + 1;
        hipLaunchKernelGGL(fwd_kernel, dim3(grid), dim3(NTHREADS), LDS_BYTES, stream, p);
    }
#endif
}
```

```cpp
#include <hip/hip_runtime.h>
#include <hip/hip_cooperative_groups.h>
#include <cstdio>
namespace cg = cooperative_groups;

#ifndef SINGLE_LAUNCH
#define SINGLE_LAUNCH 1
#endif

typedef unsigned short bf16_t;
typedef short bf16x8 __attribute__((ext_vector_type(8)));
typedef float f32x16 __attribute__((ext_vector_type(16)));
typedef float f32x4 __attribute__((ext_vector_type(4)));
typedef float f32x2 __attribute__((ext_vector_type(2)));
typedef unsigned u32x4 __attribute__((ext_vector_type(4)));
typedef unsigned u32x2 __attribute__((ext_vector_type(2)));
#define DEVI __device__ __forceinline__

constexpr int DM = 1024, SEQ = 8192, NB = 4, MTOK = NB * SEQ, FFN = 4096, INW = 5888;
constexpr int PW = 2816;
constexpr int CQ = 0, CK = 512, CNQ = 768, CNK = 1280, CSU = 2304;
constexpr float ALPHA = 1.4142135623730951f;
constexpr float LOG2E = 1.4426950408889634f;
constexpr int NTHREADS = 512, NWAVES = 8;
constexpr int LSTR = 72;
constexpr int LDS_BYTES = 2 * (256 + 256) * LSTR * 2;

constexpr size_t MiB = 1u << 20;
constexpr size_t OFF_P = 0, OFF_H = 0, OFF_ZB = 176 * MiB, OFF_MERGED = 176 * MiB, OFF_NVT = 208 * MiB, OFF_VT = 240 * MiB;
constexpr size_t OFF_ZS = 256 * MiB, OFF_SPREV = 288 * MiB;
constexpr size_t OFF_W = 304 * MiB, W_LAYER = 34 * MiB;
constexpr size_t W_IN = 0, W_GLU = 12 * MiB, W_BR = 13 * MiB, W_OUT = 16 * MiB, W_UP = 18 * MiB, W_DN = 26 * MiB;
constexpr size_t OFF_S5 = 372 * MiB, S5_LAYER = 35 * MiB;
constexpr size_t S5_BT = 0, S5_ZT = 24 * MiB, S5_KTAB = 32 * MiB, S5_LAMT = 34 * MiB;
constexpr size_t OFF_XB = 442 * MiB;
constexpr size_t OFF_CTL = 506 * MiB;
constexpr size_t OFF_STATS = 507 * MiB;
constexpr size_t WS_END = 509 * MiB;

struct Params {
    const float* in[22];
    float* out;
    unsigned char* ws;
    int ph_lo, ph_hi;
};

DEVI unsigned char* ows(const Params& p) { unsigned char* w = p.ws; asm volatile("" : "+s"(w)); return w; }
#define GAS __attribute__((address_space(1)))
DEVI u32x4 gld16(const void* p) { return *(const GAS u32x4*)(const GAS char*)p; }
DEVI bf16x8 gld16b(const void* p) { return *(const GAS bf16x8*)(const GAS char*)p; }
DEVI void gst8(void* base, unsigned off, u32x2 v) { *(GAS u32x2*)((GAS char*)base + off) = v; }
DEVI void gst2(void* base, unsigned off, bf16_t v) { *(GAS bf16_t*)((GAS char*)base + off) = v; }
DEVI int otid() { int t = threadIdx.x; asm volatile("" : "+v"(t)); return t; }
typedef __bf16 bf16x2_t __attribute__((ext_vector_type(2)));
DEVI unsigned pk_bf16_m(float lo, float hi) { const f32x2 v = {lo, hi}; const bf16x2_t b = __builtin_convertvector(v, bf16x2_t); return __builtin_bit_cast(unsigned, b); }
DEVI unsigned pk_bf16(float lo, float hi) { unsigned r; asm("v_cvt_pk_bf16_f32 %0, %1, %2" : "=v"(r) : "v"(lo), "v"(hi)); return r; }
DEVI bf16_t f2bf(float f) { return (bf16_t)(pk_bf16(f, 0.f) & 0xffffu); }
DEVI float bf2f(unsigned v) { return __uint_as_float(v << 16); }
DEVI float fexp2(float x) { return __builtin_amdgcn_exp2f(x); }
DEVI float sigmoidf_(float x) { return 1.0f / (1.0f + fexp2(-x * LOG2E)); }
DEVI float gelu_tanh(float y) {
    const float u = 0.7978845608028654f * (y + 0.044715f * y * y * y);
    return y * sigmoidf_(2.0f * u);
}
DEVI f32x16 mfma32(bf16x8 a, bf16x8 b, f32x16 c) { return __builtin_amdgcn_mfma_f32_32x32x16_bf16(a, b, c, 0, 0, 0); }
DEVI float xhalf(float v) { return __shfl_xor(v, 32); }

#define LAS __attribute__((address_space(3)))
#define SB() __builtin_amdgcn_sched_barrier(0)
template <int NT, int MT, class XF>
DEVI void gemm_kloop(f32x16 (&acc)[NT][MT], const bf16_t* wbase, int ldw, const bf16_t* xbase, const XF& xf, int K, bf16_t* lds) {
    const int tid = otid(), lane = tid & 63;
    const int wave = __builtin_amdgcn_readfirstlane(tid >> 6);
    const int wn = wave & 1, wm = wave >> 1, l32 = lane & 31, hi = lane >> 5;
    constexpr int WR = 64 * NT, XR = 128 * MT, WI = WR / 64, XI = XR / 64, STAGE = (WR + XR) * 64, NP = WI + XI;
    const int nk = K >> 6;
    const int lrow = wave * 8 + (lane >> 3);
    const int lc = ((lane & 7) ^ ((lrow >> 1) & 7)) * 8;
    const unsigned woff0 = ((unsigned)lrow * (unsigned)ldw + (unsigned)lc) * 2u;
    const unsigned wstep = 64u * (unsigned)ldw * 2u;
    unsigned xoff[XI];
#pragma unroll
    for (int j = 0; j < XI; ++j) xoff[j] = xf.off((unsigned)(lrow + 64 * j), (unsigned)lc) * 2u;
    const GAS char* wp = (const GAS char*)wbase;
    const GAS char* xp = (const GAS char*)xbase;
    const unsigned xstep = (unsigned)xf.kstep() * 2u;
    LAS bf16_t* L = (LAS bf16_t*)lds;
    const int sw = (l32 >> 1) & 7;
    int koff[4];
#pragma unroll
    for (int kk = 0; kk < 4; ++kk) koff[kk] = ((kk * 2 + hi) ^ sw) * 8;
#define GEMM_PIECE(bufi, pi) do { \
        LAS bf16_t* _d = L + (bufi) * STAGE + wave * 8 * 64; \
        if ((pi) < WI) __builtin_amdgcn_global_load_lds((const GAS unsigned*)(wp + woff0 + (pi) * wstep), (LAS unsigned*)(_d + (pi) * 64 * 64), 16, 0, 0); \
        else if ((pi) < NP) __builtin_amdgcn_global_load_lds((const GAS unsigned*)(xp + xoff[((pi) - WI) < XI ? ((pi) - WI) : 0]), (LAS unsigned*)(_d + (WR + ((pi) - WI) * 64) * 64), 16, 0, 0); \
    } while (0)
#define GEMM_RFR(set, kk) do { \
        _Pragma("unroll") for (int mt = 0; mt < MT; ++mt) fb[set][mt] = *(const LAS bf16x8*)(xsb + mt * 32 * 64 + koff[kk]); \
        _Pragma("unroll") for (int nt = 0; nt < NT; ++nt) fa[set][nt] = *(const LAS bf16x8*)(wsb + nt * 32 * 64 + koff[kk]); \
    } while (0)
#define GEMM_MMA(set, nlo, nhi) do { \
        __builtin_amdgcn_s_setprio(1); \
        _Pragma("unroll") for (int nt = (nlo); nt < (nhi); ++nt) \
        _Pragma("unroll") for (int mt = 0; mt < MT; ++mt) acc[nt][mt] = mfma32(fa[set][nt], fb[set][mt], acc[nt][mt]); \
        __builtin_amdgcn_s_setprio(0); \
    } while (0)
    asm volatile("s_waitcnt vmcnt(0)" ::: "memory");
    __builtin_amdgcn_s_barrier();
#pragma unroll
    for (int pi = 0; pi < NP; ++pi) GEMM_PIECE(0, pi);
#pragma unroll 1
    for (int kt = 0; kt < nk; ++kt) {
        const int buf = kt & 1;
        const bool more = (kt + 1 < nk);
        asm volatile("s_waitcnt vmcnt(0) lgkmcnt(0)" ::: "memory");
        __builtin_amdgcn_s_barrier();
        const LAS bf16_t* wsb = L + buf * STAGE + (wn * 32 * NT + l32) * 64;
        const LAS bf16_t* xsb = L + buf * STAGE + (WR + wm * 32 * MT + l32) * 64;
        bf16x8 fa[2][NT], fb[2][MT];
        GEMM_RFR(0, 0);
        SB();
        if (more) { wp += 128; xp += xstep; }
#pragma unroll
        for (int kk = 0; kk < 4; ++kk) {
            if (kk < 3) { GEMM_RFR((kk + 1) & 1, kk + 1); }
            SB();
            if (more && kk < 2) { GEMM_PIECE(buf ^ 1, 4 * kk); GEMM_PIECE(buf ^ 1, 4 * kk + 1); }
            SB();
            GEMM_MMA(kk & 1, 0, NT / 2);
            SB();
            if (more && kk < 2) { GEMM_PIECE(buf ^ 1, 4 * kk + 2); GEMM_PIECE(buf ^ 1, 4 * kk + 3); }
            SB();
            GEMM_MMA(kk & 1, NT / 2, NT);
            SB();
        }
    }
#undef GEMM_PIECE
#undef GEMM_RFR
#undef GEMM_MMA
}

template <int NT, int MT> DEVI void zero_acc(f32x16 (&acc)[NT][MT]) {
#pragma unroll
    for (int nt = 0; nt < NT; ++nt)
#pragma unroll
        for (int mt = 0; mt < MT; ++mt)
#pragma unroll
            for (int i = 0; i < 16; ++i) acc[nt][mt][i] = 0.f;
}
DEVI int vblock() { const int G = gridDim.x, b = blockIdx.x; return (G % 8 == 0) ? (b % 8) * (G / 8) + b / 8 : b; }

struct XRow {
    int ld;
    DEVI unsigned off(unsigned r, unsigned kc) const { return r * (unsigned)ld + kc; }
    DEVI int kstep() const { return 64; }
};
struct XS5 {
    DEVI unsigned off(unsigned r, unsigned kc) const { return (r * 32u + (kc >> 4)) * (unsigned)PW + (kc & 15u); }
    DEVI int kstep() const { return 4 * PW; }
};


template <int NT> DEVI void wave_rows_out(const bf16_t* wl, bf16_t* gbase, long ld, int lane) {
    constexpr int RS = NT * 32 + 8, CPR = NT * 4, RPI = 64 / CPR;
    asm volatile("s_waitcnt lgkmcnt(0)" ::: "memory");
    const bf16_t* lp = wl + (lane / CPR) * RS + (lane % CPR) * 8;
    const unsigned loff = ((unsigned)(lane / CPR) * (unsigned)ld + (unsigned)(lane % CPR) * 8u) * 2u;
    GAS char* gp = (GAS char*)gbase;
    const unsigned gstep = (unsigned)RPI * (unsigned)ld * 2u;
#pragma unroll 4
    for (int j = 0; j < NT * 4; ++j) {
        const u32x4 v = *(const u32x4*)(lp);
        *(GAS u32x4*)(gp + loff) = v;
        gp += gstep; lp += RPI * RS;
    }
}

DEVI void phase_inproj(const Params& p, int layer, bf16_t* lds) {
    unsigned char* ws = ows(p);
    const bf16_t* xb = (const bf16_t*)(ws + OFF_XB);
    const bf16_t* wt = (const bf16_t*)(ws + OFF_W + layer * W_LAYER + W_IN);
    bf16_t* P = (bf16_t*)(ws + OFF_P);
    bf16_t* VT = (bf16_t*)(ws + OFF_VT);
    bf16_t* NVT = (bf16_t*)(ws + OFF_NVT);
    const float* qg = p.in[2] + layer * 64;
    const float* kg = p.in[3] + layer * 64;
    const int tid0 = otid();
    const int wave = __builtin_amdgcn_readfirstlane(tid0 >> 6), wn = wave & 1, wm = wave >> 1;
    constexpr int NT_N = PW / 256, NT_M = MTOK / 256;
    for (int t = vblock(); t < NT_N * NT_M; t += gridDim.x) {
        const int tm = t / NT_N, tn = t % NT_N;
        const int n0 = tn * 256, m0 = tm * 256;
        f32x16 acc[4][2];
        zero_acc<4, 2>(acc);
        gemm_kloop<4, 2>(acc, wt + (long)n0 * DM, DM, xb + (long)m0 * DM, XRow{DM}, DM, lds);
        __syncthreads();
        bf16_t* wl = lds + wave * (64 * 136);
        int lane = tid0 & 63; asm volatile("" : "+v"(lane));
        const int l32 = lane & 31, hi = lane >> 5;
        const int nbw = n0 + wn * 128;
        const int mw = m0 + wm * 64;
        bf16_t* pbase = P + (long)mw * PW + nbw;
        if (nbw < 640) {
            const float* gain = (nbw < 512) ? qg : kg;
#pragma unroll
            for (int hp = 0; hp < 2; ++hp)
#pragma unroll
            for (int mt = 0; mt < 2; ++mt) {
                const int tpos = (mw + mt * 32 + l32) & (SEQ - 1);
                float ss = 0.f;
#pragma unroll
                for (int nt = 0; nt < 2; ++nt)
#pragma unroll
                    for (int i = 0; i < 16; ++i) ss += acc[2 * hp + nt][mt][i] * acc[2 * hp + nt][mt][i];
                ss += xhalf(ss);
                const float rs = rsqrtf(ss * (1.0f / 64.0f) + 1e-6f) * ((nbw < 512) ? 0.125f * LOG2E : 1.0f);
#pragma unroll
                for (int nt = 0; nt < 2; ++nt) {
                    const float pos = (float)(nt == 0 ? (tpos >> 6) : (tpos & 63));
                    float v[16];
#pragma unroll
                    for (int q = 0; q < 4; ++q) {
                        const f32x4 g4 = *(const GAS f32x4*)(const GAS float*)(gain + nt * 32 + 8 * q + 4 * hi);
                        v[4 * q] = acc[2 * hp + nt][mt][4 * q] * rs * g4.x; v[4 * q + 1] = acc[2 * hp + nt][mt][4 * q + 1] * rs * g4.y;
                        v[4 * q + 2] = acc[2 * hp + nt][mt][4 * q + 2] * rs * g4.z; v[4 * q + 3] = acc[2 * hp + nt][mt][4 * q + 3] * rs * g4.w;
                    }
#pragma unroll
                    for (int i = 0; i < 8; ++i) {
                        const int j = 8 * (i >> 2) + 4 * hi + (i & 3);
                        const float inv = fexp2(-(float)j * 0.8304820237218406f);
                        const float ang = pos * inv;
                        const float c = __cosf(ang), sn = __sinf(ang);
                        const float x1 = v[i], x2 = v[i + 8];
                        v[i] = x1 * c - x2 * sn;
                        v[i + 8] = x2 * c + x1 * sn;
                    }
#pragma unroll
                    for (int q = 0; q < 4; ++q) {
                        u32x2 w; w.x = pk_bf16(v[4 * q], v[4 * q + 1]); w.y = pk_bf16(v[4 * q + 2], v[4 * q + 3]);
                        *(u32x2*)(wl + (mt * 32 + l32) * 136 + hp * 64 + nt * 32 + 8 * q + 4 * hi) = w;
                    }
                    __builtin_amdgcn_sched_barrier(0);
                }
            }
            wave_rows_out<4>(wl, pbase, PW, lane);
        } else if (nbw == 640 || (nbw >= 1792 && nbw < 2304)) {
            const int b = mw >> 13, tpos0 = mw & (SEQ - 1);
            bf16_t* base = (nbw == 640) ? VT + ((long)(b * 2) * 64) * SEQ + tpos0 : NVT + ((long)(b * 8 + ((nbw - 1792) >> 6)) * 64) * SEQ + tpos0;
            const unsigned voff = (unsigned)(4 * hi * SEQ + l32) * 2u;
#pragma unroll
            for (int mt = 0; mt < 2; ++mt)
#pragma unroll
                for (int nt = 0; nt < 4; ++nt)
#pragma unroll
                    for (int i = 0; i < 16; ++i)
                        gst2(base, voff + (unsigned)(((nt * 32 + 8 * (i >> 2) + (i & 3)) * SEQ + mt * 32) * 2), f2bf(acc[nt][mt][i]));
        } else {
#pragma unroll
            for (int mt = 0; mt < 2; ++mt)
#pragma unroll
                for (int nt = 0; nt < 4; ++nt)
#pragma unroll
                    for (int q = 0; q < 4; ++q) {
                        u32x2 w; w.x = pk_bf16(acc[nt][mt][4 * q], acc[nt][mt][4 * q + 1]); w.y = pk_bf16(acc[nt][mt][4 * q + 2], acc[nt][mt][4 * q + 3]);
                        *(u32x2*)(wl + (mt * 32 + l32) * 136 + nt * 32 + 8 * q + 4 * hi) = w;
                    }
            wave_rows_out<4>(wl, pbase, PW, lane);
        }
    }
}

DEVI void online_softmax(f32x16 (&s)[2], f32x16 (&o)[2], float& mrun, float& lrun, bf16x8 (&pb)[2][2]) {
    float mx = s[0][0];
#pragma unroll
    for (int kt = 0; kt < 2; ++kt)
#pragma unroll
        for (int i = 0; i < 16; ++i) mx = fmaxf(mx, s[kt][i]);
    mx = fmaxf(mx, xhalf(mx));
    const float mnew = fmaxf(mrun, mx);
    const float alpha = fexp2(mrun - mnew);
    mrun = mnew;
    float ps = 0.f;
#pragma unroll
    for (int kt = 0; kt < 2; ++kt)
#pragma unroll
        for (int i = 0; i < 16; ++i) { const float e = fexp2(s[kt][i] - mnew); s[kt][i] = e; ps += e; }
    lrun = lrun * alpha + ps;
#pragma unroll
    for (int dt = 0; dt < 2; ++dt)
#pragma unroll
        for (int i = 0; i < 16; ++i) o[dt][i] *= alpha;
#pragma unroll
    for (int kt = 0; kt < 2; ++kt)
#pragma unroll
        for (int sl = 0; sl < 2; ++sl) {
            u32x4 w;
            w.x = pk_bf16_m(s[kt][8 * sl + 0], s[kt][8 * sl + 1]); w.y = pk_bf16_m(s[kt][8 * sl + 2], s[kt][8 * sl + 3]);
            w.z = pk_bf16_m(s[kt][8 * sl + 4], s[kt][8 * sl + 5]); w.w = pk_bf16_m(s[kt][8 * sl + 6], s[kt][8 * sl + 7]);
            pb[kt][sl] = __builtin_bit_cast(bf16x8, w);
        }
}
DEVI int kperm(int r) { return (r & 16) + 8 * ((r >> 2) & 1) + 4 * ((r >> 3) & 1) + (r & 3); }

DEVI void gqa_unit(const Params& p, int layer, int unit, bf16_t* lds) {
    unsigned char* ws = ows(p);
    bf16_t* P = (bf16_t*)(ws + OFF_P);
    const bf16_t* VT = (const bf16_t*)(ws + OFF_VT);
    const int tid = otid(), lane = tid & 63, wave = tid >> 6, l32 = lane & 31, hi = lane >> 5;
    const int qb = unit & 31, h = (unit >> 5) & 7, b = unit >> 8, kvh = h >> 2;
    const int qrow = qb * 256 + wave * 32 + l32;
    bf16_t* Ks = lds;
    bf16_t* Vs = lds + 2 * 64 * LSTR;
    bf16x8 qf[4];
    {
        const bf16_t* qp = P + ((long)(b * SEQ + qrow)) * PW + CQ + h * 64 + hi * 8;
#pragma unroll
        for (int kk = 0; kk < 4; ++kk) qf[kk] = *(const bf16x8*)(qp + kk * 16);
    }
    float mb;
    {
        float gq = fabsf(p.in[2][layer * 64 + lane]), gk = fabsf(p.in[3][layer * 64 + lane]);
#pragma unroll
        for (int o2 = 1; o2 < 64; o2 <<= 1) { gq = fmaxf(gq, __shfl_xor(gq, o2)); gk = fmaxf(gk, __shfl_xor(gk, o2)); }
        mb = 8.0f * gq * gk * LOG2E * 1.01f;
    }
    const bf16_t* kbase = P + ((long)b * SEQ) * PW + CK + kvh * 64;
    const bf16_t* vbase = VT + ((long)(b * 2 + kvh) * 64) * SEQ;
    f32x16 o[2];
#pragma unroll
    for (int dt = 0; dt < 2; ++dt)
#pragma unroll
        for (int i = 0; i < 16; ++i) o[dt][i] = 0.f;
    float lrun = 0.f;
    u32x4 kreg[1], vreg[1];
#pragma unroll
    for (int i = 0; i < 1; ++i) {
        const int c = tid, r = c >> 3, cc = (c & 7) * 8;
        kreg[i] = gld16(kbase + (long)r * PW + cc);
        vreg[i] = gld16(vbase + (long)r * SEQ + cc);
    }
#pragma unroll
    for (int i = 0; i < 1; ++i) {
        const int c = tid, r = c >> 3, cc = (c & 7) * 8;
        *(u32x4*)(Ks + r * LSTR + cc) = kreg[i];
        *(u32x4*)(Vs + r * LSTR + cc) = vreg[i];
    }
    __syncthreads();
    const int kr = kperm(l32);
    for (int kt0 = 0; kt0 < SEQ / 64; ++kt0) {
        const int buf = kt0 & 1;
        const bool more = (kt0 + 1 < SEQ / 64);
        if (more) {
            const int key0 = (kt0 + 1) * 64;
#pragma unroll
            for (int i = 0; i < 1; ++i) {
                const int c = tid, r = c >> 3, cc = (c & 7) * 8;
                kreg[i] = gld16(kbase + (long)(key0 + r) * PW + cc);
                vreg[i] = gld16(vbase + (long)r * SEQ + key0 + cc);
            }
        }
        f32x16 s[2];
        bf16x8 kf[2][4], vf[2][2][2];
#pragma unroll
        for (int kt = 0; kt < 2; ++kt) {
            const bf16_t* kp = Ks + (buf * 64 + kt * 32 + kr) * LSTR + hi * 8;
#pragma unroll
            for (int kk = 0; kk < 4; ++kk) kf[kt][kk] = *(const bf16x8*)(kp + kk * 16);
        }
#pragma unroll
        for (int dt = 0; dt < 2; ++dt) {
            const bf16_t* vp = Vs + (buf * 64 + dt * 32 + l32) * LSTR + hi * 8;
#pragma unroll
            for (int kt = 0; kt < 2; ++kt)
#pragma unroll
                for (int sl = 0; sl < 2; ++sl) vf[dt][kt][sl] = *(const bf16x8*)(vp + kt * 32 + sl * 16);
        }
        __builtin_amdgcn_sched_barrier(0);
        __builtin_amdgcn_s_setprio(1);
#pragma unroll
        for (int kt = 0; kt < 2; ++kt) {
#pragma unroll
            for (int i = 0; i < 16; ++i) s[kt][i] = -mb;
#pragma unroll
            for (int kk = 0; kk < 4; ++kk) s[kt] = mfma32(kf[kt][kk], qf[kk], s[kt]);
        }
        __builtin_amdgcn_s_setprio(0);
        bf16x8 pb[2][2];
#pragma unroll
        for (int kt = 0; kt < 2; ++kt) {
#pragma unroll
            for (int i = 0; i < 16; ++i) { const float e = fexp2(s[kt][i]); s[kt][i] = e; lrun += e; }
#pragma unroll
            for (int sl = 0; sl < 2; ++sl) {
                u32x4 w;
                w.x = pk_bf16_m(s[kt][8 * sl + 0], s[kt][8 * sl + 1]); w.y = pk_bf16_m(s[kt][8 * sl + 2], s[kt][8 * sl + 3]);
                w.z = pk_bf16_m(s[kt][8 * sl + 4], s[kt][8 * sl + 5]); w.w = pk_bf16_m(s[kt][8 * sl + 6], s[kt][8 * sl + 7]);
                pb[kt][sl] = __builtin_bit_cast(bf16x8, w);
            }
        }
#pragma unroll
        for (int dt = 0; dt < 2; ++dt)
#pragma unroll
            for (int kt = 0; kt < 2; ++kt)
#pragma unroll
                for (int sl = 0; sl < 2; ++sl) o[dt] = mfma32(vf[dt][kt][sl], pb[kt][sl], o[dt]);
        if (more) {
            const int nb = buf ^ 1;
#pragma unroll
            for (int i = 0; i < 1; ++i) {
                const int c = tid, r = c >> 3, cc = (c & 7) * 8;
                *(u32x4*)(Ks + (nb * 64 + r) * LSTR + cc) = kreg[i];
                *(u32x4*)(Vs + (nb * 64 + r) * LSTR + cc) = vreg[i];
            }
        }
        __syncthreads();
    }
    lrun += xhalf(lrun);
    const float inv = 1.0f / lrun;
    bf16_t* op = P + ((long)(b * SEQ + qrow)) * PW + CQ + h * 64;
#pragma unroll
    for (int dt = 0; dt < 2; ++dt)
#pragma unroll
        for (int q = 0; q < 4; ++q) {
            u32x2 w; w.x = pk_bf16(o[dt][4 * q] * inv, o[dt][4 * q + 1] * inv); w.y = pk_bf16(o[dt][4 * q + 2] * inv, o[dt][4 * q + 3] * inv);
            *(u32x2*)(op + dt * 32 + 8 * q + 4 * hi) = w;
        }
}

DEVI void nat_block_unit(const Params& p, int layer, int unit, bf16_t* lds) {
    unsigned char* ws = ows(p);
    bf16_t* P = (bf16_t*)(ws + OFF_P);
    const bf16_t* NVT = (const bf16_t*)(ws + OFF_NVT);
    const float* bias = p.in[4] + (long)layer * 8 * 15 * 31;
    const int tid = otid(), lane = tid & 63, wave = __builtin_amdgcn_readfirstlane(tid >> 6), l32 = lane & 31, hi = lane >> 5;
    const int wu = unit * NWAVES + wave;
    const int qt = wu & 1, h = (wu >> 1) & 7, r = (wu >> 4) & 127, b = wu >> 11;
    const int h0 = (unit * 4) & 7;
    float* bl = (float*)lds;
    for (int e = tid; e < 4 * 465; e += NTHREADS) bl[e] = bias[h0 * 465 + e];
    __syncthreads();
    const float* bh = bl + (h - h0) * 465;
    int rs = r - 4; rs = rs < 0 ? 0 : (rs > 120 ? 120 : rs);
    const int qc = qt * 32 + l32;
    int cs = qc - 8; cs = cs < 0 ? 0 : (cs > 48 ? 48 : cs);
    const long tok0 = (long)b * SEQ;
    bf16x8 qf[4];
    {
        const bf16_t* qp = P + (tok0 + r * 64 + qc) * PW + CNQ + h * 64 + hi * 8;
#pragma unroll
        for (int kk = 0; kk < 4; ++kk) qf[kk] = gld16b(qp + kk * 16);
    }
    f32x16 o[2];
#pragma unroll
    for (int dt = 0; dt < 2; ++dt)
#pragma unroll
        for (int i = 0; i < 16; ++i) o[dt][i] = 0.f;
    float mrun = -INFINITY, lrun = 0.f;
    const int kr = kperm(l32);
    constexpr float C = 0.125f * LOG2E;
    const bf16_t* kbase = P + (tok0 + kr) * PW + CNK + h * 64 + hi * 8;
    const bf16_t* vbase = NVT + ((long)(b * 8 + h) * 64 + l32) * SEQ + hi * 8;
    bf16_t* wl = (bf16_t*)((unsigned char*)lds + 8192) + wave * (64 * LSTR);
    const int srow = lane >> 3, scol = (lane & 7) * 8;
    const bf16_t* kg = P + (tok0 + srow) * PW + CNK + h * 64 + scol;
    const bf16_t* vg = NVT + ((long)(b * 8 + h) * 64 + srow) * SEQ + scol;
    u32x4 kst[8], vst[8];
#define NAT_LOADK(krow) do { _Pragma("unroll") for (int i = 0; i < 8; ++i) kst[i] = gld16(kg + (long)((krow) * 64 + 8 * i) * PW); } while (0)
#define NAT_LOADV(krow) do { _Pragma("unroll") for (int i = 0; i < 8; ++i) vst[i] = gld16(vg + (long)(8 * i) * SEQ + (krow) * 64); } while (0)
    NAT_LOADK(rs);
    NAT_LOADV(rs);
#pragma unroll 1
    for (int ir = 0; ir < 8; ++ir) {
        const int krow = rs + ir;
        const int nrow = (ir < 7) ? krow + 1 : krow;
        const float* brow = bh + (krow - r + 7) * 31 + 15 - qc;
        bf16x8 kf[2][4], vf[2][2][2];
#pragma unroll
        for (int i = 0; i < 8; ++i) *(u32x4*)(wl + (srow + 8 * i) * LSTR + scol) = kst[i];
        __builtin_amdgcn_sched_barrier(0);
#pragma unroll
        for (int kt = 0; kt < 2; ++kt)
#pragma unroll
            for (int kk = 0; kk < 4; ++kk) kf[kt][kk] = *(const bf16x8*)(wl + (kt * 32 + kr) * LSTR + hi * 8 + kk * 16);
        __builtin_amdgcn_sched_barrier(0);
        NAT_LOADK(nrow);
        f32x16 s[2];
#pragma unroll
        for (int kt = 0; kt < 2; ++kt) {
#pragma unroll
            for (int i = 0; i < 16; ++i) s[kt][i] = 0.f;
#pragma unroll
            for (int kk = 0; kk < 4; ++kk) s[kt] = mfma32(kf[kt][kk], qf[kk], s[kt]);
        }
        __builtin_amdgcn_sched_barrier(0);
#pragma unroll
        for (int i = 0; i < 8; ++i) *(u32x4*)(wl + (srow + 8 * i) * LSTR + scol) = vst[i];
        __builtin_amdgcn_sched_barrier(0);
#pragma unroll
        for (int dt = 0; dt < 2; ++dt)
#pragma unroll
            for (int kt = 0; kt < 2; ++kt)
#pragma unroll
                for (int sl = 0; sl < 2; ++sl) vf[dt][kt][sl] = *(const bf16x8*)(wl + (dt * 32 + l32) * LSTR + hi * 8 + kt * 32 + sl * 16);
        __builtin_amdgcn_sched_barrier(0);
        NAT_LOADV(nrow);
        float mx = -INFINITY;
#pragma unroll
        for (int g4 = 0; g4 < 4; ++g4) {
            const int kt = g4 >> 1, sl = g4 & 1;
            const bool dead = (g4 == 3 && qt == 0) || (g4 == 0 && qt == 1);
            if (!dead) {
#pragma unroll
                for (int e = 0; e < 8; ++e) {
                    const int i = sl * 8 + e;
                    const int kc = kt * 32 + 16 * sl + 8 * hi + e;
                    const bool valid = (kc >= cs) && (kc < cs + 16);
                    const float bv = brow[valid ? kc : qc];
                    const float v = valid ? (s[kt][i] * C + bv * LOG2E) : -INFINITY;
                    s[kt][i] = v; mx = fmaxf(mx, v);
                }
            }
        }
        mx = fmaxf(mx, xhalf(mx));
        const float mnew = fmaxf(mrun, mx);
        const float alpha = fexp2(mrun - mnew);
        mrun = mnew;
        float ps = 0.f;
        bf16x8 pb[2][2];
#pragma unroll
        for (int g4 = 0; g4 < 4; ++g4) {
            const int kt = g4 >> 1, sl = g4 & 1;
            const bool dead = (g4 == 3 && qt == 0) || (g4 == 0 && qt == 1);
            if (!dead) {
                float pe[8];
#pragma unroll
                for (int e = 0; e < 8; ++e) { pe[e] = fexp2(s[kt][sl * 8 + e] - mnew); ps += pe[e]; }
                u32x4 w;
                w.x = pk_bf16_m(pe[0], pe[1]); w.y = pk_bf16_m(pe[2], pe[3]); w.z = pk_bf16_m(pe[4], pe[5]); w.w = pk_bf16_m(pe[6], pe[7]);
                pb[kt][sl] = __builtin_bit_cast(bf16x8, w);
            }
        }
        lrun = lrun * alpha + ps;
#pragma unroll
        for (int dt = 0; dt < 2; ++dt)
#pragma unroll
            for (int i = 0; i < 16; ++i) o[dt][i] *= alpha;
#pragma unroll
        for (int g4 = 0; g4 < 4; ++g4) {
            const int kt = g4 >> 1, sl = g4 & 1;
            const bool dead = (g4 == 3 && qt == 0) || (g4 == 0 && qt == 1);
            if (!dead) {
#pragma unroll
                for (int dt = 0; dt < 2; ++dt) o[dt] = mfma32(vf[dt][kt][sl], pb[kt][sl], o[dt]);
            }
        }
        __builtin_amdgcn_sched_barrier(0);
    }
#undef NAT_LOADK
#undef NAT_LOADV
    lrun += xhalf(lrun);
    const float inv = 1.0f / lrun;
    bf16_t* op = P + (tok0 + r * 64 + qc) * PW + CNQ + h * 64;
#pragma unroll
    for (int dt = 0; dt < 2; ++dt)
#pragma unroll
        for (int q = 0; q < 4; ++q) {
            u32x2 w; w.x = pk_bf16(o[dt][4 * q] * inv, o[dt][4 * q + 1] * inv); w.y = pk_bf16(o[dt][4 * q + 2] * inv, o[dt][4 * q + 3] * inv);
            *(u32x2*)(op + dt * 32 + 8 * q + 4 * hi) = w;
        }
}

DEVI void s5z_tile(const Params& p, int layer, int t, bf16_t* lds) {
    unsigned char* ws = ows(p);
    const bf16_t* P = (const bf16_t*)(ws + OFF_P);
    const bf16_t* Zt = (const bf16_t*)(ws + OFF_S5 + layer * S5_LAYER + S5_ZT);
    float* ZS = (float*)(ws + OFF_ZS);
    const int lane = otid() & 63, wave = __builtin_amdgcn_readfirstlane(otid() >> 6), wn = wave & 1, wm = wave >> 1, l32 = lane & 31, hi = lane >> 5;
    const int g = t >> 2, tm = t & 3;
    const int m0 = tm * 256;
    f32x16 acc[4][2];
    zero_acc<4, 2>(acc);
    gemm_kloop<4, 2>(acc, Zt + ((long)g * 256) * 512, 512, P + ((long)m0 * 32) * PW + CSU + g * 16, XS5{}, 512, lds);
#pragma unroll
    for (int mt = 0; mt < 2; ++mt) {
        const int R = m0 + wm * 64 + mt * 32 + l32, b = R >> 8, c = R & 255;
        float* zp = ZS + ((long)((b * 32 + g) * 256 + c)) * 256 + wn * 128;
#pragma unroll
        for (int nt = 0; nt < 4; ++nt)
#pragma unroll
            for (int q = 0; q < 4; ++q) {
                f32x4 v = {acc[nt][mt][4 * q], acc[nt][mt][4 * q + 1], acc[nt][mt][4 * q + 2], acc[nt][mt][4 * q + 3]};
                *(f32x4*)(zp + nt * 32 + 8 * q + 4 * hi) = v;
            }
    }
}


DEVI void scan_wave_unit(const Params& p, int layer, int b, int g, int dir) {
    unsigned char* ws = ows(p);
    const float* ZS = (const float*)(ws + OFF_ZS);
    bf16_t* SP = (bf16_t*)(ws + OFF_SPREV);
    const f32x2* LT = (const f32x2*)(ws + OFF_S5 + layer * S5_LAYER + S5_LAMT);
    const int lane = otid() & 63;
    const f32x2 lt = LT[(dir * 32 + g) * 64 + lane];
    const long base = ((long)(b * 32 + g) * 256) * 256 + dir * 128 + lane;
    float sr = 0.f, si = 0.f;
    for (int cb = 0; cb < 16; ++cb) {
        float zr[16], zi[16];
#pragma unroll
        for (int i = 0; i < 16; ++i) {
            const int cc = cb * 16 + i, c = dir ? 255 - cc : cc;
            zr[i] = ZS[base + (long)c * 256]; zi[i] = ZS[base + (long)c * 256 + 64];
        }
#pragma unroll
        for (int i = 0; i < 16; ++i) {
            const int cc = cb * 16 + i, c = dir ? 255 - cc : cc;
            SP[base + (long)c * 256] = f2bf(sr); SP[base + (long)c * 256 + 64] = f2bf(si);
            const float nr = lt.x * sr - lt.y * si + zr[i], ni = lt.x * si + lt.y * sr + zi[i];
            sr = nr; si = ni;
        }
    }
}

DEVI void s5c_tile(const Params& p, int layer, int t, bf16_t* lds) {
    unsigned char* ws = ows(p);
    const bf16_t* P = (const bf16_t*)(ws + OFF_P);
    const bf16_t* SP = (const bf16_t*)(ws + OFF_SPREV);
    const bf16_t* Bt = (const bf16_t*)(ws + OFF_S5 + layer * S5_LAYER + S5_BT);
    bf16_t* ZB = (bf16_t*)(ws + OFF_ZB);
    const int lane = otid() & 63, wave = __builtin_amdgcn_readfirstlane(otid() >> 6), wn = wave & 1, wm = wave >> 1, l32 = lane & 31, hi = lane >> 5;
    {
        const int g = t >> 3, tm = (t >> 1) & 3, tn = t & 1;
        const int n0 = tn * 256, m0 = tm * 256;
        f32x16 acc[4][2];
        zero_acc<4, 2>(acc);
        gemm_kloop<4, 2>(acc, Bt + ((long)g * 512 + n0) * 768, 768, P + ((long)m0 * 32) * PW + CSU + g * 16, XS5{}, 512, lds);
        gemm_kloop<4, 2>(acc, Bt + ((long)g * 512 + n0) * 768 + 512, 768, SP + ((long)(((m0 >> 8) * 32 + g) * 256)) * 256, XRow{256}, 256, lds);
#pragma unroll
        for (int mt = 0; mt < 2; ++mt) {
            const int R = m0 + wm * 64 + mt * 32 + l32;
#pragma unroll
            for (int nt = 0; nt < 4; ++nt)
#pragma unroll
                for (int q = 0; q < 4; ++q) {
                    const int n = n0 + wn * 128 + nt * 32 + 8 * q + 4 * hi;
                    u32x2 w;
                    w.x = pk_bf16(gelu_tanh(acc[nt][mt][4 * q]), gelu_tanh(acc[nt][mt][4 * q + 1]));
                    w.y = pk_bf16(gelu_tanh(acc[nt][mt][4 * q + 2]), gelu_tanh(acc[nt][mt][4 * q + 3]));
                    *(u32x2*)(ZB + ((long)R * 32 + (n >> 4)) * 512 + g * 16 + (n & 15)) = w;
                }
        }
    }
}

DEVI void glu_tile(const Params& p, int layer, int t, bf16_t* lds) {
    unsigned char* ws = ows(p);
    bf16_t* P = (bf16_t*)(ws + OFF_P);
    const bf16_t* ZB = (const bf16_t*)(ws + OFF_ZB);
    const bf16_t* wt = (const bf16_t*)(ws + OFF_W + layer * W_LAYER + W_GLU);
    const int lane = otid() & 63, wave = __builtin_amdgcn_readfirstlane(otid() >> 6), wn = wave & 1, wm = wave >> 1, l32 = lane & 31, hi = lane >> 5;
    {
        const int tm = t >> 1, tn = t & 1;
        const int n0 = tn * 256, m0 = tm * 256;
        f32x16 acc[4][2];
        zero_acc<4, 2>(acc);
        gemm_kloop<4, 2>(acc, wt + (long)n0 * 512, 512, ZB + (long)m0 * 512, XRow{512}, 512, lds);
#pragma unroll
        for (int mt = 0; mt < 2; ++mt) {
            const int m = m0 + wm * 64 + mt * 32 + l32;
#pragma unroll
            for (int nt = 0; nt < 4; ++nt)
#pragma unroll
                for (int q = 0; q < 4; ++q) {
                    const int n = n0 + wn * 128 + nt * 32 + 8 * q + 4 * hi;
                    const u32x2 zz = *(const u32x2*)(ZB + (long)m * 512 + n);
                    const float z0 = bf2f(zz.x & 0xffffu), z1 = bf2f(zz.x >> 16), z2 = bf2f(zz.y & 0xffffu), z3 = bf2f(zz.y >> 16);
                    u32x2 w;
                    w.x = pk_bf16(z0 * sigmoidf_(acc[nt][mt][4 * q]), z1 * sigmoidf_(acc[nt][mt][4 * q + 1]));
                    w.y = pk_bf16(z2 * sigmoidf_(acc[nt][mt][4 * q + 2]), z3 * sigmoidf_(acc[nt][mt][4 * q + 3]));
                    *(u32x2*)(P + (long)m * PW + CSU + n) = w;
                }
        }
    }
}

DEVI int queue_grab(unsigned* ctr, volatile unsigned* slot, int tid) {
    asm volatile("s_waitcnt vmcnt(0)" ::: "memory");
    __syncthreads();
    if (tid == 0) *slot = __hip_atomic_fetch_add(ctr, 1u, __ATOMIC_RELAXED, __HIP_MEMORY_SCOPE_AGENT);
    __syncthreads();
    return (int)*slot;
}
DEVI void phase_mixers(const Params& p, int layer, bf16_t* lds) {
    unsigned char* ws = ows(p);
    unsigned* ctl = (unsigned*)(ws + OFF_CTL);
    unsigned* q = ctl + 64 + layer * 320;
    unsigned* done = ctl + 704 + layer * 64;
    volatile unsigned* slot = (volatile unsigned*)((unsigned char*)lds + LDS_BYTES - 16);
    const int tid = otid();
    const int wave = __builtin_amdgcn_readfirstlane(tid >> 6);
    const int xcd = (int)(__builtin_amdgcn_s_getreg((3 << 11) | 20) & 7u);
    int u;
    while ((u = queue_grab(q, slot, tid)) < 128) {
        const int g = u >> 2, b = u & 3;
        s5z_tile(p, layer, u, lds);
        asm volatile("s_waitcnt vmcnt(0)" ::: "memory");
        __syncthreads();
        __builtin_amdgcn_fence(__ATOMIC_ACQUIRE, "agent");
        if (wave < 2) scan_wave_unit(p, layer, b, g, wave);
        asm volatile("s_waitcnt vmcnt(0)" ::: "memory");
        __syncthreads();
        __builtin_amdgcn_fence(__ATOMIC_ACQUIRE, "agent");
        s5c_tile(p, layer, (g << 3) + (b << 1), lds);
        s5c_tile(p, layer, (g << 3) + (b << 1) + 1, lds);
        asm volatile("s_waitcnt vmcnt(0)" ::: "memory");
        __syncthreads();
        if (tid == 0) {
            __builtin_amdgcn_fence(__ATOMIC_RELEASE, "agent");
            asm volatile("s_waitcnt vmcnt(0)" ::: "memory");
            __hip_atomic_fetch_add(done + b * 16, 1u, __ATOMIC_RELAXED, __HIP_MEMORY_SCOPE_AGENT);
        }
    }
#pragma unroll 1
    for (int j8 = 0; j8 < 8; ++j8) {
        const int xs = (xcd + j8) & 7;
        while ((u = queue_grab(q + 16 * (1 + xs), slot, tid)) < 128)
            gqa_unit(p, layer, ((xs >> 1) << 8) | ((((xs & 1) << 2) | (u & 3)) << 5) | (u >> 2), lds);
    }
    while ((u = queue_grab(q + 16 * 9, slot, tid)) < 256) {
        const int b = u >> 6;
        if (tid == 0) {
            while (__hip_atomic_load(done + b * 16, __ATOMIC_RELAXED, __HIP_MEMORY_SCOPE_AGENT) < 32u) __builtin_amdgcn_s_sleep(8);
            __builtin_amdgcn_fence(__ATOMIC_ACQUIRE, "agent");
            asm volatile("s_waitcnt vmcnt(0)" ::: "memory");
        }
        __syncthreads();
        glu_tile(p, layer, u, lds);
    }
#pragma unroll 1
    for (int j8 = 0; j8 < 8; ++j8) {
        const int xs = (xcd + j8) & 7;
        while ((u = queue_grab(q + 16 * (10 + xs), slot, tid)) < 128)
            nat_block_unit(p, layer, ((xs >> 1) << 8) | (u << 1) | (xs & 1), lds);
    }
}

DEVI void phase_merge(const Params& p, int layer, bf16_t* lds) {
    unsigned char* ws = ows(p);
    const bf16_t* P = (const bf16_t*)(ws + OFF_P);
    const bf16_t* xb = (const bf16_t*)(ws + OFF_XB);
    const bf16_t* wg = (const bf16_t*)(ws + OFF_W + layer * W_LAYER + W_IN) + (long)PW * DM;
    const bf16_t* wbr = (const bf16_t*)(ws + OFF_W + layer * W_LAYER + W_BR);
    bf16_t* MG = (bf16_t*)(ws + OFF_MERGED);
    const int lane = otid() & 63, wave = __builtin_amdgcn_readfirstlane(otid() >> 6), wn = wave & 1, wm = wave >> 1, l32 = lane & 31, hi = lane >> 5;
    for (int t = vblock(); t < 8 * 128; t += gridDim.x) {
        const int tm = t >> 3, tn = t & 7;
        const int n0 = tn * 128, m0 = tm * 256;
        f32x16 mg[2][2];
        zero_acc<2, 2>(mg);
#pragma unroll 1
        for (int br = 0; br < 3; ++br) {
            const int bcol = (br == 0) ? CQ : (br == 1 ? CNQ : CSU);
            f32x16 acc[2][2];
            unsigned sg[2][2][8];
            zero_acc<2, 2>(acc);
            gemm_kloop<2, 2>(acc, wg + ((long)br * DM + n0) * DM, DM, xb + (long)m0 * DM, XRow{DM}, DM, lds);
#pragma unroll
            for (int nt = 0; nt < 2; ++nt)
#pragma unroll
                for (int mt = 0; mt < 2; ++mt)
#pragma unroll
                    for (int i = 0; i < 8; ++i) sg[nt][mt][i] = pk_bf16(sigmoidf_(acc[nt][mt][2 * i]), sigmoidf_(acc[nt][mt][2 * i + 1]));
            zero_acc<2, 2>(acc);
            gemm_kloop<2, 2>(acc, wbr + ((long)br * DM + n0) * 512, 512, P + (long)m0 * PW + bcol, XRow{PW}, 512, lds);
#pragma unroll
            for (int nt = 0; nt < 2; ++nt)
#pragma unroll
                for (int mt = 0; mt < 2; ++mt)
#pragma unroll
                    for (int i = 0; i < 8; ++i) {
                        mg[nt][mt][2 * i] += bf2f(sg[nt][mt][i] & 0xffffu) * acc[nt][mt][2 * i];
                        mg[nt][mt][2 * i + 1] += bf2f(sg[nt][mt][i] >> 16) * acc[nt][mt][2 * i + 1];
                    }
        }
        __syncthreads();
        bf16_t* wl = lds + wave * (64 * 72);
#pragma unroll
        for (int mt = 0; mt < 2; ++mt)
#pragma unroll
            for (int nt = 0; nt < 2; ++nt)
#pragma unroll
                for (int q = 0; q < 4; ++q) {
                    u32x2 w; w.x = pk_bf16(mg[nt][mt][4 * q], mg[nt][mt][4 * q + 1]); w.y = pk_bf16(mg[nt][mt][4 * q + 2], mg[nt][mt][4 * q + 3]);
                    *(u32x2*)(wl + (mt * 32 + l32) * 72 + nt * 32 + 8 * q + 4 * hi) = w;
                }
        wave_rows_out<2>(wl, MG + (long)(m0 + wm * 64) * DM + n0 + wn * 64, DM, lane);
    }
}

DEVI void phase_res_gemm_ln(const bf16_t* A, int K, const bf16_t* wt, float* out, bf16_t* xb, const float* gain, const float* bias,
                            f32x2* stats, unsigned* cnt, bf16_t* lds, bool rev = false) {
    const int tid = otid(), lane = tid & 63, wave = __builtin_amdgcn_readfirstlane(tid >> 6), wn = wave & 1, wm = wave >> 1, l32 = lane & 31, hi = lane >> 5;
    for (int t = vblock(); t < 4 * 128; t += gridDim.x) {
        const int tm = rev ? 127 - (t >> 2) : (t >> 2), tn = t & 3;
        const int n0 = tn * 256, m0 = tm * 256;
        f32x16 acc[4][2];
        zero_acc<4, 2>(acc);
        gemm_kloop<4, 2>(acc, wt + (long)n0 * K, K, A + (long)m0 * K, XRow{K}, K, lds);
#pragma unroll
        for (int mt = 0; mt < 2; ++mt) {
            const int m = m0 + wm * 64 + mt * 32 + l32;
            float s1 = 0.f, s2 = 0.f;
#pragma unroll
            for (int nt = 0; nt < 4; ++nt)
#pragma unroll
                for (int q = 0; q < 4; ++q) {
                    const long idx = (long)m * DM + n0 + wn * 128 + nt * 32 + 8 * q + 4 * hi;
                    const u32x2 rr = *(const u32x2*)(xb + idx);
                    const float r[4] = {bf2f(rr.x & 0xffffu), bf2f(rr.x >> 16), bf2f(rr.y & 0xffffu), bf2f(rr.y >> 16)};
#pragma unroll
                    for (int e = 0; e < 4; ++e) {
                        const float v = ALPHA * r[e] + acc[nt][mt][4 * q + e];
                        acc[nt][mt][4 * q + e] = v; s1 += v; s2 += v * v;
                    }
                }
            s1 += xhalf(s1); s2 += xhalf(s2);
            if (hi == 0) stats[(long)m * 8 + tn * 2 + wn] = (f32x2){s1, s2};
        }
        asm volatile("s_waitcnt vmcnt(0)" ::: "memory");
        __syncthreads();
        if (tid == 0) {
            __builtin_amdgcn_fence(__ATOMIC_RELEASE, "agent");
            asm volatile("s_waitcnt vmcnt(0)" ::: "memory");
            __hip_atomic_fetch_add(cnt + tm, 1u, __ATOMIC_RELAXED, __HIP_MEMORY_SCOPE_AGENT);
            while (__hip_atomic_load(cnt + tm, __ATOMIC_RELAXED, __HIP_MEMORY_SCOPE_AGENT) < 4u) __builtin_amdgcn_s_sleep(1);
            __builtin_amdgcn_fence(__ATOMIC_ACQUIRE, "agent");
            asm volatile("s_waitcnt vmcnt(0)" ::: "memory");
        }
        __syncthreads();
        float mu[2], rstd[2];
#pragma unroll
        for (int mt = 0; mt < 2; ++mt) {
            const int m = m0 + wm * 64 + mt * 32 + l32;
            float s1 = 0.f, s2 = 0.f;
#pragma unroll
            for (int j = 0; j < 8; ++j) { const f32x2 pj = *(const GAS f32x2*)(const GAS void*)(stats + (long)m * 8 + j); s1 += pj.x; s2 += pj.y; }
            mu[mt] = s1 * (1.0f / DM);
            const float var = fmaxf(s2 * (1.0f / DM) - mu[mt] * mu[mt], 0.f);
            rstd[mt] = rsqrtf(var + 1e-5f);
        }
#pragma unroll
        for (int nt = 0; nt < 4; ++nt) {
#pragma unroll
            for (int q = 0; q < 4; ++q) {
                const int n = n0 + wn * 128 + nt * 32 + 8 * q + 4 * hi;
                const f32x4 g4 = *(const GAS f32x4*)(const GAS float*)(gain + n), b4 = *(const GAS f32x4*)(const GAS float*)(bias + n);
#pragma unroll
                for (int mt = 0; mt < 2; ++mt) {
                    acc[nt][mt][4 * q] = (acc[nt][mt][4 * q] - mu[mt]) * rstd[mt] * g4.x + b4.x; acc[nt][mt][4 * q + 1] = (acc[nt][mt][4 * q + 1] - mu[mt]) * rstd[mt] * g4.y + b4.y;
                    acc[nt][mt][4 * q + 2] = (acc[nt][mt][4 * q + 2] - mu[mt]) * rstd[mt] * g4.z + b4.z; acc[nt][mt][4 * q + 3] = (acc[nt][mt][4 * q + 3] - mu[mt]) * rstd[mt] * g4.w + b4.w;
                }
            }
            __builtin_amdgcn_sched_barrier(0);
        }
        __builtin_amdgcn_sched_barrier(0);
        if (out) {
#pragma unroll
            for (int mt = 0; mt < 2; ++mt) {
                float* orow = out + (long)(m0 + wm * 64 + mt * 32 + l32) * DM + n0 + wn * 128 + 4 * hi;
#pragma unroll
                for (int nt = 0; nt < 4; ++nt)
#pragma unroll
                    for (int q = 0; q < 4; ++q)
                        *(f32x4*)(orow + nt * 32 + 8 * q) = (f32x4){acc[nt][mt][4 * q], acc[nt][mt][4 * q + 1], acc[nt][mt][4 * q + 2], acc[nt][mt][4 * q + 3]};
            }
        } else {
            bf16_t* wl = lds + wave * (64 * 136);
#pragma unroll
            for (int mt = 0; mt < 2; ++mt)
#pragma unroll
                for (int nt = 0; nt < 4; ++nt)
#pragma unroll
                    for (int q = 0; q < 4; ++q) {
                        u32x2 w; w.x = pk_bf16(acc[nt][mt][4 * q], acc[nt][mt][4 * q + 1]); w.y = pk_bf16(acc[nt][mt][4 * q + 2], acc[nt][mt][4 * q + 3]);
                        *(u32x2*)(wl + (mt * 32 + l32) * 136 + nt * 32 + 8 * q + 4 * hi) = w;
                    }
            wave_rows_out<4>(wl, xb + (long)(m0 + wm * 64) * DM + n0 + wn * 128, DM, lane);
        }
    }
}

DEVI void phase_ffn_up(const Params& p, int layer, bf16_t* lds) {
    unsigned char* ws = ows(p);
    const bf16_t* xb = (const bf16_t*)(ws + OFF_XB);
    const bf16_t* wt = (const bf16_t*)(ws + OFF_W + layer * W_LAYER + W_UP);
    bf16_t* H = (bf16_t*)(ws + OFF_H);
    const int lane = otid() & 63, wave = __builtin_amdgcn_readfirstlane(otid() >> 6), wn = wave & 1, wm = wave >> 1, l32 = lane & 31, hi = lane >> 5;
    for (int t = vblock(); t < 16 * 128; t += gridDim.x) {
        const int v8 = t & 255, grp = v8 >> 5, w5 = v8 & 31;
        const int tm = (t >> 8) * 16 + (grp & 3) * 4 + (w5 & 3), tn = (grp >> 2) * 8 + (w5 >> 2);
        const int n0 = tn * 256, m0 = tm * 256;
        f32x16 acc[4][2];
        zero_acc<4, 2>(acc);
        gemm_kloop<4, 2>(acc, wt + (long)n0 * DM, DM, xb + (long)m0 * DM, XRow{DM}, DM, lds);
        __syncthreads();
        bf16_t* wl = lds + wave * (64 * 136);
#pragma unroll
        for (int mt = 0; mt < 2; ++mt)
#pragma unroll
            for (int nt = 0; nt < 4; ++nt)
#pragma unroll
                for (int q = 0; q < 4; ++q) {
                    float v[4];
#pragma unroll
                    for (int e = 0; e < 4; ++e) { const float a = fmaxf(acc[nt][mt][4 * q + e], 0.f); v[e] = a * a; }
                    u32x2 w; w.x = pk_bf16(v[0], v[1]); w.y = pk_bf16(v[2], v[3]);
                    *(u32x2*)(wl + (mt * 32 + l32) * 136 + nt * 32 + 8 * q + 4 * hi) = w;
                }
        wave_rows_out<4>(wl, H + (long)(m0 + wm * 64) * FFN + n0 + wn * 128, FFN, lane);
    }
}

DEVI void phase_ln(const float* src, float* dst, bf16_t* xb, const float* gain, const float* bias) {
    const int lane = otid() & 63, wave = otid() >> 6;
    for (int row = blockIdx.x * NWAVES + wave; row < MTOK; row += gridDim.x * NWAVES) {
        const float* s = src + (long)row * DM;
        f32x4 v[4];
#pragma unroll
        for (int i = 0; i < 4; ++i) v[i] = *(const f32x4*)(s + i * 256 + lane * 4);
        float sum = 0.f;
#pragma unroll
        for (int i = 0; i < 4; ++i) sum += v[i].x + v[i].y + v[i].z + v[i].w;
#pragma unroll
        for (int o = 1; o < 64; o <<= 1) sum += __shfl_xor(sum, o);
        const float mu = sum * (1.0f / DM);
        float sq = 0.f;
#pragma unroll
        for (int i = 0; i < 4; ++i) { v[i].x -= mu; v[i].y -= mu; v[i].z -= mu; v[i].w -= mu; sq += v[i].x * v[i].x + v[i].y * v[i].y + v[i].z * v[i].z + v[i].w * v[i].w; }
#pragma unroll
        for (int o = 1; o < 64; o <<= 1) sq += __shfl_xor(sq, o);
        const float rstd = rsqrtf(sq * (1.0f / DM) + 1e-5f);
#pragma unroll
        for (int i = 0; i < 4; ++i) {
            const int c = i * 256 + lane * 4;
            const f32x4 g = *(const f32x4*)(gain + c), bb = *(const f32x4*)(bias + c);
            f32x4 y;
            y.x = v[i].x * rstd * g.x + bb.x; y.y = v[i].y * rstd * g.y + bb.y; y.z = v[i].z * rstd * g.z + bb.z; y.w = v[i].w * rstd * g.w + bb.w;
            *(f32x4*)(dst + (long)row * DM + c) = y;
            u32x2 w; w.x = pk_bf16(y.x, y.y); w.y = pk_bf16(y.z, y.w);
            *(u32x2*)(xb + (long)row * DM + c) = w;
        }
    }
}

DEVI void transpose_mat(const float* src, int K, int N, bf16_t* dst, float* tl) {
    const int tid = otid();
    const int tk = K / 64, tn = N / 64;
    for (int t = blockIdx.x; t < tk * tn; t += gridDim.x) {
        const int k0 = (t / tn) * 64, n0 = (t % tn) * 64;
        __syncthreads();
#pragma unroll
        for (int i = 0; i < 2; ++i) {
            const int e = tid + 512 * i, r = e >> 4, c4 = (e & 15) * 4;
            const f32x4 v = *(const f32x4*)(src + (long)(k0 + r) * N + n0 + c4);
            tl[r * 65 + c4] = v.x; tl[r * 65 + c4 + 1] = v.y; tl[r * 65 + c4 + 2] = v.z; tl[r * 65 + c4 + 3] = v.w;
        }
        __syncthreads();
#pragma unroll
        for (int i = 0; i < 1; ++i) {
            const int e = tid, n = e >> 3, kc = (e & 7) * 8;
            u32x4 w;
            w.x = pk_bf16(tl[(kc + 0) * 65 + n], tl[(kc + 1) * 65 + n]); w.y = pk_bf16(tl[(kc + 2) * 65 + n], tl[(kc + 3) * 65 + n]);
            w.z = pk_bf16(tl[(kc + 4) * 65 + n], tl[(kc + 5) * 65 + n]); w.w = pk_bf16(tl[(kc + 6) * 65 + n], tl[(kc + 7) * 65 + n]);
            *(u32x4*)(dst + (long)(n0 + n) * K + k0 + kc) = w;
        }
    }
}

struct Cx { float re, im; };
DEVI Cx cmul(Cx a, Cx b) { return {a.re * b.re - a.im * b.im, a.re * b.im + a.im * b.re}; }
DEVI Cx lam_pow(float are, float aim, float dt, float n) {
    const float mag = fexp2(are * dt * n * LOG2E);
    const float ph = (aim * dt) * n;
    return {mag * __cosf(ph), mag * __sinf(ph)};
}
DEVI Cx zoh_coef(float are, float aim, float dt) {
    const Cx lam = lam_pow(are, aim, dt, 1.0f);
    const float den = are * are + aim * aim, nr = lam.re - 1.0f;
    return {(nr * are + lam.im * aim) / den, (lam.im * are - nr * aim) / den};
}

DEVI void phase_prologue_a(const Params& p, bf16_t* lds) {
    unsigned char* ws = ows(p);
    float* tl = (float*)lds;
    const int tid = otid();
    const long gtid = (long)blockIdx.x * NTHREADS + tid, gsz = (long)gridDim.x * NTHREADS;
    {
        const float* x = p.in[0];
        bf16_t* xb = (bf16_t*)(ws + OFF_XB);
        for (long e = gtid; e < (long)MTOK * DM / 4; e += gsz) {
            const f32x4 v = *(const f32x4*)(x + e * 4);
            u32x2 w; w.x = pk_bf16(v.x, v.y); w.y = pk_bf16(v.z, v.w);
            *(u32x2*)(xb + e * 4) = w;
        }
    }
    for (int layer = 0; layer < 2; ++layer) {
        unsigned char* wl = ws + OFF_W + layer * W_LAYER;
        transpose_mat(p.in[1] + (long)layer * DM * INW, DM, INW, (bf16_t*)(wl + W_IN), tl);
        transpose_mat(p.in[13] + (long)layer * 512 * 512, 512, 512, (bf16_t*)(wl + W_GLU), tl);
        for (int br = 0; br < 3; ++br)
            transpose_mat(p.in[14] + ((long)layer * 3 + br) * 512 * DM, 512, DM, (bf16_t*)(wl + W_BR) + (long)br * DM * 512, tl);
        transpose_mat(p.in[15] + (long)layer * DM * DM, DM, DM, (bf16_t*)(wl + W_OUT), tl);
        transpose_mat(p.in[18] + (long)layer * DM * FFN, DM, FFN, (bf16_t*)(wl + W_UP), tl);
        transpose_mat(p.in[19] + (long)layer * FFN * DM, FFN, DM, (bf16_t*)(wl + W_DN), tl);

        unsigned char* sl = ws + OFF_S5 + layer * S5_LAYER;
        bf16_t* Bt = (bf16_t*)(sl + S5_BT);
        bf16_t* Zt = (bf16_t*)(sl + S5_ZT);
        float* KT = (float*)(sl + S5_KTAB);
        f32x2* LT = (f32x2*)(sl + S5_LAMT);
        const float* a_re = p.in[5] + layer * 2 * 32 * 64;
        const float* a_im = p.in[6] + layer * 2 * 32 * 64;
        const float* ldt = p.in[7] + layer * 2 * 32;
        const float* b_re = p.in[8] + (long)layer * 32 * 64 * 16;
        const float* b_im = p.in[9] + (long)layer * 32 * 64 * 16;
        const float* c_re = p.in[10] + (long)layer * 2 * 32 * 16 * 64;
        const float* c_im = p.in[11] + (long)layer * 2 * 32 * 16 * 64;
        for (long e = gtid; e < 2 * 32 * 64; e += gsz) {
            const int dg = (int)(e >> 6);
            const float dt = __expf(ldt[dg]);
            const Cx l = lam_pow(a_re[e], a_im[e], dt, 32.0f);
            LT[e] = (f32x2){l.re, l.im};
        }
        for (long e = gtid; e < 32 * 2 * 32 * 64; e += gsz) {
            const int pp = (int)(e & 63), jt = (int)((e >> 6) & 31), dir = (int)((e >> 11) & 1), g = (int)(e >> 12);
            const int ai = (dir * 32 + g) * 64 + pp;
            const float are = a_re[ai], aim = a_im[ai], dt = __expf(ldt[dir * 32 + g]);
            const Cx coef = zoh_coef(are, aim, dt);
            {
                const Cx w = cmul(lam_pow(are, aim, dt, (float)(dir == 0 ? 31 - jt : jt)), coef);
                bf16_t* zr = Zt + ((long)(g * 256 + dir * 128 + pp)) * 512 + jt * 16;
                bf16_t* zi = zr + 64 * 512;
#pragma unroll
                for (int h = 0; h < 16; ++h) {
                    const Cx bb = {b_re[(g * 64 + pp) * 16 + h], b_im[(g * 64 + pp) * 16 + h]};
                    const Cx wb = cmul(w, bb);
                    zr[h] = f2bf(wb.re); zi[h] = f2bf(wb.im);
                }
            }
            {
                const Cx lp = lam_pow(are, aim, dt, (float)(dir == 0 ? jt + 1 : 32 - jt));
#pragma unroll
                for (int h = 0; h < 16; ++h) {
                    const int ci = ((dir * 32 + g) * 16 + h) * 64 + pp;
                    const Cx c = cmul((Cx){c_re[ci], c_im[ci]}, lp);
                    bf16_t* bp = Bt + ((long)(g * 512 + jt * 16 + h)) * 768 + 512 + dir * 128 + pp;
                    bp[0] = f2bf(c.re); bp[64] = f2bf(-c.im);
                }
            }
        }
        for (int u = blockIdx.x; u < 2 * 32 * 32; u += gridDim.x) {
            const int tau = u & 31, g = (u >> 5) & 31, dir = u >> 10;
            __syncthreads();
            if (tid < 64) {
                const int ai = (dir * 32 + g) * 64 + tid;
                const float are = a_re[ai], aim = a_im[ai], dt = __expf(ldt[dir * 32 + g]);
                const Cx w = cmul(lam_pow(are, aim, dt, (float)tau), zoh_coef(are, aim, dt));
                tl[2 * tid] = w.re; tl[2 * tid + 1] = w.im;
            }
            __syncthreads();
            const int hp = (tid >> 4) & 15, h = tid & 15;
            float acc = 0.f;
            if (tid < 256)
            for (int pp = 0; pp < 64; ++pp) {
                const Cx w = {tl[2 * pp], tl[2 * pp + 1]};
                const Cx bb = {b_re[(g * 64 + pp) * 16 + h], b_im[(g * 64 + pp) * 16 + h]};
                const Cx wb = cmul(w, bb);
                const int ci = ((dir * 32 + g) * 16 + hp) * 64 + pp;
                acc += c_re[ci] * wb.re - c_im[ci] * wb.im;
            }
            if (tid < 256) KT[((long)((dir * 32 + g) * 32 + tau)) * 256 + tid] = acc;
        }
    }
}

DEVI void phase_prologue_b(const Params& p) {
    unsigned char* ws = ows(p);
    const long gtid = (long)blockIdx.x * NTHREADS + otid(), gsz = (long)gridDim.x * NTHREADS;
    for (int layer = 0; layer < 2; ++layer) {
        unsigned char* sl = ws + OFF_S5 + layer * S5_LAYER;
        bf16_t* Bt = (bf16_t*)(sl + S5_BT);
        const float* KT = (const float*)(sl + S5_KTAB);
        const float* dsk = p.in[12] + layer * 32 * 16;
        for (long e = gtid; e < 32L * 512 * 64; e += gsz) {
            const int kc = (int)(e & 63), n = (int)((e >> 6) & 511), g = (int)(e >> 15);
            const int j = kc >> 1, h0 = (kc & 1) * 8, t = n >> 4, hp = n & 15;
            float v[8];
            if (j < t) {
                const float* k = KT + ((long)((0 * 32 + g) * 32 + (t - j))) * 256 + hp * 16 + h0;
#pragma unroll
                for (int i = 0; i < 8; ++i) v[i] = k[i];
            } else if (j > t) {
                const float* k = KT + ((long)((1 * 32 + g) * 32 + (j - t))) * 256 + hp * 16 + h0;
#pragma unroll
                for (int i = 0; i < 8; ++i) v[i] = k[i];
            } else {
                const float* kf = KT + ((long)((0 * 32 + g) * 32)) * 256 + hp * 16 + h0;
                const float* kb = KT + ((long)((1 * 32 + g) * 32)) * 256 + hp * 16 + h0;
#pragma unroll
                for (int i = 0; i < 8; ++i) v[i] = kf[i] + kb[i] + ((h0 + i == hp) ? dsk[g * 16 + hp] : 0.f);
            }
            u32x4 w; w.x = pk_bf16(v[0], v[1]); w.y = pk_bf16(v[2], v[3]); w.z = pk_bf16(v[4], v[5]); w.w = pk_bf16(v[6], v[7]);
            *(u32x4*)(Bt + ((long)(g * 512 + n)) * 768 + kc * 8) = w;
        }
    }
}


#define XB_TMO      128
#define XB_XCNT(j)  (256  + 64 * (j))
#define XB_XSUB(j)  (1280 + 64 * (j))
#define XB_XGEN(j)  (2304 + 64 * (j))
#define XB_TOP      3328
#define XB_TOPGEN   3392
#define XCD_BAR_WORDS 3456
#define XB_SPIN_CAP (1u << 18)

__device__ __forceinline__ unsigned xb_ld(unsigned* p)              { return __hip_atomic_load(p, __ATOMIC_RELAXED, __HIP_MEMORY_SCOPE_AGENT); }
__device__ __forceinline__ unsigned xb_add(unsigned* p, unsigned v) { return __hip_atomic_fetch_add(p, v, __ATOMIC_RELAXED, __HIP_MEMORY_SCOPE_AGENT); }
__device__ __forceinline__ unsigned xb_xcc_id() { return (unsigned)__builtin_amdgcn_s_getreg((3 << 11) | 20) & 0xFu; }
#define XB_SPIN(cond, bar) do { unsigned _sp = 0; while (cond) { __builtin_amdgcn_s_sleep(1); \
    if ((++_sp & 255u) == 0u) { if (xb_ld(&(bar)[XB_TMO])) break; if (_sp > XB_SPIN_CAP) { atomicAdd(&(bar)[XB_TMO], 1u); break; } } } } while (0)

struct XcdBarrier {
    unsigned* bar; unsigned x;
    volatile LAS unsigned* st;
};

__device__ __forceinline__ XcdBarrier xcd_barrier_post(unsigned* bar, volatile LAS unsigned* st) {
    XcdBarrier b; b.bar = bar; b.x = xb_xcc_id(); b.st = st;
    if (threadIdx.x == 0) (void)xb_add(&bar[XB_XCNT(b.x)], 1u);
    return b;
}
__device__ __forceinline__ void xcd_barrier_complete(unsigned* bar, unsigned x, unsigned& nloc, unsigned& nx) {
    const unsigned G = gridDim.x * gridDim.y * gridDim.z;
    unsigned sum, cnt, mine, sp = 0u;
    for (;;) {
        sum = 0u; cnt = 0u; mine = 0u;
#pragma unroll
        for (unsigned j = 0; j < 16; ++j) { const unsigned c = xb_ld(&bar[XB_XCNT(j)]); sum += c; cnt += (c > 0u) ? 1u : 0u; mine = (j == x) ? c : mine; }
        if (sum == G) break;
        __builtin_amdgcn_s_sleep(1);
        if ((++sp & 255u) == 0u) { if (xb_ld(&bar[XB_TMO])) break; if (sp > XB_SPIN_CAP) { atomicAdd(&bar[XB_TMO], 1u); break; } }
    }
    nloc = mine > 0u ? mine : 1u; nx = cnt > 0u ? cnt : 1u;
}

__device__ __forceinline__ void xcd_barrier(const XcdBarrier& b) {
    asm volatile("s_waitcnt vmcnt(0)" ::: "memory");
    __syncthreads();
    if (threadIdx.x == 0) {
        unsigned* bar = b.bar;
        __builtin_amdgcn_s_waitcnt(0);
        unsigned nloc = b.st[0], nx = b.st[1];
        if (nloc == 0u) { xcd_barrier_complete(bar, b.x, nloc, nx); b.st[0] = nloc; b.st[1] = nx; }
        const unsigned old = xb_add(&bar[XB_XSUB(b.x)], 1u);
        const unsigned gen = old / nloc;
        if (old + 1u == (gen + 1u) * nloc) {
            __builtin_amdgcn_fence(__ATOMIC_RELEASE, "agent");
            asm volatile("s_waitcnt vmcnt(0)" ::: "memory");
            const unsigned og = xb_add(&bar[XB_TOP], 1u);
            const unsigned tg = og / nx;
            if (og + 1u == (tg + 1u) * nx) xb_add(&bar[XB_TOPGEN], 1u);
            else XB_SPIN(xb_ld(&bar[XB_TOPGEN]) == tg, bar);
            __builtin_amdgcn_fence(__ATOMIC_ACQUIRE, "agent");
            xb_add(&bar[XB_XGEN(b.x)], 1u);
            asm volatile("s_waitcnt vmcnt(0)" ::: "memory");
        } else {
            XB_SPIN(xb_ld(&bar[XB_XGEN(b.x)]) == gen, bar);
            __builtin_amdgcn_fence(__ATOMIC_ACQUIRE, "agent");
            asm volatile("s_waitcnt vmcnt(0)" ::: "memory");
        }
    }
    __syncthreads();
}


DEVI void grid_barrier(unsigned* ctr, unsigned target) {
    asm volatile("s_waitcnt vmcnt(0) lgkmcnt(0)" ::: "memory");
    __syncthreads();
    if (threadIdx.x == 0) {
        __builtin_amdgcn_fence(__ATOMIC_RELEASE, "agent");
        asm volatile("s_waitcnt vmcnt(0)" ::: "memory");
        __hip_atomic_fetch_add(ctr, 1u, __ATOMIC_RELAXED, __HIP_MEMORY_SCOPE_AGENT);
        while (__hip_atomic_load(ctr, __ATOMIC_RELAXED, __HIP_MEMORY_SCOPE_AGENT) < target) __builtin_amdgcn_s_sleep(2);
        __builtin_amdgcn_fence(__ATOMIC_ACQUIRE, "agent");
        asm volatile("s_waitcnt vmcnt(0)" ::: "memory");
    }
    __syncthreads();
}

constexpr int PH_PER_LAYER = 6;
constexpr int N_PHASES = 2 + PH_PER_LAYER * 2;
__global__ void __launch_bounds__(NTHREADS, 2) fwd_kernel(Params p) {
    extern __shared__ __attribute__((aligned(16))) unsigned char lds_raw[];
    bf16_t* lds = (bf16_t*)lds_raw;
    unsigned char* ws = ows(p);
    volatile LAS unsigned* xst = (volatile LAS unsigned*)(LAS unsigned char*)(lds_raw + LDS_BYTES - 32);
    if (threadIdx.x == 0) { xst[0] = 0u; xst[1] = 0u; }
    __syncthreads();
    const XcdBarrier xbar = xcd_barrier_post((unsigned*)(ws + OFF_CTL + 16384), xst);
    for (int ph = p.ph_lo; ph < p.ph_hi; ++ph) {
        if (ph == 0) phase_prologue_a(p, lds);
        else if (ph == 1) phase_prologue_b(p);
        else {
            const int layer = (ph - 2) / PH_PER_LAYER, sub = (ph - 2) % PH_PER_LAYER;
            switch (sub) {
            case 0: phase_inproj(p, layer, lds); break;
            case 1: phase_mixers(p, layer, lds); break;
            case 2: phase_merge(p, layer, lds); break;
            case 3: phase_res_gemm_ln((const bf16_t*)(ws + OFF_MERGED), DM, (const bf16_t*)(ws + OFF_W + layer * W_LAYER + W_OUT), nullptr, (bf16_t*)(ws + OFF_XB),
                                      p.in[16] + layer * DM, p.in[17] + layer * DM, (f32x2*)(ws + OFF_STATS), (unsigned*)(ws + OFF_CTL) + 1024 + (layer * 2) * 128, lds); break;
            case 4: phase_ffn_up(p, layer, lds); break;
            default: phase_res_gemm_ln((const bf16_t*)(ws + OFF_H), FFN, (const bf16_t*)(ws + OFF_W + layer * W_LAYER + W_DN), layer == 1 ? p.out : nullptr, (bf16_t*)(ws + OFF_XB),
                                      p.in[20] + layer * DM, p.in[21] + layer * DM, (f32x2*)(ws + OFF_STATS), (unsigned*)(ws + OFF_CTL) + 1024 + (layer * 2 + 1) * 128, lds, true); break;
            }
        }
        if (ph + 1 < p.ph_hi) {
            if (p.ph_lo < 0) cg::this_grid().sync();
            xcd_barrier(xbar);
        }
    }
}

extern "C" void kernel_launch(void* const* d_in, const int* in_sizes, int n_in, void* d_out, int out_size, void* d_ws, size_t ws_size, hipStream_t stream) {
    static int grid = 0;
    if (grid == 0) {
        if (n_in != 22 || ws_size < WS_END) { fprintf(stderr, "kernel_launch: unexpected n_in %d / ws_size %zu\n", n_in, ws_size); grid = -1; return; }
        int dev = 0, cus = 0, per_cu = 0;
        hipGetDevice(&dev);
        hipDeviceGetAttribute(&cus, hipDeviceAttributeMultiprocessorCount, dev);
        hipFuncSetAttribute((const void*)fwd_kernel, hipFuncAttributeMaxDynamicSharedMemorySize, LDS_BYTES);
        hipOccupancyMaxActiveBlocksPerMultiprocessor(&per_cu, (const void*)fwd_kernel, NTHREADS, LDS_BYTES);
        if (per_cu < 1) per_cu = 1;
        if (per_cu > 1) per_cu = 1;
        grid = cus * per_cu;
        fprintf(stderr, "kernel_launch: grid %d (%d CUs x %d)\n", grid, cus, per_cu);
    }
    if (grid < 0) return;
    Params p{};
    for (int i = 0; i < 22; ++i) p.in[i] = (const float*)d_in[i];
    p.out = (float*)d_out; p.ws = (unsigned char*)d_ws;
#if SINGLE_LAUNCH
    hipMemsetAsync((unsigned char*)d_ws + OFF_CTL, 0, 32768, stream);
    p.ph_lo = 0; p.ph_hi = N_PHASES;
    void* args[] = {&p};
    hipError_t e = hipLaunchCooperativeKernel((const void*)fwd_kernel, dim3(grid), dim3(NTHREADS), args, LDS_BYTES, stream);
    if (e != hipSuccess) fprintf(stderr, "cooperative launch failed: %s (grid %d)\n", hipGetErrorString(e), grid);
#else
    for (int ph = 0; ph < N_PHASES; ++ph) {
        p.ph_lo = ph; p.ph_hi = ph + 1;
        hipLaunchKernelGGL(fwd_kernel, dim3(grid), dim3(NTHREADS), LDS_BYTES, stream, p);
    }
#endif
}
```

```cpp
#include <hip/hip_runtime.h>
#include <hip/hip_cooperative_groups.h>
#include <cstdio>
namespace cg = cooperative_groups;

#ifndef SINGLE_LAUNCH
#define SINGLE_LAUNCH 1
#endif

typedef unsigned short bf16_t;
typedef short bf16x8 __attribute__((ext_vector_type(8)));
typedef float f32x16 __attribute__((ext_vector_type(16)));
typedef float f32x4 __attribute__((ext_vector_type(4)));
typedef float f32x2 __attribute__((ext_vector_type(2)));
typedef unsigned u32x4 __attribute__((ext_vector_type(4)));
typedef unsigned u32x2 __attribute__((ext_vector_type(2)));
#define DEVI __device__ __forceinline__

constexpr int DM = 1024, SEQ = 8192, NB = 4, MTOK = NB * SEQ, FFN = 4096, INW = 5888;
constexpr int PW = 2816;
constexpr int CQ = 0, CK = 512, CNQ = 768, CNK = 1280, CSU = 2304;
constexpr float ALPHA = 1.4142135623730951f;
constexpr float LOG2E = 1.4426950408889634f;
constexpr int NTHREADS = 512, NWAVES = 8;
constexpr int LSTR = 72;
constexpr int LDS_BYTES = 2 * (256 + 256) * LSTR * 2;

constexpr size_t MiB = 1u << 20;
constexpr size_t OFF_P = 0, OFF_H = 0, OFF_ZB = 176 * MiB, OFF_MERGED = 176 * MiB, OFF_NVT = 208 * MiB, OFF_VT = 240 * MiB;
constexpr size_t OFF_ZS = 256 * MiB, OFF_SPREV = 288 * MiB;
constexpr size_t OFF_W = 304 * MiB, W_LAYER = 34 * MiB;
constexpr size_t W_IN = 0, W_GLU = 12 * MiB, W_BR = 13 * MiB, W_OUT = 16 * MiB, W_UP = 18 * MiB, W_DN = 26 * MiB;
constexpr size_t OFF_S5 = 372 * MiB, S5_LAYER = 35 * MiB;
constexpr size_t S5_BT = 0, S5_ZT = 24 * MiB, S5_KTAB = 32 * MiB, S5_LAMT = 34 * MiB;
constexpr size_t OFF_XB = 442 * MiB;
constexpr size_t OFF_CTL = 506 * MiB;
constexpr size_t OFF_STATS = 507 * MiB;
constexpr size_t WS_END = 509 * MiB;

struct Params {
    const float* in[22];
    float* out;
    unsigned char* ws;
    int ph_lo, ph_hi;
};

DEVI unsigned char* ows(const Params& p) { unsigned char* w = p.ws; asm volatile("" : "+s"(w)); return w; }
#define GAS __attribute__((address_space(1)))
DEVI u32x4 gld16(const void* p) { return *(const GAS u32x4*)(const GAS char*)p; }
DEVI bf16x8 gld16b(const void* p) { return *(const GAS bf16x8*)(const GAS char*)p; }
DEVI void gst8(void* base, unsigned off, u32x2 v) { *(GAS u32x2*)((GAS char*)base + off) = v; }
DEVI void gst2(void* base, unsigned off, bf16_t v) { *(GAS bf16_t*)((GAS char*)base + off) = v; }
DEVI int otid() { int t = threadIdx.x; asm volatile("" : "+v"(t)); return t; }
typedef __bf16 bf16x2_t __attribute__((ext_vector_type(2)));
DEVI unsigned pk_bf16_m(float lo, float hi) { const f32x2 v = {lo, hi}; const bf16x2_t b = __builtin_convertvector(v, bf16x2_t); return __builtin_bit_cast(unsigned, b); }
DEVI unsigned pk_bf16(float lo, float hi) { unsigned r; asm("v_cvt_pk_bf16_f32 %0, %1, %2" : "=v"(r) : "v"(lo), "v"(hi)); return r; }
DEVI bf16_t f2bf(float f) { return (bf16_t)(pk_bf16(f, 0.f) & 0xffffu); }
DEVI float bf2f(unsigned v) { return __uint_as_float(v << 16); }
DEVI float fexp2(float x) { return __builtin_amdgcn_exp2f(x); }
DEVI float sigmoidf_(float x) { return 1.0f / (1.0f + fexp2(-x * LOG2E)); }
DEVI float gelu_tanh(float y) {
    const float u = 0.7978845608028654f * (y + 0.044715f * y * y * y);
    return y * sigmoidf_(2.0f * u);
}
DEVI f32x16 mfma32(bf16x8 a, bf16x8 b, f32x16 c) { return __builtin_amdgcn_mfma_f32_32x32x16_bf16(a, b, c, 0, 0, 0); }
DEVI float xhalf(float v) { return __shfl_xor(v, 32); }

#define LAS __attribute__((address_space(3)))
#define SB() __builtin_amdgcn_sched_barrier(0)
template <int NT, int MT, class XF>
DEVI void gemm_kloop(f32x16 (&acc)[NT][MT], const bf16_t* wbase, int ldw, const bf16_t* xbase, const XF& xf, int K, bf16_t* lds) {
    const int tid = otid(), lane = tid & 63;
    const int wave = __builtin_amdgcn_readfirstlane(tid >> 6);
    const int wn = wave & 1, wm = wave >> 1, l32 = lane & 31, hi = lane >> 5;
    constexpr int WR = 64 * NT, XR = 128 * MT, WI = WR / 64, XI = XR / 64, STAGE = (WR + XR) * 64, NP = WI + XI;
    const int nk = K >> 6;
    const int lrow = wave * 8 + (lane >> 3);
    const int lc = ((lane & 7) ^ ((lrow >> 1) & 7)) * 8;
    const unsigned woff0 = ((unsigned)lrow * (unsigned)ldw + (unsigned)lc) * 2u;
    const unsigned wstep = 64u * (unsigned)ldw * 2u;
    unsigned xoff[XI];
#pragma unroll
    for (int j = 0; j < XI; ++j) xoff[j] = xf.off((unsigned)(lrow + 64 * j), (unsigned)lc) * 2u;
    const GAS char* wp = (const GAS char*)wbase;
    const GAS char* xp = (const GAS char*)xbase;
    const unsigned xstep = (unsigned)xf.kstep() * 2u;
    LAS bf16_t* L = (LAS bf16_t*)lds;
    const int sw = (l32 >> 1) & 7;
    int koff[4];
#pragma unroll
    for (int kk = 0; kk < 4; ++kk) koff[kk] = ((kk * 2 + hi) ^ sw) * 8;
#define GEMM_PIECE(bufi, pi) do { \
        LAS bf16_t* _d = L + (bufi) * STAGE + wave * 8 * 64; \
        if ((pi) < WI) __builtin_amdgcn_global_load_lds((const GAS unsigned*)(wp + woff0 + (pi) * wstep), (LAS unsigned*)(_d + (pi) * 64 * 64), 16, 0, 0); \
        else if ((pi) < NP) __builtin_amdgcn_global_load_lds((const GAS unsigned*)(xp + xoff[((pi) - WI) < XI ? ((pi) - WI) : 0]), (LAS unsigned*)(_d + (WR + ((pi) - WI) * 64) * 64), 16, 0, 0); \
    } while (0)
#define GEMM_RFR(set, kk) do { \
        _Pragma("unroll") for (int mt = 0; mt < MT; ++mt) fb[set][mt] = *(const LAS bf16x8*)(xsb + mt * 32 * 64 + koff[kk]); \
        _Pragma("unroll") for (int nt = 0; nt < NT; ++nt) fa[set][nt] = *(const LAS bf16x8*)(wsb + nt * 32 * 64 + koff[kk]); \
    } while (0)
#define GEMM_MMA(set, nlo, nhi) do { \
        __builtin_amdgcn_s_setprio(1); \
        _Pragma("unroll") for (int nt = (nlo); nt < (nhi); ++nt) \
        _Pragma("unroll") for (int mt = 0; mt < MT; ++mt) acc[nt][mt] = mfma32(fa[set][nt], fb[set][mt], acc[nt][mt]); \
        __builtin_amdgcn_s_setprio(0); \
    } while (0)
    asm volatile("s_waitcnt vmcnt(0)" ::: "memory");
    __builtin_amdgcn_s_barrier();
#pragma unroll
    for (int pi = 0; pi < NP; ++pi) GEMM_PIECE(0, pi);
#pragma unroll 1
    for (int kt = 0; kt < nk; ++kt) {
        const int buf = kt & 1;
        const bool more = (kt + 1 < nk);
        asm volatile("s_waitcnt vmcnt(0) lgkmcnt(0)" ::: "memory");
        __builtin_amdgcn_s_barrier();
        const LAS bf16_t* wsb = L + buf * STAGE + (wn * 32 * NT + l32) * 64;
        const LAS bf16_t* xsb = L + buf * STAGE + (WR + wm * 32 * MT + l32) * 64;
        bf16x8 fa[2][NT], fb[2][MT];
        GEMM_RFR(0, 0);
        SB();
        if (more) { wp += 128; xp += xstep; }
#pragma unroll
        for (int kk = 0; kk < 4; ++kk) {
            if (kk < 3) { GEMM_RFR((kk + 1) & 1, kk + 1); }
            SB();
            if (more && kk < 2) { GEMM_PIECE(buf ^ 1, 4 * kk); GEMM_PIECE(buf ^ 1, 4 * kk + 1); }
            SB();
            GEMM_MMA(kk & 1, 0, NT / 2);
            SB();
            if (more && kk < 2) { GEMM_PIECE(buf ^ 1, 4 * kk + 2); GEMM_PIECE(buf ^ 1, 4 * kk + 3); }
            SB();
            GEMM_MMA(kk & 1, NT / 2, NT);
            SB();
        }
    }
#undef GEMM_PIECE
#undef GEMM_RFR
#undef GEMM_MMA
}

template <int NT, int MT> DEVI void zero_acc(f32x16 (&acc)[NT][MT]) {
#pragma unroll
    for (int nt = 0; nt < NT; ++nt)
#pragma unroll
        for (int mt = 0; mt < MT; ++mt)
#pragma unroll
            for (int i = 0; i < 16; ++i) acc[nt][mt][i] = 0.f;
}
DEVI int vblock() { const int G = gridDim.x, b = blockIdx.x; return (G % 8 == 0) ? (b % 8) * (G / 8) + b / 8 : b; }

struct XRow {
    int ld;
    DEVI unsigned off(unsigned r, unsigned kc) const { return r * (unsigned)ld + kc; }
    DEVI int kstep() const { return 64; }
};
struct XS5 {
    DEVI unsigned off(unsigned r, unsigned kc) const { return (r * 32u + (kc >> 4)) * (unsigned)PW + (kc & 15u); }
    DEVI int kstep() const { return 4 * PW; }
};


template <int NT> DEVI void wave_rows_out(const bf16_t* wl, bf16_t* gbase, long ld, int lane) {
    constexpr int RS = NT * 32 + 8, CPR = NT * 4, RPI = 64 / CPR;
    asm volatile("s_waitcnt lgkmcnt(0)" ::: "memory");
    const bf16_t* lp = wl + (lane / CPR) * RS + (lane % CPR) * 8;
    const unsigned loff = ((unsigned)(lane / CPR) * (unsigned)ld + (unsigned)(lane % CPR) * 8u) * 2u;
    GAS char* gp = (GAS char*)gbase;
    const unsigned gstep = (unsigned)RPI * (unsigned)ld * 2u;
#pragma unroll 4
    for (int j = 0; j < NT * 4; ++j) {
        const u32x4 v = *(const u32x4*)(lp);
        *(GAS u32x4*)(gp + loff) = v;
        gp += gstep; lp += RPI * RS;
    }
}

DEVI void phase_inproj(const Params& p, int layer, bf16_t* lds) {
    unsigned char* ws = ows(p);
    const bf16_t* xb = (const bf16_t*)(ws + OFF_XB);
    const bf16_t* wt = (const bf16_t*)(ws + OFF_W + layer * W_LAYER + W_IN);
    bf16_t* P = (bf16_t*)(ws + OFF_P);
    bf16_t* VT = (bf16_t*)(ws + OFF_VT);
    bf16_t* NVT = (bf16_t*)(ws + OFF_NVT);
    const float* qg = p.in[2] + layer * 64;
    const float* kg = p.in[3] + layer * 64;
    const int tid0 = otid();
    const int wave = __builtin_amdgcn_readfirstlane(tid0 >> 6), wn = wave & 1, wm = wave >> 1;
    constexpr int NT_N = PW / 256, NT_M = MTOK / 256;
    for (int t = vblock(); t < NT_N * NT_M; t += gridDim.x) {
        const int tm = t / NT_N, tn = t % NT_N;
        const int n0 = tn * 256, m0 = tm * 256;
        f32x16 acc[4][2];
        zero_acc<4, 2>(acc);
        gemm_kloop<4, 2>(acc, wt + (long)n0 * DM, DM, xb + (long)m0 * DM, XRow{DM}, DM, lds);
        __syncthreads();
        bf16_t* wl = lds + wave * (64 * 136);
        int lane = tid0 & 63; asm volatile("" : "+v"(lane));
        const int l32 = lane & 31, hi = lane >> 5;
        const int nbw = n0 + wn * 128;
        const int mw = m0 + wm * 64;
        bf16_t* pbase = P + (long)mw * PW + nbw;
        if (nbw < 640) {
            const float* gain = (nbw < 512) ? qg : kg;
#pragma unroll
            for (int hp = 0; hp < 2; ++hp)
#pragma unroll
            for (int mt = 0; mt < 2; ++mt) {
                const int tpos = (mw + mt * 32 + l32) & (SEQ - 1);
                float ss = 0.f;
#pragma unroll
                for (int nt = 0; nt < 2; ++nt)
#pragma unroll
                    for (int i = 0; i < 16; ++i) ss += acc[2 * hp + nt][mt][i] * acc[2 * hp + nt][mt][i];
                ss += xhalf(ss);
                const float rs = rsqrtf(ss * (1.0f / 64.0f) + 1e-6f) * ((nbw < 512) ? 0.125f * LOG2E : 1.0f);
#pragma unroll
                for (int nt = 0; nt < 2; ++nt) {
                    const float pos = (float)(nt == 0 ? (tpos >> 6) : (tpos & 63));
                    float v[16];
#pragma unroll
                    for (int q = 0; q < 4; ++q) {
                        const f32x4 g4 = *(const GAS f32x4*)(const GAS float*)(gain + nt * 32 + 8 * q + 4 * hi);
                        v[4 * q] = acc[2 * hp + nt][mt][4 * q] * rs * g4.x; v[4 * q + 1] = acc[2 * hp + nt][mt][4 * q + 1] * rs * g4.y;
                        v[4 * q + 2] = acc[2 * hp + nt][mt][4 * q + 2] * rs * g4.z; v[4 * q + 3] = acc[2 * hp + nt][mt][4 * q + 3] * rs * g4.w;
                    }
#pragma unroll
                    for (int i = 0; i < 8; ++i) {
                        const int j = 8 * (i >> 2) + 4 * hi + (i & 3);
                        const float inv = fexp2(-(float)j * 0.8304820237218406f);
                        const float ang = pos * inv;
                        const float c = __cosf(ang), sn = __sinf(ang);
                        const float x1 = v[i], x2 = v[i + 8];
                        v[i] = x1 * c - x2 * sn;
                        v[i + 8] = x2 * c + x1 * sn;
                    }
#pragma unroll
                    for (int q = 0; q < 4; ++q) {
                        u32x2 w; w.x = pk_bf16(v[4 * q], v[4 * q + 1]); w.y = pk_bf16(v[4 * q + 2], v[4 * q + 3]);
                        *(u32x2*)(wl + (mt * 32 + l32) * 136 + hp * 64 + nt * 32 + 8 * q + 4 * hi) = w;
                    }
                    __builtin_amdgcn_sched_barrier(0);
                }
            }
            wave_rows_out<4>(wl, pbase, PW, lane);
        } else if (nbw == 640 || (nbw >= 1792 && nbw < 2304)) {
            const int b = mw >> 13, tpos0 = mw & (SEQ - 1);
            bf16_t* base = (nbw == 640) ? VT + ((long)(b * 2) * 64) * SEQ + tpos0 : NVT + ((long)(b * 8 + ((nbw - 1792) >> 6)) * 64) * SEQ + tpos0;
            const unsigned voff = (unsigned)(4 * hi * SEQ + l32) * 2u;
#pragma unroll
            for (int mt = 0; mt < 2; ++mt)
#pragma unroll
                for (int nt = 0; nt < 4; ++nt)
#pragma unroll
                    for (int i = 0; i < 16; ++i)
                        gst2(base, voff + (unsigned)(((nt * 32 + 8 * (i >> 2) + (i & 3)) * SEQ + mt * 32) * 2), f2bf(acc[nt][mt][i]));
        } else {
#pragma unroll
            for (int mt = 0; mt < 2; ++mt)
#pragma unroll
                for (int nt = 0; nt < 4; ++nt)
#pragma unroll
                    for (int q = 0; q < 4; ++q) {
                        u32x2 w; w.x = pk_bf16(acc[nt][mt][4 * q], acc[nt][mt][4 * q + 1]); w.y = pk_bf16(acc[nt][mt][4 * q + 2], acc[nt][mt][4 * q + 3]);
                        *(u32x2*)(wl + (mt * 32 + l32) * 136 + nt * 32 + 8 * q + 4 * hi) = w;
                    }
            wave_rows_out<4>(wl, pbase, PW, lane);
        }
    }
}

DEVI void online_softmax(f32x16 (&s)[2], f32x16 (&o)[2], float& mrun, float& lrun, bf16x8 (&pb)[2][2]) {
    float mx = s[0][0];
#pragma unroll
    for (int kt = 0; kt < 2; ++kt)
#pragma unroll
        for (int i = 0; i < 16; ++i) mx = fmaxf(mx, s[kt][i]);
    mx = fmaxf(mx, xhalf(mx));
    const float mnew = fmaxf(mrun, mx);
    const float alpha = fexp2(mrun - mnew);
    mrun = mnew;
    float ps = 0.f;
#pragma unroll
    for (int kt = 0; kt < 2; ++kt)
#pragma unroll
        for (int i = 0; i < 16; ++i) { const float e = fexp2(s[kt][i] - mnew); s[kt][i] = e; ps += e; }
    lrun = lrun * alpha + ps;
#pragma unroll
    for (int dt = 0; dt < 2; ++dt)
#pragma unroll
        for (int i = 0; i < 16; ++i) o[dt][i] *= alpha;
#pragma unroll
    for (int kt = 0; kt < 2; ++kt)
#pragma unroll
        for (int sl = 0; sl < 2; ++sl) {
            u32x4 w;
            w.x = pk_bf16_m(s[kt][8 * sl + 0], s[kt][8 * sl + 1]); w.y = pk_bf16_m(s[kt][8 * sl + 2], s[kt][8 * sl + 3]);
            w.z = pk_bf16_m(s[kt][8 * sl + 4], s[kt][8 * sl + 5]); w.w = pk_bf16_m(s[kt][8 * sl + 6], s[kt][8 * sl + 7]);
            pb[kt][sl] = __builtin_bit_cast(bf16x8, w);
        }
}
DEVI int kperm(int r) { return (r & 16) + 8 * ((r >> 2) & 1) + 4 * ((r >> 3) & 1) + (r & 3); }

DEVI void gqa_unit(const Params& p, int layer, int unit, bf16_t* lds) {
    unsigned char* ws = ows(p);
    bf16_t* P = (bf16_t*)(ws + OFF_P);
    const bf16_t* VT = (const bf16_t*)(ws + OFF_VT);
    const int tid = otid(), lane = tid & 63, wave = tid >> 6, l32 = lane & 31, hi = lane >> 5;
    const int qb = unit & 31, h = (unit >> 5) & 7, b = unit >> 8, kvh = h >> 2;
    const int qrow = qb * 256 + wave * 32 + l32;
    bf16_t* Ks = lds;
    bf16_t* Vs = lds + 2 * 64 * LSTR;
    bf16x8 qf[4];
    {
        const bf16_t* qp = P + ((long)(b * SEQ + qrow)) * PW + CQ + h * 64 + hi * 8;
#pragma unroll
        for (int kk = 0; kk < 4; ++kk) qf[kk] = *(const bf16x8*)(qp + kk * 16);
    }
    float mb;
    {
        float gq = fabsf(p.in[2][layer * 64 + lane]), gk = fabsf(p.in[3][layer * 64 + lane]);
#pragma unroll
        for (int o2 = 1; o2 < 64; o2 <<= 1) { gq = fmaxf(gq, __shfl_xor(gq, o2)); gk = fmaxf(gk, __shfl_xor(gk, o2)); }
        mb = 8.0f * gq * gk * LOG2E * 1.01f;
    }
    const bf16_t* kbase = P + ((long)b * SEQ) * PW + CK + kvh * 64;
    const bf16_t* vbase = VT + ((long)(b * 2 + kvh) * 64) * SEQ;
    f32x16 o[2];
#pragma unroll
    for (int dt = 0; dt < 2; ++dt)
#pragma unroll
        for (int i = 0; i < 16; ++i) o[dt][i] = 0.f;
    float lrun = 0.f;
    u32x4 kreg[1], vreg[1];
#pragma unroll
    for (int i = 0; i < 1; ++i) {
        const int c = tid, r = c >> 3, cc = (c & 7) * 8;
        kreg[i] = gld16(kbase + (long)r * PW + cc);
        vreg[i] = gld16(vbase + (long)r * SEQ + cc);
    }
#pragma unroll
    for (int i = 0; i < 1; ++i) {
        const int c = tid, r = c >> 3, cc = (c & 7) * 8;
        *(u32x4*)(Ks + r * LSTR + cc) = kreg[i];
        *(u32x4*)(Vs + r * LSTR + cc) = vreg[i];
    }
    __syncthreads();
    const int kr = kperm(l32);
    for (int kt0 = 0; kt0 < SEQ / 64; ++kt0) {
        const int buf = kt0 & 1;
        const bool more = (kt0 + 1 < SEQ / 64);
        if (more) {
            const int key0 = (kt0 + 1) * 64;
#pragma unroll
            for (int i = 0; i < 1; ++i) {
                const int c = tid, r = c >> 3, cc = (c & 7) * 8;
                kreg[i] = gld16(kbase + (long)(key0 + r) * PW + cc);
                vreg[i] = gld16(vbase + (long)r * SEQ + key0 + cc);
            }
        }
        f32x16 s[2];
        bf16x8 kf[2][4], vf[2][2][2];
#pragma unroll
        for (int kt = 0; kt < 2; ++kt) {
            const bf16_t* kp = Ks + (buf * 64 + kt * 32 + kr) * LSTR + hi * 8;
#pragma unroll
            for (int kk = 0; kk < 4; ++kk) kf[kt][kk] = *(const bf16x8*)(kp + kk * 16);
        }
#pragma unroll
        for (int dt = 0; dt < 2; ++dt) {
            const bf16_t* vp = Vs + (buf * 64 + dt * 32 + l32) * LSTR + hi * 8;
#pragma unroll
            for (int kt = 0; kt < 2; ++kt)
#pragma unroll
                for (int sl = 0; sl < 2; ++sl) vf[dt][kt][sl] = *(const bf16x8*)(vp + kt * 32 + sl * 16);
        }
        __builtin_amdgcn_sched_barrier(0);
        __builtin_amdgcn_s_setprio(1);
#pragma unroll
        for (int kt = 0; kt < 2; ++kt) {
#pragma unroll
            for (int i = 0; i < 16; ++i) s[kt][i] = -mb;
#pragma unroll
            for (int kk = 0; kk < 4; ++kk) s[kt] = mfma32(kf[kt][kk], qf[kk], s[kt]);
        }
        __builtin_amdgcn_s_setprio(0);
        bf16x8 pb[2][2];
#pragma unroll
        for (int kt = 0; kt < 2; ++kt) {
#pragma unroll
            for (int i = 0; i < 16; ++i) { const float e = fexp2(s[kt][i]); s[kt][i] = e; lrun += e; }
#pragma unroll
            for (int sl = 0; sl < 2; ++sl) {
                u32x4 w;
                w.x = pk_bf16_m(s[kt][8 * sl + 0], s[kt][8 * sl + 1]); w.y = pk_bf16_m(s[kt][8 * sl + 2], s[kt][8 * sl + 3]);
                w.z = pk_bf16_m(s[kt][8 * sl + 4], s[kt][8 * sl + 5]); w.w = pk_bf16_m(s[kt][8 * sl + 6], s[kt][8 * sl + 7]);
                pb[kt][sl] = __builtin_bit_cast(bf16x8, w);
            }
        }
#pragma unroll
        for (int dt = 0; dt < 2; ++dt)
#pragma unroll
            for (int kt = 0; kt < 2; ++kt)
#pragma unroll
                for (int sl = 0; sl < 2; ++sl) o[dt] = mfma32(vf[dt][kt][sl], pb[kt][sl], o[dt]);
        if (more) {
            const int nb = buf ^ 1;
#pragma unroll
            for (int i = 0; i < 1; ++i) {
                const int c = tid, r = c >> 3, cc = (c & 7) * 8;
                *(u32x4*)(Ks + (nb * 64 + r) * LSTR + cc) = kreg[i];
                *(u32x4*)(Vs + (nb * 64 + r) * LSTR + cc) = vreg[i];
            }
        }
        __syncthreads();
    }
    lrun += xhalf(lrun);
    const float inv = 1.0f / lrun;
    bf16_t* op = P + ((long)(b * SEQ + qrow)) * PW + CQ + h * 64;
#pragma unroll
    for (int dt = 0; dt < 2; ++dt)
#pragma unroll
        for (int q = 0; q < 4; ++q) {
            u32x2 w; w.x = pk_bf16(o[dt][4 * q] * inv, o[dt][4 * q + 1] * inv); w.y = pk_bf16(o[dt][4 * q + 2] * inv, o[dt][4 * q + 3] * inv);
            *(u32x2*)(op + dt * 32 + 8 * q + 4 * hi) = w;
        }
}

DEVI void nat_block_unit(const Params& p, int layer, int unit, bf16_t* lds) {
    unsigned char* ws = ows(p);
    bf16_t* P = (bf16_t*)(ws + OFF_P);
    const bf16_t* NVT = (const bf16_t*)(ws + OFF_NVT);
    const float* bias = p.in[4] + (long)layer * 8 * 15 * 31;
    const int tid = otid(), lane = tid & 63, wave = __builtin_amdgcn_readfirstlane(tid >> 6), l32 = lane & 31, hi = lane >> 5;
    const int wu = unit * NWAVES + wave;
    const int qt = wu & 1, h = (wu >> 1) & 7, r = (wu >> 4) & 127, b = wu >> 11;
    const int h0 = (unit * 4) & 7;
    float* bl = (float*)lds;
    for (int e = tid; e < 4 * 465; e += NTHREADS) bl[e] = bias[h0 * 465 + e];
    __syncthreads();
    const float* bh = bl + (h - h0) * 465;
    int rs = r - 4; rs = rs < 0 ? 0 : (rs > 120 ? 120 : rs);
    const int qc = qt * 32 + l32;
    int cs = qc - 8; cs = cs < 0 ? 0 : (cs > 48 ? 48 : cs);
    const long tok0 = (long)b * SEQ;
    bf16x8 qf[4];
    {
        const bf16_t* qp = P + (tok0 + r * 64 + qc) * PW + CNQ + h * 64 + hi * 8;
#pragma unroll
        for (int kk = 0; kk < 4; ++kk) qf[kk] = gld16b(qp + kk * 16);
    }
    f32x16 o[2];
#pragma unroll
    for (int dt = 0; dt < 2; ++dt)
#pragma unroll
        for (int i = 0; i < 16; ++i) o[dt][i] = 0.f;
    float mrun = -INFINITY, lrun = 0.f;
    const int kr = kperm(l32);
    constexpr float C = 0.125f * LOG2E;
    const bf16_t* kbase = P + (tok0 + kr) * PW + CNK + h * 64 + hi * 8;
    const bf16_t* vbase = NVT + ((long)(b * 8 + h) * 64 + l32) * SEQ + hi * 8;
    bf16_t* wl = (bf16_t*)((unsigned char*)lds + 8192) + wave * (64 * LSTR);
    const int srow = lane >> 3, scol = (lane & 7) * 8;
    const bf16_t* kg = P + (tok0 + srow) * PW + CNK + h * 64 + scol;
    const bf16_t* vg = NVT + ((long)(b * 8 + h) * 64 + srow) * SEQ + scol;
    u32x4 kst[8], vst[8];
#define NAT_LOADK(krow) do { _Pragma("unroll") for (int i = 0; i < 8; ++i) kst[i] = gld16(kg + (long)((krow) * 64 + 8 * i) * PW); } while (0)
#define NAT_LOADV(krow) do { _Pragma("unroll") for (int i = 0; i < 8; ++i) vst[i] = gld16(vg + (long)(8 * i) * SEQ + (krow) * 64); } while (0)
    NAT_LOADK(rs);
    NAT_LOADV(rs);
#pragma unroll 1
    for (int ir = 0; ir < 8; ++ir) {
        const int krow = rs + ir;
        const int nrow = (ir < 7) ? krow + 1 : krow;
        const float* brow = bh + (krow - r + 7) * 31 + 15 - qc;
        bf16x8 kf[2][4], vf[2][2][2];
#pragma unroll
        for (int i = 0; i < 8; ++i) *(u32x4*)(wl + (srow + 8 * i) * LSTR + scol) = kst[i];
        __builtin_amdgcn_sched_barrier(0);
#pragma unroll
        for (int kt = 0; kt < 2; ++kt)
#pragma unroll
            for (int kk = 0; kk < 4; ++kk) kf[kt][kk] = *(const bf16x8*)(wl + (kt * 32 + kr) * LSTR + hi * 8 + kk * 16);
        __builtin_amdgcn_sched_barrier(0);
        NAT_LOADK(nrow);
        f32x16 s[2];
#pragma unroll
        for (int kt = 0; kt < 2; ++kt) {
#pragma unroll
            for (int i = 0; i < 16; ++i) s[kt][i] = 0.f;
#pragma unroll
            for (int kk = 0; kk < 4; ++kk) s[kt] = mfma32(kf[kt][kk], qf[kk], s[kt]);
        }
        __builtin_amdgcn_sched_barrier(0);
#pragma unroll
        for (int i = 0; i < 8; ++i) *(u32x4*)(wl + (srow + 8 * i) * LSTR + scol) = vst[i];
        __builtin_amdgcn_sched_barrier(0);
#pragma unroll
        for (int dt = 0; dt < 2; ++dt)
#pragma unroll
            for (int kt = 0; kt < 2; ++kt)
#pragma unroll
                for (int sl = 0; sl < 2; ++sl) vf[dt][kt][sl] = *(const bf16x8*)(wl + (dt * 32 + l32) * LSTR + hi * 8 + kt * 32 + sl * 16);
        __builtin_amdgcn_sched_barrier(0);
        NAT_LOADV(nrow);
        float mx = -INFINITY;
#pragma unroll
        for (int g4 = 0; g4 < 4; ++g4) {
            const int kt = g4 >> 1, sl = g4 & 1;
            const bool dead = (g4 == 3 && qt == 0) || (g4 == 0 && qt == 1);
            if (!dead) {
#pragma unroll
                for (int e = 0; e < 8; ++e) {
                    const int i = sl * 8 + e;
                    const int kc = kt * 32 + 16 * sl + 8 * hi + e;
                    const bool valid = (kc >= cs) && (kc < cs + 16);
                    const float bv = brow[valid ? kc : qc];
                    const float v = valid ? (s[kt][i] * C + bv * LOG2E) : -INFINITY;
                    s[kt][i] = v; mx = fmaxf(mx, v);
                }
            }
        }
        mx = fmaxf(mx, xhalf(mx));
        const float mnew = fmaxf(mrun, mx);
        const float alpha = fexp2(mrun - mnew);
        mrun = mnew;
        float ps = 0.f;
        bf16x8 pb[2][2];
#pragma unroll
        for (int g4 = 0; g4 < 4; ++g4) {
            const int kt = g4 >> 1, sl = g4 & 1;
            const bool dead = (g4 == 3 && qt == 0) || (g4 == 0 && qt == 1);
            if (!dead) {
                float pe[8];
#pragma unroll
                for (int e = 0; e < 8; ++e) { pe[e] = fexp2(s[kt][sl * 8 + e] - mnew); ps += pe[e]; }
                u32x4 w;
                w.x = pk_bf16_m(pe[0], pe[1]); w.y = pk_bf16_m(pe[2], pe[3]); w.z = pk_bf16_m(pe[4], pe[5]); w.w = pk_bf16_m(pe[6], pe[7]);
                pb[kt][sl] = __builtin_bit_cast(bf16x8, w);
            }
        }
        lrun = lrun * alpha + ps;
#pragma unroll
        for (int dt = 0; dt < 2; ++dt)
#pragma unroll
            for (int i = 0; i < 16; ++i) o[dt][i] *= alpha;
#pragma unroll
        for (int g4 = 0; g4 < 4; ++g4) {
            const int kt = g4 >> 1, sl = g4 & 1;
            const bool dead = (g4 == 3 && qt == 0) || (g4 == 0 && qt == 1);
            if (!dead) {
#pragma unroll
                for (int dt = 0; dt < 2; ++dt) o[dt] = mfma32(vf[dt][kt][sl], pb[kt][sl], o[dt]);
            }
        }
        __builtin_amdgcn_sched_barrier(0);
    }
#undef NAT_LOADK
#undef NAT_LOADV
    lrun += xhalf(lrun);
    const float inv = 1.0f / lrun;
    bf16_t* op = P + (tok0 + r * 64 + qc) * PW + CNQ + h * 64;
#pragma unroll
    for (int dt = 0; dt < 2; ++dt)
#pragma unroll
        for (int q = 0; q < 4; ++q) {
            u32x2 w; w.x = pk_bf16(o[dt][4 * q] * inv, o[dt][4 * q + 1] * inv); w.y = pk_bf16(o[dt][4 * q + 2] * inv, o[dt][4 * q + 3] * inv);
            *(u32x2*)(op + dt * 32 + 8 * q + 4 * hi) = w;
        }
}

DEVI void s5z_tile(const Params& p, int layer, int t, bf16_t* lds) {
    unsigned char* ws = ows(p);
    const bf16_t* P = (const bf16_t*)(ws + OFF_P);
    const bf16_t* Zt = (const bf16_t*)(ws + OFF_S5 + layer * S5_LAYER + S5_ZT);
    float* ZS = (float*)(ws + OFF_ZS);
    const int lane = otid() & 63, wave = __builtin_amdgcn_readfirstlane(otid() >> 6), wn = wave & 1, wm = wave >> 1, l32 = lane & 31, hi = lane >> 5;
    const int g = t >> 2, tm = t & 3;
    const int m0 = tm * 256;
    f32x16 acc[4][2];
    zero_acc<4, 2>(acc);
    gemm_kloop<4, 2>(acc, Zt + ((long)g * 256) * 512, 512, P + ((long)m0 * 32) * PW + CSU + g * 16, XS5{}, 512, lds);
#pragma unroll
    for (int mt = 0; mt < 2; ++mt) {
        const int R = m0 + wm * 64 + mt * 32 + l32, b = R >> 8, c = R & 255;
        float* zp = ZS + ((long)((b * 32 + g) * 256 + c)) * 256 + wn * 128;
#pragma unroll
        for (int nt = 0; nt < 4; ++nt)
#pragma unroll
            for (int q = 0; q < 4; ++q) {
                f32x4 v = {acc[nt][mt][4 * q], acc[nt][mt][4 * q + 1], acc[nt][mt][4 * q + 2], acc[nt][mt][4 * q + 3]};
                *(f32x4*)(zp + nt * 32 + 8 * q + 4 * hi) = v;
            }
    }
}


DEVI void scan_wave_unit(const Params& p, int layer, int b, int g, int dir) {
    unsigned char* ws = ows(p);
    const float* ZS = (const float*)(ws + OFF_ZS);
    bf16_t* SP = (bf16_t*)(ws + OFF_SPREV);
    const f32x2* LT = (const f32x2*)(ws + OFF_S5 + layer * S5_LAYER + S5_LAMT);
    const int lane = otid() & 63;
    const f32x2 lt = LT[(dir * 32 + g) * 64 + lane];
    const long base = ((long)(b * 32 + g) * 256) * 256 + dir * 128 + lane;
    float sr = 0.f, si = 0.f;
    for (int cb = 0; cb < 16; ++cb) {
        float zr[16], zi[16];
#pragma unroll
        for (int i = 0; i < 16; ++i) {
            const int cc = cb * 16 + i, c = dir ? 255 - cc : cc;
            zr[i] = __uint_as_float(__hip_atomic_load((const unsigned*)(ZS + base + (long)c * 256), __ATOMIC_RELAXED, __HIP_MEMORY_SCOPE_AGENT));
            zi[i] = __uint_as_float(__hip_atomic_load((const unsigned*)(ZS + base + (long)c * 256 + 64), __ATOMIC_RELAXED, __HIP_MEMORY_SCOPE_AGENT));
        }
#pragma unroll
        for (int i = 0; i < 16; ++i) {
            const int cc = cb * 16 + i, c = dir ? 255 - cc : cc;
            SP[base + (long)c * 256] = f2bf(sr); SP[base + (long)c * 256 + 64] = f2bf(si);
            const float nr = lt.x * sr - lt.y * si + zr[i], ni = lt.x * si + lt.y * sr + zi[i];
            sr = nr; si = ni;
        }
    }
}

DEVI void s5c_tile(const Params& p, int layer, int t, bf16_t* lds) {
    unsigned char* ws = ows(p);
    const bf16_t* P = (const bf16_t*)(ws + OFF_P);
    const bf16_t* SP = (const bf16_t*)(ws + OFF_SPREV);
    const bf16_t* Bt = (const bf16_t*)(ws + OFF_S5 + layer * S5_LAYER + S5_BT);
    bf16_t* ZB = (bf16_t*)(ws + OFF_ZB);
    const int lane = otid() & 63, wave = __builtin_amdgcn_readfirstlane(otid() >> 6), wn = wave & 1, wm = wave >> 1, l32 = lane & 31, hi = lane >> 5;
    {
        const int g = t >> 3, tm = (t >> 1) & 3, tn = t & 1;
        const int n0 = tn * 256, m0 = tm * 256;
        f32x16 acc[4][2];
        zero_acc<4, 2>(acc);
        gemm_kloop<4, 2>(acc, Bt + ((long)g * 512 + n0) * 768, 768, P + ((long)m0 * 32) * PW + CSU + g * 16, XS5{}, 512, lds);
        gemm_kloop<4, 2>(acc, Bt + ((long)g * 512 + n0) * 768 + 512, 768, SP + ((long)(((m0 >> 8) * 32 + g) * 256)) * 256, XRow{256}, 256, lds);
#pragma unroll
        for (int mt = 0; mt < 2; ++mt) {
            const int R = m0 + wm * 64 + mt * 32 + l32;
#pragma unroll
            for (int nt = 0; nt < 4; ++nt)
#pragma unroll
                for (int q = 0; q < 4; ++q) {
                    const int n = n0 + wn * 128 + nt * 32 + 8 * q + 4 * hi;
                    u32x2 w;
                    w.x = pk_bf16(gelu_tanh(acc[nt][mt][4 * q]), gelu_tanh(acc[nt][mt][4 * q + 1]));
                    w.y = pk_bf16(gelu_tanh(acc[nt][mt][4 * q + 2]), gelu_tanh(acc[nt][mt][4 * q + 3]));
                    *(u32x2*)(ZB + ((long)R * 32 + (n >> 4)) * 512 + g * 16 + (n & 15)) = w;
                }
        }
    }
}

DEVI void glu_tile(const Params& p, int layer, int t, bf16_t* lds) {
    unsigned char* ws = ows(p);
    bf16_t* P = (bf16_t*)(ws + OFF_P);
    const bf16_t* ZB = (const bf16_t*)(ws + OFF_ZB);
    const bf16_t* wt = (const bf16_t*)(ws + OFF_W + layer * W_LAYER + W_GLU);
    const int lane = otid() & 63, wave = __builtin_amdgcn_readfirstlane(otid() >> 6), wn = wave & 1, wm = wave >> 1, l32 = lane & 31, hi = lane >> 5;
    {
        const int tm = t >> 1, tn = t & 1;
        const int n0 = tn * 256, m0 = tm * 256;
        f32x16 acc[4][2];
        zero_acc<4, 2>(acc);
        gemm_kloop<4, 2>(acc, wt + (long)n0 * 512, 512, ZB + (long)m0 * 512, XRow{512}, 512, lds);
#pragma unroll
        for (int mt = 0; mt < 2; ++mt) {
            const int m = m0 + wm * 64 + mt * 32 + l32;
#pragma unroll
            for (int nt = 0; nt < 4; ++nt)
#pragma unroll
                for (int q = 0; q < 4; ++q) {
                    const int n = n0 + wn * 128 + nt * 32 + 8 * q + 4 * hi;
                    const u32x2 zz = *(const u32x2*)(ZB + (long)m * 512 + n);
                    const float z0 = bf2f(zz.x & 0xffffu), z1 = bf2f(zz.x >> 16), z2 = bf2f(zz.y & 0xffffu), z3 = bf2f(zz.y >> 16);
                    u32x2 w;
                    w.x = pk_bf16(z0 * sigmoidf_(acc[nt][mt][4 * q]), z1 * sigmoidf_(acc[nt][mt][4 * q + 1]));
                    w.y = pk_bf16(z2 * sigmoidf_(acc[nt][mt][4 * q + 2]), z3 * sigmoidf_(acc[nt][mt][4 * q + 3]));
                    *(u32x2*)(P + (long)m * PW + CSU + n) = w;
                }
        }
    }
}

DEVI int queue_grab(unsigned* ctr, volatile unsigned* slot, int tid) {
    asm volatile("s_waitcnt vmcnt(0)" ::: "memory");
    __syncthreads();
    if (tid == 0) *slot = __hip_atomic_fetch_add(ctr, 1u, __ATOMIC_RELAXED, __HIP_MEMORY_SCOPE_AGENT);
    __syncthreads();
    return (int)*slot;
}
DEVI void phase_mixers(const Params& p, int layer, bf16_t* lds) {
    unsigned char* ws = ows(p);
    unsigned* ctl = (unsigned*)(ws + OFF_CTL);
    unsigned* q = ctl + 64 + layer * 320;
    unsigned* done = ctl + 704 + layer * 64;
    volatile unsigned* slot = (volatile unsigned*)((unsigned char*)lds + LDS_BYTES - 16);
    const int tid = otid();
    const int wave = __builtin_amdgcn_readfirstlane(tid >> 6);
    const int xcd = (int)(__builtin_amdgcn_s_getreg((3 << 11) | 20) & 7u);
    int u;
    while ((u = queue_grab(q, slot, tid)) < 128) {
        const int g = u >> 2, b = u & 3;
        s5z_tile(p, layer, u, lds);
        asm volatile("s_waitcnt vmcnt(0)" ::: "memory");
        __syncthreads();
        if (wave < 2) scan_wave_unit(p, layer, b, g, wave);
        asm volatile("s_waitcnt vmcnt(0)" ::: "memory");
        __syncthreads();
        s5c_tile(p, layer, (g << 3) + (b << 1), lds);
        s5c_tile(p, layer, (g << 3) + (b << 1) + 1, lds);
        asm volatile("s_waitcnt vmcnt(0)" ::: "memory");
        __syncthreads();
        if (tid == 0) {
            __builtin_amdgcn_fence(__ATOMIC_RELEASE, "agent");
            asm volatile("s_waitcnt vmcnt(0)" ::: "memory");
            __hip_atomic_fetch_add(done + b * 16, 1u, __ATOMIC_RELAXED, __HIP_MEMORY_SCOPE_AGENT);
        }
    }
#pragma unroll 1
    for (int j8 = 0; j8 < 8; ++j8) {
        const int xs = (xcd + j8) & 7;
        while ((u = queue_grab(q + 16 * (1 + xs), slot, tid)) < 128)
            gqa_unit(p, layer, ((xs >> 1) << 8) | ((((xs & 1) << 2) | (u & 3)) << 5) | (u >> 2), lds);
    }
    while ((u = queue_grab(q + 16 * 9, slot, tid)) < 256) {
        const int b = u >> 6;
        if (tid == 0) {
            while (__hip_atomic_load(done + b * 16, __ATOMIC_RELAXED, __HIP_MEMORY_SCOPE_AGENT) < 32u) __builtin_amdgcn_s_sleep(8);
            __builtin_amdgcn_fence(__ATOMIC_ACQUIRE, "agent");
            asm volatile("s_waitcnt vmcnt(0)" ::: "memory");
        }
        __syncthreads();
        glu_tile(p, layer, u, lds);
    }
#pragma unroll 1
    for (int j8 = 0; j8 < 8; ++j8) {
        const int xs = (xcd + j8) & 7;
        while ((u = queue_grab(q + 16 * (10 + xs), slot, tid)) < 128)
            nat_block_unit(p, layer, ((xs >> 1) << 8) | (u << 1) | (xs & 1), lds);
    }
}

DEVI void phase_merge(const Params& p, int layer, bf16_t* lds) {
    unsigned char* ws = ows(p);
    const bf16_t* P = (const bf16_t*)(ws + OFF_P);
    const bf16_t* xb = (const bf16_t*)(ws + OFF_XB);
    const bf16_t* wg = (const bf16_t*)(ws + OFF_W + layer * W_LAYER + W_IN) + (long)PW * DM;
    const bf16_t* wbr = (const bf16_t*)(ws + OFF_W + layer * W_LAYER + W_BR);
    bf16_t* MG = (bf16_t*)(ws + OFF_MERGED);
    const int lane = otid() & 63, wave = __builtin_amdgcn_readfirstlane(otid() >> 6), wn = wave & 1, wm = wave >> 1, l32 = lane & 31, hi = lane >> 5;
    for (int t = vblock(); t < 8 * 128; t += gridDim.x) {
        const int tm = t >> 3, tn = t & 7;
        const int n0 = tn * 128, m0 = tm * 256;
        f32x16 mg[2][2];
        zero_acc<2, 2>(mg);
#pragma unroll 1
        for (int br = 0; br < 3; ++br) {
            const int bcol = (br == 0) ? CQ : (br == 1 ? CNQ : CSU);
            f32x16 acc[2][2];
            unsigned sg[2][2][8];
            zero_acc<2, 2>(acc);
            gemm_kloop<2, 2>(acc, wg + ((long)br * DM + n0) * DM, DM, xb + (long)m0 * DM, XRow{DM}, DM, lds);
#pragma unroll
            for (int nt = 0; nt < 2; ++nt)
#pragma unroll
                for (int mt = 0; mt < 2; ++mt)
#pragma unroll
                    for (int i = 0; i < 8; ++i) sg[nt][mt][i] = pk_bf16(sigmoidf_(acc[nt][mt][2 * i]), sigmoidf_(acc[nt][mt][2 * i + 1]));
            zero_acc<2, 2>(acc);
            gemm_kloop<2, 2>(acc, wbr + ((long)br * DM + n0) * 512, 512, P + (long)m0 * PW + bcol, XRow{PW}, 512, lds);
#pragma unroll
            for (int nt = 0; nt < 2; ++nt)
#pragma unroll
                for (int mt = 0; mt < 2; ++mt)
#pragma unroll
                    for (int i = 0; i < 8; ++i) {
                        mg[nt][mt][2 * i] += bf2f(sg[nt][mt][i] & 0xffffu) * acc[nt][mt][2 * i];
                        mg[nt][mt][2 * i + 1] += bf2f(sg[nt][mt][i] >> 16) * acc[nt][mt][2 * i + 1];
                    }
        }
        __syncthreads();
        bf16_t* wl = lds + wave * (64 * 72);
#pragma unroll
        for (int mt = 0; mt < 2; ++mt)
#pragma unroll
            for (int nt = 0; nt < 2; ++nt)
#pragma unroll
                for (int q = 0; q < 4; ++q) {
                    u32x2 w; w.x = pk_bf16(mg[nt][mt][4 * q], mg[nt][mt][4 * q + 1]); w.y = pk_bf16(mg[nt][mt][4 * q + 2], mg[nt][mt][4 * q + 3]);
                    *(u32x2*)(wl + (mt * 32 + l32) * 72 + nt * 32 + 8 * q + 4 * hi) = w;
                }
        wave_rows_out<2>(wl, MG + (long)(m0 + wm * 64) * DM + n0 + wn * 64, DM, lane);
    }
}

DEVI void phase_res_gemm_ln(const bf16_t* A, int K, const bf16_t* wt, float* out, bf16_t* xb, const float* gain, const float* bias,
                            f32x2* stats, unsigned* cnt, bf16_t* lds, bool rev = false) {
    const int tid = otid(), lane = tid & 63, wave = __builtin_amdgcn_readfirstlane(tid >> 6), wn = wave & 1, wm = wave >> 1, l32 = lane & 31, hi = lane >> 5;
    for (int t = vblock(); t < 4 * 128; t += gridDim.x) {
        const int tm = rev ? 127 - (t >> 2) : (t >> 2), tn = t & 3;
        const int n0 = tn * 256, m0 = tm * 256;
        f32x16 acc[4][2];
        zero_acc<4, 2>(acc);
        gemm_kloop<4, 2>(acc, wt + (long)n0 * K, K, A + (long)m0 * K, XRow{K}, K, lds);
#pragma unroll
        for (int mt = 0; mt < 2; ++mt) {
            const int m = m0 + wm * 64 + mt * 32 + l32;
            float s1 = 0.f, s2 = 0.f;
#pragma unroll
            for (int nt = 0; nt < 4; ++nt)
#pragma unroll
                for (int q = 0; q < 4; ++q) {
                    const long idx = (long)m * DM + n0 + wn * 128 + nt * 32 + 8 * q + 4 * hi;
                    const u32x2 rr = *(const u32x2*)(xb + idx);
                    const float r[4] = {bf2f(rr.x & 0xffffu), bf2f(rr.x >> 16), bf2f(rr.y & 0xffffu), bf2f(rr.y >> 16)};
#pragma unroll
                    for (int e = 0; e < 4; ++e) {
                        const float v = ALPHA * r[e] + acc[nt][mt][4 * q + e];
                        acc[nt][mt][4 * q + e] = v; s1 += v; s2 += v * v;
                    }
                }
            s1 += xhalf(s1); s2 += xhalf(s2);
            if (hi == 0) __hip_atomic_store((unsigned long long*)(stats + (long)m * 8 + tn * 2 + wn),
                                            ((unsigned long long)__float_as_uint(s2) << 32) | (unsigned long long)__float_as_uint(s1), __ATOMIC_RELAXED, __HIP_MEMORY_SCOPE_AGENT);
        }
        asm volatile("s_waitcnt vmcnt(0)" ::: "memory");
        __syncthreads();
        if (tid == 0) {
            __hip_atomic_fetch_add(cnt + tm, 1u, __ATOMIC_RELAXED, __HIP_MEMORY_SCOPE_AGENT);
            while (__hip_atomic_load(cnt + tm, __ATOMIC_RELAXED, __HIP_MEMORY_SCOPE_AGENT) < 4u) __builtin_amdgcn_s_sleep(1);
        }
        __syncthreads();
        float mu[2], rstd[2];
#pragma unroll
        for (int mt = 0; mt < 2; ++mt) {
            const int m = m0 + wm * 64 + mt * 32 + l32;
            float s1 = 0.f, s2 = 0.f;
#pragma unroll
            for (int j = 0; j < 8; ++j) {
                const unsigned long long pj = __hip_atomic_load((unsigned long long*)(stats + (long)m * 8 + j), __ATOMIC_RELAXED, __HIP_MEMORY_SCOPE_AGENT);
                s1 += __uint_as_float((unsigned)pj); s2 += __uint_as_float((unsigned)(pj >> 32));
            }
            mu[mt] = s1 * (1.0f / DM);
            const float var = fmaxf(s2 * (1.0f / DM) - mu[mt] * mu[mt], 0.f);
            rstd[mt] = rsqrtf(var + 1e-5f);
        }
#pragma unroll
        for (int nt = 0; nt < 4; ++nt) {
#pragma unroll
            for (int q = 0; q < 4; ++q) {
                const int n = n0 + wn * 128 + nt * 32 + 8 * q + 4 * hi;
                const f32x4 g4 = *(const GAS f32x4*)(const GAS float*)(gain + n), b4 = *(const GAS f32x4*)(const GAS float*)(bias + n);
#pragma unroll
                for (int mt = 0; mt < 2; ++mt) {
                    acc[nt][mt][4 * q] = (acc[nt][mt][4 * q] - mu[mt]) * rstd[mt] * g4.x + b4.x; acc[nt][mt][4 * q + 1] = (acc[nt][mt][4 * q + 1] - mu[mt]) * rstd[mt] * g4.y + b4.y;
                    acc[nt][mt][4 * q + 2] = (acc[nt][mt][4 * q + 2] - mu[mt]) * rstd[mt] * g4.z + b4.z; acc[nt][mt][4 * q + 3] = (acc[nt][mt][4 * q + 3] - mu[mt]) * rstd[mt] * g4.w + b4.w;
                }
            }
            __builtin_amdgcn_sched_barrier(0);
        }
        __builtin_amdgcn_sched_barrier(0);
        if (out) {
#pragma unroll
            for (int mt = 0; mt < 2; ++mt) {
                float* orow = out + (long)(m0 + wm * 64 + mt * 32 + l32) * DM + n0 + wn * 128 + 4 * hi;
#pragma unroll
                for (int nt = 0; nt < 4; ++nt)
#pragma unroll
                    for (int q = 0; q < 4; ++q)
                        *(f32x4*)(orow + nt * 32 + 8 * q) = (f32x4){acc[nt][mt][4 * q], acc[nt][mt][4 * q + 1], acc[nt][mt][4 * q + 2], acc[nt][mt][4 * q + 3]};
            }
        } else {
            bf16_t* wl = lds + wave * (64 * 136);
#pragma unroll
            for (int mt = 0; mt < 2; ++mt)
#pragma unroll
                for (int nt = 0; nt < 4; ++nt)
#pragma unroll
                    for (int q = 0; q < 4; ++q) {
                        u32x2 w; w.x = pk_bf16(acc[nt][mt][4 * q], acc[nt][mt][4 * q + 1]); w.y = pk_bf16(acc[nt][mt][4 * q + 2], acc[nt][mt][4 * q + 3]);
                        *(u32x2*)(wl + (mt * 32 + l32) * 136 + nt * 32 + 8 * q + 4 * hi) = w;
                    }
            wave_rows_out<4>(wl, xb + (long)(m0 + wm * 64) * DM + n0 + wn * 128, DM, lane);
        }
    }
}

DEVI void phase_ffn_up(const Params& p, int layer, bf16_t* lds) {
    unsigned char* ws = ows(p);
    const bf16_t* xb = (const bf16_t*)(ws + OFF_XB);
    const bf16_t* wt = (const bf16_t*)(ws + OFF_W + layer * W_LAYER + W_UP);
    bf16_t* H = (bf16_t*)(ws + OFF_H);
    const int lane = otid() & 63, wave = __builtin_amdgcn_readfirstlane(otid() >> 6), wn = wave & 1, wm = wave >> 1, l32 = lane & 31, hi = lane >> 5;
    for (int t = vblock(); t < 16 * 128; t += gridDim.x) {
        const int v8 = t & 255, grp = v8 >> 5, w5 = v8 & 31;
        const int tm = (t >> 8) * 16 + (grp & 3) * 4 + (w5 & 3), tn = (grp >> 2) * 8 + (w5 >> 2);
        const int n0 = tn * 256, m0 = tm * 256;
        f32x16 acc[4][2];
        zero_acc<4, 2>(acc);
        gemm_kloop<4, 2>(acc, wt + (long)n0 * DM, DM, xb + (long)m0 * DM, XRow{DM}, DM, lds);
        __syncthreads();
        bf16_t* wl = lds + wave * (64 * 136);
#pragma unroll
        for (int mt = 0; mt < 2; ++mt)
#pragma unroll
            for (int nt = 0; nt < 4; ++nt)
#pragma unroll
                for (int q = 0; q < 4; ++q) {
                    float v[4];
#pragma unroll
                    for (int e = 0; e < 4; ++e) { const float a = fmaxf(acc[nt][mt][4 * q + e], 0.f); v[e] = a * a; }
                    u32x2 w; w.x = pk_bf16(v[0], v[1]); w.y = pk_bf16(v[2], v[3]);
                    *(u32x2*)(wl + (mt * 32 + l32) * 136 + nt * 32 + 8 * q + 4 * hi) = w;
                }
        wave_rows_out<4>(wl, H + (long)(m0 + wm * 64) * FFN + n0 + wn * 128, FFN, lane);
    }
}

DEVI void phase_ln(const float* src, float* dst, bf16_t* xb, const float* gain, const float* bias) {
    const int lane = otid() & 63, wave = otid() >> 6;
    for (int row = blockIdx.x * NWAVES + wave; row < MTOK; row += gridDim.x * NWAVES) {
        const float* s = src + (long)row * DM;
        f32x4 v[4];
#pragma unroll
        for (int i = 0; i < 4; ++i) v[i] = *(const f32x4*)(s + i * 256 + lane * 4);
        float sum = 0.f;
#pragma unroll
        for (int i = 0; i < 4; ++i) sum += v[i].x + v[i].y + v[i].z + v[i].w;
#pragma unroll
        for (int o = 1; o < 64; o <<= 1) sum += __shfl_xor(sum, o);
        const float mu = sum * (1.0f / DM);
        float sq = 0.f;
#pragma unroll
        for (int i = 0; i < 4; ++i) { v[i].x -= mu; v[i].y -= mu; v[i].z -= mu; v[i].w -= mu; sq += v[i].x * v[i].x + v[i].y * v[i].y + v[i].z * v[i].z + v[i].w * v[i].w; }
#pragma unroll
        for (int o = 1; o < 64; o <<= 1) sq += __shfl_xor(sq, o);
        const float rstd = rsqrtf(sq * (1.0f / DM) + 1e-5f);
#pragma unroll
        for (int i = 0; i < 4; ++i) {
            const int c = i * 256 + lane * 4;
            const f32x4 g = *(const f32x4*)(gain + c), bb = *(const f32x4*)(bias + c);
            f32x4 y;
            y.x = v[i].x * rstd * g.x + bb.x; y.y = v[i].y * rstd * g.y + bb.y; y.z = v[i].z * rstd * g.z + bb.z; y.w = v[i].w * rstd * g.w + bb.w;
            *(f32x4*)(dst + (long)row * DM + c) = y;
            u32x2 w; w.x = pk_bf16(y.x, y.y); w.y = pk_bf16(y.z, y.w);
            *(u32x2*)(xb + (long)row * DM + c) = w;
        }
    }
}

DEVI void transpose_mat(const float* src, int K, int N, bf16_t* dst, float* tl) {
    const int tid = otid();
    const int tk = K / 64, tn = N / 64;
    for (int t = blockIdx.x; t < tk * tn; t += gridDim.x) {
        const int k0 = (t / tn) * 64, n0 = (t % tn) * 64;
        __syncthreads();
#pragma unroll
        for (int i = 0; i < 2; ++i) {
            const int e = tid + 512 * i, r = e >> 4, c4 = (e & 15) * 4;
            const f32x4 v = *(const f32x4*)(src + (long)(k0 + r) * N + n0 + c4);
            tl[r * 65 + c4] = v.x; tl[r * 65 + c4 + 1] = v.y; tl[r * 65 + c4 + 2] = v.z; tl[r * 65 + c4 + 3] = v.w;
        }
        __syncthreads();
#pragma unroll
        for (int i = 0; i < 1; ++i) {
            const int e = tid, n = e >> 3, kc = (e & 7) * 8;
            u32x4 w;
            w.x = pk_bf16(tl[(kc + 0) * 65 + n], tl[(kc + 1) * 65 + n]); w.y = pk_bf16(tl[(kc + 2) * 65 + n], tl[(kc + 3) * 65 + n]);
            w.z = pk_bf16(tl[(kc + 4) * 65 + n], tl[(kc + 5) * 65 + n]); w.w = pk_bf16(tl[(kc + 6) * 65 + n], tl[(kc + 7) * 65 + n]);
            *(u32x4*)(dst + (long)(n0 + n) * K + k0 + kc) = w;
        }
    }
}

struct Cx { float re, im; };
DEVI Cx cmul(Cx a, Cx b) { return {a.re * b.re - a.im * b.im, a.re * b.im + a.im * b.re}; }
DEVI Cx lam_pow(float are, float aim, float dt, float n) {
    const float mag = fexp2(are * dt * n * LOG2E);
    const float ph = (aim * dt) * n;
    return {mag * __cosf(ph), mag * __sinf(ph)};
}
DEVI Cx zoh_coef(float are, float aim, float dt) {
    const Cx lam = lam_pow(are, aim, dt, 1.0f);
    const float den = are * are + aim * aim, nr = lam.re - 1.0f;
    return {(nr * are + lam.im * aim) / den, (lam.im * are - nr * aim) / den};
}

DEVI void phase_prologue_a(const Params& p, bf16_t* lds) {
    unsigned char* ws = ows(p);
    float* tl = (float*)lds;
    const int tid = otid();
    const long gtid = (long)blockIdx.x * NTHREADS + tid, gsz = (long)gridDim.x * NTHREADS;
    {
        const float* x = p.in[0];
        bf16_t* xb = (bf16_t*)(ws + OFF_XB);
        for (long e = gtid; e < (long)MTOK * DM / 4; e += gsz) {
            const f32x4 v = *(const f32x4*)(x + e * 4);
            u32x2 w; w.x = pk_bf16(v.x, v.y); w.y = pk_bf16(v.z, v.w);
            *(u32x2*)(xb + e * 4) = w;
        }
    }
    for (int layer = 0; layer < 2; ++layer) {
        unsigned char* wl = ws + OFF_W + layer * W_LAYER;
        transpose_mat(p.in[1] + (long)layer * DM * INW, DM, INW, (bf16_t*)(wl + W_IN), tl);
        transpose_mat(p.in[13] + (long)layer * 512 * 512, 512, 512, (bf16_t*)(wl + W_GLU), tl);
        for (int br = 0; br < 3; ++br)
            transpose_mat(p.in[14] + ((long)layer * 3 + br) * 512 * DM, 512, DM, (bf16_t*)(wl + W_BR) + (long)br * DM * 512, tl);
        transpose_mat(p.in[15] + (long)layer * DM * DM, DM, DM, (bf16_t*)(wl + W_OUT), tl);
        transpose_mat(p.in[18] + (long)layer * DM * FFN, DM, FFN, (bf16_t*)(wl + W_UP), tl);
        transpose_mat(p.in[19] + (long)layer * FFN * DM, FFN, DM, (bf16_t*)(wl + W_DN), tl);

        unsigned char* sl = ws + OFF_S5 + layer * S5_LAYER;
        bf16_t* Bt = (bf16_t*)(sl + S5_BT);
        bf16_t* Zt = (bf16_t*)(sl + S5_ZT);
        float* KT = (float*)(sl + S5_KTAB);
        f32x2* LT = (f32x2*)(sl + S5_LAMT);
        const float* a_re = p.in[5] + layer * 2 * 32 * 64;
        const float* a_im = p.in[6] + layer * 2 * 32 * 64;
        const float* ldt = p.in[7] + layer * 2 * 32;
        const float* b_re = p.in[8] + (long)layer * 32 * 64 * 16;
        const float* b_im = p.in[9] + (long)layer * 32 * 64 * 16;
        const float* c_re = p.in[10] + (long)layer * 2 * 32 * 16 * 64;
        const float* c_im = p.in[11] + (long)layer * 2 * 32 * 16 * 64;
        for (long e = gtid; e < 2 * 32 * 64; e += gsz) {
            const int dg = (int)(e >> 6);
            const float dt = __expf(ldt[dg]);
            const Cx l = lam_pow(a_re[e], a_im[e], dt, 32.0f);
            LT[e] = (f32x2){l.re, l.im};
        }
        for (long e = gtid; e < 32 * 2 * 32 * 64; e += gsz) {
            const int pp = (int)(e & 63), jt = (int)((e >> 6) & 31), dir = (int)((e >> 11) & 1), g = (int)(e >> 12);
            const int ai = (dir * 32 + g) * 64 + pp;
            const float are = a_re[ai], aim = a_im[ai], dt = __expf(ldt[dir * 32 + g]);
            const Cx coef = zoh_coef(are, aim, dt);
            {
                const Cx w = cmul(lam_pow(are, aim, dt, (float)(dir == 0 ? 31 - jt : jt)), coef);
                bf16_t* zr = Zt + ((long)(g * 256 + dir * 128 + pp)) * 512 + jt * 16;
                bf16_t* zi = zr + 64 * 512;
#pragma unroll
                for (int h = 0; h < 16; ++h) {
                    const Cx bb = {b_re[(g * 64 + pp) * 16 + h], b_im[(g * 64 + pp) * 16 + h]};
                    const Cx wb = cmul(w, bb);
                    zr[h] = f2bf(wb.re); zi[h] = f2bf(wb.im);
                }
            }
            {
                const Cx lp = lam_pow(are, aim, dt, (float)(dir == 0 ? jt + 1 : 32 - jt));
#pragma unroll
                for (int h = 0; h < 16; ++h) {
                    const int ci = ((dir * 32 + g) * 16 + h) * 64 + pp;
                    const Cx c = cmul((Cx){c_re[ci], c_im[ci]}, lp);
                    bf16_t* bp = Bt + ((long)(g * 512 + jt * 16 + h)) * 768 + 512 + dir * 128 + pp;
                    bp[0] = f2bf(c.re); bp[64] = f2bf(-c.im);
                }
            }
        }
        for (int u = blockIdx.x; u < 2 * 32 * 32; u += gridDim.x) {
            const int tau = u & 31, g = (u >> 5) & 31, dir = u >> 10;
            __syncthreads();
            if (tid < 64) {
                const int ai = (dir * 32 + g) * 64 + tid;
                const float are = a_re[ai], aim = a_im[ai], dt = __expf(ldt[dir * 32 + g]);
                const Cx w = cmul(lam_pow(are, aim, dt, (float)tau), zoh_coef(are, aim, dt));
                tl[2 * tid] = w.re; tl[2 * tid + 1] = w.im;
            }
            __syncthreads();
            const int hp = (tid >> 4) & 15, h = tid & 15;
            float acc = 0.f;
            if (tid < 256)
            for (int pp = 0; pp < 64; ++pp) {
                const Cx w = {tl[2 * pp], tl[2 * pp + 1]};
                const Cx bb = {b_re[(g * 64 + pp) * 16 + h], b_im[(g * 64 + pp) * 16 + h]};
                const Cx wb = cmul(w, bb);
                const int ci = ((dir * 32 + g) * 16 + hp) * 64 + pp;
                acc += c_re[ci] * wb.re - c_im[ci] * wb.im;
            }
            if (tid < 256) KT[((long)((dir * 32 + g) * 32 + tau)) * 256 + tid] = acc;
        }
    }
}

DEVI void phase_prologue_b(const Params& p) {
    unsigned char* ws = ows(p);
    const long gtid = (long)blockIdx.x * NTHREADS + otid(), gsz = (long)gridDim.x * NTHREADS;
    for (int layer = 0; layer < 2; ++layer) {
        unsigned char* sl = ws + OFF_S5 + layer * S5_LAYER;
        bf16_t* Bt = (bf16_t*)(sl + S5_BT);
        const float* KT = (const float*)(sl + S5_KTAB);
        const float* dsk = p.in[12] + layer * 32 * 16;
        for (long e = gtid; e < 32L * 512 * 64; e += gsz) {
            const int kc = (int)(e & 63), n = (int)((e >> 6) & 511), g = (int)(e >> 15);
            const int j = kc >> 1, h0 = (kc & 1) * 8, t = n >> 4, hp = n & 15;
            float v[8];
            if (j < t) {
                const float* k = KT + ((long)((0 * 32 + g) * 32 + (t - j))) * 256 + hp * 16 + h0;
#pragma unroll
                for (int i = 0; i < 8; ++i) v[i] = k[i];
            } else if (j > t) {
                const float* k = KT + ((long)((1 * 32 + g) * 32 + (j - t))) * 256 + hp * 16 + h0;
#pragma unroll
                for (int i = 0; i < 8; ++i) v[i] = k[i];
            } else {
                const float* kf = KT + ((long)((0 * 32 + g) * 32)) * 256 + hp * 16 + h0;
                const float* kb = KT + ((long)((1 * 32 + g) * 32)) * 256 + hp * 16 + h0;
#pragma unroll
                for (int i = 0; i < 8; ++i) v[i] = kf[i] + kb[i] + ((h0 + i == hp) ? dsk[g * 16 + hp] : 0.f);
            }
            u32x4 w; w.x = pk_bf16(v[0], v[1]); w.y = pk_bf16(v[2], v[3]); w.z = pk_bf16(v[4], v[5]); w.w = pk_bf16(v[6], v[7]);
            *(u32x4*)(Bt + ((long)(g * 512 + n)) * 768 + kc * 8) = w;
        }
    }
}


#define XB_TMO      128
#define XB_XCNT(j)  (256  + 64 * (j))
#define XB_XSUB(j)  (1280 + 64 * (j))
#define XB_XGEN(j)  (2304 + 64 * (j))
#define XB_TOP      3328
#define XB_TOPGEN   3392
#define XCD_BAR_WORDS 3456
#define XB_SPIN_CAP (1u << 18)

__device__ __forceinline__ unsigned xb_ld(unsigned* p)              { return __hip_atomic_load(p, __ATOMIC_RELAXED, __HIP_MEMORY_SCOPE_AGENT); }
__device__ __forceinline__ unsigned xb_add(unsigned* p, unsigned v) { return __hip_atomic_fetch_add(p, v, __ATOMIC_RELAXED, __HIP_MEMORY_SCOPE_AGENT); }
__device__ __forceinline__ unsigned xb_xcc_id() { return (unsigned)__builtin_amdgcn_s_getreg((3 << 11) | 20) & 0xFu; }
#define XB_SPIN(cond, bar) do { unsigned _sp = 0; while (cond) { __builtin_amdgcn_s_sleep(1); \
    if ((++_sp & 255u) == 0u) { if (xb_ld(&(bar)[XB_TMO])) break; if (_sp > XB_SPIN_CAP) { atomicAdd(&(bar)[XB_TMO], 1u); break; } } } } while (0)

struct XcdBarrier {
    unsigned* bar; unsigned x;
    volatile LAS unsigned* st;
};

__device__ __forceinline__ XcdBarrier xcd_barrier_post(unsigned* bar, volatile LAS unsigned* st) {
    XcdBarrier b; b.bar = bar; b.x = xb_xcc_id(); b.st = st;
    if (threadIdx.x == 0) (void)xb_add(&bar[XB_XCNT(b.x)], 1u);
    return b;
}
__device__ __forceinline__ void xcd_barrier_complete(unsigned* bar, unsigned x, unsigned& nloc, unsigned& nx) {
    const unsigned G = gridDim.x * gridDim.y * gridDim.z;
    unsigned sum, cnt, mine, sp = 0u;
    for (;;) {
        sum = 0u; cnt = 0u; mine = 0u;
#pragma unroll
        for (unsigned j = 0; j < 16; ++j) { const unsigned c = xb_ld(&bar[XB_XCNT(j)]); sum += c; cnt += (c > 0u) ? 1u : 0u; mine = (j == x) ? c : mine; }
        if (sum == G) break;
        __builtin_amdgcn_s_sleep(1);
        if ((++sp & 255u) == 0u) { if (xb_ld(&bar[XB_TMO])) break; if (sp > XB_SPIN_CAP) { atomicAdd(&bar[XB_TMO], 1u); break; } }
    }
    nloc = mine > 0u ? mine : 1u; nx = cnt > 0u ? cnt : 1u;
}

__device__ __forceinline__ void xcd_barrier(const XcdBarrier& b) {
    asm volatile("s_waitcnt vmcnt(0)" ::: "memory");
    __syncthreads();
    if (threadIdx.x == 0) {
        unsigned* bar = b.bar;
        __builtin_amdgcn_s_waitcnt(0);
        unsigned nloc = b.st[0], nx = b.st[1];
        if (nloc == 0u) { xcd_barrier_complete(bar, b.x, nloc, nx); b.st[0] = nloc; b.st[1] = nx; }
        const unsigned old = xb_add(&bar[XB_XSUB(b.x)], 1u);
        const unsigned gen = old / nloc;
        if (old + 1u == (gen + 1u) * nloc) {
            __builtin_amdgcn_fence(__ATOMIC_RELEASE, "agent");
            asm volatile("s_waitcnt vmcnt(0)" ::: "memory");
            const unsigned og = xb_add(&bar[XB_TOP], 1u);
            const unsigned tg = og / nx;
            if (og + 1u == (tg + 1u) * nx) xb_add(&bar[XB_TOPGEN], 1u);
            else XB_SPIN(xb_ld(&bar[XB_TOPGEN]) == tg, bar);
            __builtin_amdgcn_fence(__ATOMIC_ACQUIRE, "agent");
            xb_add(&bar[XB_XGEN(b.x)], 1u);
            asm volatile("s_waitcnt vmcnt(0)" ::: "memory");
        } else {
            XB_SPIN(xb_ld(&bar[XB_XGEN(b.x)]) == gen, bar);
            __builtin_amdgcn_fence(__ATOMIC_ACQUIRE, "agent");
            asm volatile("s_waitcnt vmcnt(0)" ::: "memory");
        }
    }
    __syncthreads();
}


DEVI void grid_barrier(unsigned* ctr, unsigned target) {
    asm volatile("s_waitcnt vmcnt(0) lgkmcnt(0)" ::: "memory");
    __syncthreads();
    if (threadIdx.x == 0) {
        __builtin_amdgcn_fence(__ATOMIC_RELEASE, "agent");
        asm volatile("s_waitcnt vmcnt(0)" ::: "memory");
        __hip_atomic_fetch_add(ctr, 1u, __ATOMIC_RELAXED, __HIP_MEMORY_SCOPE_AGENT);
        while (__hip_atomic_load(ctr, __ATOMIC_RELAXED, __HIP_MEMORY_SCOPE_AGENT) < target) __builtin_amdgcn_s_sleep(2);
        __builtin_amdgcn_fence(__ATOMIC_ACQUIRE, "agent");
        asm volatile("s_waitcnt vmcnt(0)" ::: "memory");
    }
    __syncthreads();
}

constexpr int PH_PER_LAYER = 6;
constexpr int N_PHASES = 2 + PH_PER_LAYER * 2;
__global__ void __launch_bounds__(NTHREADS, 2) fwd_kernel(Params p) {
    extern __shared__ __attribute__((aligned(16))) unsigned char lds_raw[];
    bf16_t* lds = (bf16_t*)lds_raw;
    unsigned char* ws = ows(p);
    volatile LAS unsigned* xst = (volatile LAS unsigned*)(LAS unsigned char*)(lds_raw + LDS_BYTES - 32);
    if (threadIdx.x == 0) { xst[0] = 0u; xst[1] = 0u; }
    __syncthreads();
    const XcdBarrier xbar = xcd_barrier_post((unsigned*)(ws + OFF_CTL + 16384), xst);
    for (int ph = p.ph_lo; ph < p.ph_hi; ++ph) {
        if (ph == 0) phase_prologue_a(p, lds);
        else if (ph == 1) phase_prologue_b(p);
        else {
            const int layer = (ph - 2) / PH_PER_LAYER, sub = (ph - 2) % PH_PER_LAYER;
            switch (sub) {
            case 0: phase_inproj(p, layer, lds); break;
            case 1: phase_mixers(p, layer, lds); break;
            case 2: phase_merge(p, layer, lds); break;
            case 3: phase_res_gemm_ln((const bf16_t*)(ws + OFF_MERGED), DM, (const bf16_t*)(ws + OFF_W + layer * W_LAYER + W_OUT), nullptr, (bf16_t*)(ws + OFF_XB),
                                      p.in[16] + layer * DM, p.in[17] + layer * DM, (f32x2*)(ws + OFF_STATS), (unsigned*)(ws + OFF_CTL) + 1024 + (layer * 2) * 128, lds); break;
            case 4: phase_ffn_up(p, layer, lds); break;
            default: phase_res_gemm_ln((const bf16_t*)(ws + OFF_H), FFN, (const bf16_t*)(ws + OFF_W + layer * W_LAYER + W_DN), layer == 1 ? p.out : nullptr, (bf16_t*)(ws + OFF_XB),
                                      p.in[20] + layer * DM, p.in[21] + layer * DM, (f32x2*)(ws + OFF_STATS), (unsigned*)(ws + OFF_CTL) + 1024 + (layer * 2 + 1) * 128, lds, true); break;
            }
        }
        if (ph + 1 < p.ph_hi) {
            if (p.ph_lo < 0) cg::this_grid().sync();
            xcd_barrier(xbar);
        }
    }
}

extern "C" void kernel_launch(void* const* d_in, const int* in_sizes, int n_in, void* d_out, int out_size, void* d_ws, size_t ws_size, hipStream_t stream) {
    static int grid = 0;
    if (grid == 0) {
        if (n_in != 22 || ws_size < WS_END) { fprintf(stderr, "kernel_launch: unexpected n_in %d / ws_size %zu\n", n_in, ws_size); grid = -1; return; }
        int dev = 0, cus = 0, per_cu = 0;
        hipGetDevice(&dev);
        hipDeviceGetAttribute(&cus, hipDeviceAttributeMultiprocessorCount, dev);
        hipFuncSetAttribute((const void*)fwd_kernel, hipFuncAttributeMaxDynamicSharedMemorySize, LDS_BYTES);
        hipOccupancyMaxActiveBlocksPerMultiprocessor(&per_cu, (const void*)fwd_kernel, NTHREADS, LDS_BYTES);
        if (per_cu < 1) per_cu = 1;
        if (per_cu > 1) per_cu = 1;
        grid = cus * per_cu;
        fprintf(stderr, "kernel_launch: grid %d (%d CUs x %d)\n", grid, cus, per_cu);
    }
    if (grid < 0) return;
    Params p{};
    for (int i = 0; i < 22; ++i) p.in[i] = (const float*)d_in[i];
    p.out = (float*)d_out; p.ws = (unsigned char*)d_ws;
#if SINGLE_LAUNCH
    hipMemsetAsync((unsigned char*)d_ws + OFF_CTL, 0, 32768, stream);
    p.ph_lo = 0; p.ph_hi = N_PHASES;
    void* args[] = {&p};
    hipError_t e = hipLaunchCooperativeKernel((const void*)fwd_kernel, dim3(grid), dim3(NTHREADS), args, LDS_BYTES, stream);
    if (e != hipSuccess) fprintf(stderr, "cooperative launch failed: %s (grid %d)\n", hipGetErrorString(e), grid);
#else
    for (int ph = 0; ph < N_PHASES; ++ph) {
        p.ph_lo = ph; p.ph_hi = ph + 1;
        hipLaunchKernelGGL(fwd_kernel, dim3(grid), dim3(NTHREADS), LDS_BYTES, stream, p);
    }
#endif
}
```

```cpp
#include <hip/hip_runtime.h>
#include <hip/hip_cooperative_groups.h>
#include <cstdio>
namespace cg = cooperative_groups;

#ifndef SINGLE_LAUNCH
#define SINGLE_LAUNCH 1
#endif

typedef unsigned short bf16_t;
typedef short bf16x8 __attribute__((ext_vector_type(8)));
typedef float f32x16 __attribute__((ext_vector_type(16)));
typedef float f32x4 __attribute__((ext_vector_type(4)));
typedef float f32x2 __attribute__((ext_vector_type(2)));
typedef unsigned u32x4 __attribute__((ext_vector_type(4)));
typedef unsigned u32x2 __attribute__((ext_vector_type(2)));
#define DEVI __device__ __forceinline__

constexpr int DM = 1024, SEQ = 8192, NB = 4, MTOK = NB * SEQ, FFN = 4096, INW = 5888;
constexpr int PW = 2816;
constexpr int CQ = 0, CK = 512, CNQ = 768, CNK = 1280, CSU = 2304;
constexpr float ALPHA = 1.4142135623730951f;
constexpr float LOG2E = 1.4426950408889634f;
constexpr int NTHREADS = 512, NWAVES = 8;
constexpr int LSTR = 72;
constexpr int LDS_BYTES = 2 * (256 + 256) * LSTR * 2;

constexpr size_t MiB = 1u << 20;
constexpr size_t OFF_P = 0, OFF_H = 0, OFF_ZB = 176 * MiB, OFF_MERGED = 176 * MiB, OFF_NVT = 208 * MiB, OFF_VT = 240 * MiB;
constexpr size_t OFF_ZS = 256 * MiB, OFF_SPREV = 288 * MiB;
constexpr size_t OFF_W = 304 * MiB, W_LAYER = 34 * MiB;
constexpr size_t W_IN = 0, W_GLU = 12 * MiB, W_BR = 13 * MiB, W_OUT = 16 * MiB, W_UP = 18 * MiB, W_DN = 26 * MiB;
constexpr size_t OFF_S5 = 372 * MiB, S5_LAYER = 35 * MiB;
constexpr size_t S5_BT = 0, S5_ZT = 24 * MiB, S5_KTAB = 32 * MiB, S5_LAMT = 34 * MiB;
constexpr size_t OFF_XB = 442 * MiB;
constexpr size_t OFF_CTL = 506 * MiB;
constexpr size_t OFF_STATS = 507 * MiB;
constexpr size_t WS_END = 509 * MiB;

struct Params {
    const float* in[22];
    float* out;
    unsigned char* ws;
    int ph_lo, ph_hi;
};

DEVI unsigned char* ows(const Params& p) { unsigned char* w = p.ws; asm volatile("" : "+s"(w)); return w; }
#define GAS __attribute__((address_space(1)))
DEVI u32x4 gld16(const void* p) { return *(const GAS u32x4*)(const GAS char*)p; }
DEVI bf16x8 gld16b(const void* p) { return *(const GAS bf16x8*)(const GAS char*)p; }
DEVI void gst8(void* base, unsigned off, u32x2 v) { *(GAS u32x2*)((GAS char*)base + off) = v; }
DEVI void gst2(void* base, unsigned off, bf16_t v) { *(GAS bf16_t*)((GAS char*)base + off) = v; }
DEVI int otid() { int t = threadIdx.x; asm volatile("" : "+v"(t)); return t; }
typedef __bf16 bf16x2_t __attribute__((ext_vector_type(2)));
DEVI unsigned pk_bf16_m(float lo, float hi) { const f32x2 v = {lo, hi}; const bf16x2_t b = __builtin_convertvector(v, bf16x2_t); return __builtin_bit_cast(unsigned, b); }
DEVI unsigned pk_bf16(float lo, float hi) { unsigned r; asm("v_cvt_pk_bf16_f32 %0, %1, %2" : "=v"(r) : "v"(lo), "v"(hi)); return r; }
DEVI bf16_t f2bf(float f) { return (bf16_t)(pk_bf16(f, 0.f) & 0xffffu); }
DEVI float bf2f(unsigned v) { return __uint_as_float(v << 16); }
DEVI float fexp2(float x) { return __builtin_amdgcn_exp2f(x); }
DEVI float sigmoidf_(float x) { return 1.0f / (1.0f + fexp2(-x * LOG2E)); }
DEVI float gelu_tanh(float y) {
    const float u = 0.7978845608028654f * (y + 0.044715f * y * y * y);
    return y * sigmoidf_(2.0f * u);
}
DEVI f32x16 mfma32(bf16x8 a, bf16x8 b, f32x16 c) { return __builtin_amdgcn_mfma_f32_32x32x16_bf16(a, b, c, 0, 0, 0); }
DEVI float xhalf(float v) { return __shfl_xor(v, 32); }

#define LAS __attribute__((address_space(3)))
#define SB() __builtin_amdgcn_sched_barrier(0)
template <int NT, int MT, class XF>
DEVI void gemm_kloop(f32x16 (&acc)[NT][MT], const bf16_t* wbase, int ldw, const bf16_t* xbase, const XF& xf, int K, bf16_t* lds) {
    const int tid = otid(), lane = tid & 63;
    const int wave = __builtin_amdgcn_readfirstlane(tid >> 6);
    const int wn = wave & 1, wm = wave >> 1, l32 = lane & 31, hi = lane >> 5;
    constexpr int WR = 64 * NT, XR = 128 * MT, WI = WR / 64, XI = XR / 64, STAGE = (WR + XR) * 64, NP = WI + XI;
    const int nk = K >> 6;
    const int lrow = wave * 8 + (lane >> 3);
    const int lc = ((lane & 7) ^ ((lrow >> 1) & 7)) * 8;
    const unsigned woff0 = ((unsigned)lrow * (unsigned)ldw + (unsigned)lc) * 2u;
    const unsigned wstep = 64u * (unsigned)ldw * 2u;
    unsigned xoff[XI];
#pragma unroll
    for (int j = 0; j < XI; ++j) xoff[j] = xf.off((unsigned)(lrow + 64 * j), (unsigned)lc) * 2u;
    const GAS char* wp = (const GAS char*)wbase;
    const GAS char* xp = (const GAS char*)xbase;
    const unsigned xstep = (unsigned)xf.kstep() * 2u;
    LAS bf16_t* L = (LAS bf16_t*)lds;
    const int sw = (l32 >> 1) & 7;
    int koff[4];
#pragma unroll
    for (int kk = 0; kk < 4; ++kk) koff[kk] = ((kk * 2 + hi) ^ sw) * 8;
#define GEMM_PIECE(bufi, pi) do { \
        LAS bf16_t* _d = L + (bufi) * STAGE + wave * 8 * 64; \
        if ((pi) < WI) __builtin_amdgcn_global_load_lds((const GAS unsigned*)(wp + woff0 + (pi) * wstep), (LAS unsigned*)(_d + (pi) * 64 * 64), 16, 0, 0); \
        else if ((pi) < NP) __builtin_amdgcn_global_load_lds((const GAS unsigned*)(xp + xoff[((pi) - WI) < XI ? ((pi) - WI) : 0]), (LAS unsigned*)(_d + (WR + ((pi) - WI) * 64) * 64), 16, 0, 0); \
    } while (0)
#define GEMM_RFR(set, kk) do { \
        _Pragma("unroll") for (int mt = 0; mt < MT; ++mt) fb[set][mt] = *(const LAS bf16x8*)(xsb + mt * 32 * 64 + koff[kk]); \
        _Pragma("unroll") for (int nt = 0; nt < NT; ++nt) fa[set][nt] = *(const LAS bf16x8*)(wsb + nt * 32 * 64 + koff[kk]); \
    } while (0)
#define GEMM_MMA(set, nlo, nhi) do { \
        __builtin_amdgcn_s_setprio(1); \
        _Pragma("unroll") for (int nt = (nlo); nt < (nhi); ++nt) \
        _Pragma("unroll") for (int mt = 0; mt < MT; ++mt) acc[nt][mt] = mfma32(fa[set][nt], fb[set][mt], acc[nt][mt]); \
        __builtin_amdgcn_s_setprio(0); \
    } while (0)
    asm volatile("s_waitcnt vmcnt(0)" ::: "memory");
    __builtin_amdgcn_s_barrier();
#pragma unroll
    for (int pi = 0; pi < NP; ++pi) GEMM_PIECE(0, pi);
#pragma unroll 1
    for (int kt = 0; kt < nk; ++kt) {
        const int buf = kt & 1;
        const bool more = (kt + 1 < nk);
        asm volatile("s_waitcnt vmcnt(0) lgkmcnt(0)" ::: "memory");
        __builtin_amdgcn_s_barrier();
        const LAS bf16_t* wsb = L + buf * STAGE + (wn * 32 * NT + l32) * 64;
        const LAS bf16_t* xsb = L + buf * STAGE + (WR + wm * 32 * MT + l32) * 64;
        bf16x8 fa[2][NT], fb[2][MT];
        GEMM_RFR(0, 0);
        SB();
        if (more) { wp += 128; xp += xstep; }
#pragma unroll
        for (int kk = 0; kk < 4; ++kk) {
            if (kk < 3) { GEMM_RFR((kk + 1) & 1, kk + 1); }
            SB();
            if (more && kk < 2) { GEMM_PIECE(buf ^ 1, 4 * kk); GEMM_PIECE(buf ^ 1, 4 * kk + 1); }
            SB();
            GEMM_MMA(kk & 1, 0, NT / 2);
            SB();
            if (more && kk < 2) { GEMM_PIECE(buf ^ 1, 4 * kk + 2); GEMM_PIECE(buf ^ 1, 4 * kk + 3); }
            SB();
            GEMM_MMA(kk & 1, NT / 2, NT);
            SB();
        }
    }
#undef GEMM_PIECE
#undef GEMM_RFR
#undef GEMM_MMA
}

template <int NT, int MT> DEVI void zero_acc(f32x16 (&acc)[NT][MT]) {
#pragma unroll
    for (int nt = 0; nt < NT; ++nt)
#pragma unroll
        for (int mt = 0; mt < MT; ++mt)
#pragma unroll
            for (int i = 0; i < 16; ++i) acc[nt][mt][i] = 0.f;
}
DEVI int vblock() { const int G = gridDim.x, b = blockIdx.x; return (G % 8 == 0) ? (b % 8) * (G / 8) + b / 8 : b; }

struct XRow {
    int ld;
    DEVI unsigned off(unsigned r, unsigned kc) const { return r * (unsigned)ld + kc; }
    DEVI int kstep() const { return 64; }
};
struct XS5 {
    DEVI unsigned off(unsigned r, unsigned kc) const { return (r * 32u + (kc >> 4)) * (unsigned)PW + (kc & 15u); }
    DEVI int kstep() const { return 4 * PW; }
};


template <int NT> DEVI void wave_rows_out(const bf16_t* wl, bf16_t* gbase, long ld, int lane) {
    constexpr int RS = NT * 32 + 8, CPR = NT * 4, RPI = 64 / CPR;
    asm volatile("s_waitcnt lgkmcnt(0)" ::: "memory");
    const bf16_t* lp = wl + (lane / CPR) * RS + (lane % CPR) * 8;
    const unsigned loff = ((unsigned)(lane / CPR) * (unsigned)ld + (unsigned)(lane % CPR) * 8u) * 2u;
    GAS char* gp = (GAS char*)gbase;
    const unsigned gstep = (unsigned)RPI * (unsigned)ld * 2u;
#pragma unroll 4
    for (int j = 0; j < NT * 4; ++j) {
        const u32x4 v = *(const u32x4*)(lp);
        __builtin_nontemporal_store(v, (GAS u32x4*)(gp + loff));
        gp += gstep; lp += RPI * RS;
    }
}

DEVI void phase_inproj(const Params& p, int layer, bf16_t* lds) {
    unsigned char* ws = ows(p);
    const bf16_t* xb = (const bf16_t*)(ws + OFF_XB);
    const bf16_t* wt = (const bf16_t*)(ws + OFF_W + layer * W_LAYER + W_IN);
    bf16_t* P = (bf16_t*)(ws + OFF_P);
    bf16_t* VT = (bf16_t*)(ws + OFF_VT);
    bf16_t* NVT = (bf16_t*)(ws + OFF_NVT);
    const float* qg = p.in[2] + layer * 64;
    const float* kg = p.in[3] + layer * 64;
    const int tid0 = otid();
    const int wave = __builtin_amdgcn_readfirstlane(tid0 >> 6), wn = wave & 1, wm = wave >> 1;
    constexpr int NT_N = PW / 256, NT_M = MTOK / 256;
    for (int t = vblock(); t < NT_N * NT_M; t += gridDim.x) {
        const int tm = t / NT_N, tn = t % NT_N;
        const int n0 = tn * 256, m0 = tm * 256;
        f32x16 acc[4][2];
        zero_acc<4, 2>(acc);
        gemm_kloop<4, 2>(acc, wt + (long)n0 * DM, DM, xb + (long)m0 * DM, XRow{DM}, DM, lds);
        __syncthreads();
        bf16_t* wl = lds + wave * (64 * 136);
        int lane = tid0 & 63; asm volatile("" : "+v"(lane));
        const int l32 = lane & 31, hi = lane >> 5;
        const int nbw = n0 + wn * 128;
        const int mw = m0 + wm * 64;
        bf16_t* pbase = P + (long)mw * PW + nbw;
        if (nbw < 640) {
            const float* gain = (nbw < 512) ? qg : kg;
#pragma unroll
            for (int hp = 0; hp < 2; ++hp)
#pragma unroll
            for (int mt = 0; mt < 2; ++mt) {
                const int tpos = (mw + mt * 32 + l32) & (SEQ - 1);
                float ss = 0.f;
#pragma unroll
                for (int nt = 0; nt < 2; ++nt)
#pragma unroll
                    for (int i = 0; i < 16; ++i) ss += acc[2 * hp + nt][mt][i] * acc[2 * hp + nt][mt][i];
                ss += xhalf(ss);
                const float rs = rsqrtf(ss * (1.0f / 64.0f) + 1e-6f) * ((nbw < 512) ? 0.125f * LOG2E : 1.0f);
#pragma unroll
                for (int nt = 0; nt < 2; ++nt) {
                    const float pos = (float)(nt == 0 ? (tpos >> 6) : (tpos & 63));
                    float v[16];
#pragma unroll
                    for (int q = 0; q < 4; ++q) {
                        const f32x4 g4 = *(const GAS f32x4*)(const GAS float*)(gain + nt * 32 + 8 * q + 4 * hi);
                        v[4 * q] = acc[2 * hp + nt][mt][4 * q] * rs * g4.x; v[4 * q + 1] = acc[2 * hp + nt][mt][4 * q + 1] * rs * g4.y;
                        v[4 * q + 2] = acc[2 * hp + nt][mt][4 * q + 2] * rs * g4.z; v[4 * q + 3] = acc[2 * hp + nt][mt][4 * q + 3] * rs * g4.w;
                    }
#pragma unroll
                    for (int i = 0; i < 8; ++i) {
                        const int j = 8 * (i >> 2) + 4 * hi + (i & 3);
                        const float inv = fexp2(-(float)j * 0.8304820237218406f);
                        const float ang = pos * inv;
                        const float c = __cosf(ang), sn = __sinf(ang);
                        const float x1 = v[i], x2 = v[i + 8];
                        v[i] = x1 * c - x2 * sn;
                        v[i + 8] = x2 * c + x1 * sn;
                    }
#pragma unroll
                    for (int q = 0; q < 4; ++q) {
                        u32x2 w; w.x = pk_bf16(v[4 * q], v[4 * q + 1]); w.y = pk_bf16(v[4 * q + 2], v[4 * q + 3]);
                        *(u32x2*)(wl + (mt * 32 + l32) * 136 + hp * 64 + nt * 32 + 8 * q + 4 * hi) = w;
                    }
                    __builtin_amdgcn_sched_barrier(0);
                }
            }
            wave_rows_out<4>(wl, pbase, PW, lane);
        } else if (nbw == 640 || (nbw >= 1792 && nbw < 2304)) {
            const int b = mw >> 13, tpos0 = mw & (SEQ - 1);
            bf16_t* base = (nbw == 640) ? VT + ((long)(b * 2) * 64) * SEQ + tpos0 : NVT + ((long)(b * 8 + ((nbw - 1792) >> 6)) * 64) * SEQ + tpos0;
            const unsigned voff = (unsigned)(4 * hi * SEQ + l32) * 2u;
#pragma unroll
            for (int mt = 0; mt < 2; ++mt)
#pragma unroll
                for (int nt = 0; nt < 4; ++nt)
#pragma unroll
                    for (int i = 0; i < 16; ++i)
                        gst2(base, voff + (unsigned)(((nt * 32 + 8 * (i >> 2) + (i & 3)) * SEQ + mt * 32) * 2), f2bf(acc[nt][mt][i]));
        } else {
#pragma unroll
            for (int mt = 0; mt < 2; ++mt)
#pragma unroll
                for (int nt = 0; nt < 4; ++nt)
#pragma unroll
                    for (int q = 0; q < 4; ++q) {
                        u32x2 w; w.x = pk_bf16(acc[nt][mt][4 * q], acc[nt][mt][4 * q + 1]); w.y = pk_bf16(acc[nt][mt][4 * q + 2], acc[nt][mt][4 * q + 3]);
                        *(u32x2*)(wl + (mt * 32 + l32) * 136 + nt * 32 + 8 * q + 4 * hi) = w;
                    }
            wave_rows_out<4>(wl, pbase, PW, lane);
        }
    }
}

DEVI void online_softmax(f32x16 (&s)[2], f32x16 (&o)[2], float& mrun, float& lrun, bf16x8 (&pb)[2][2]) {
    float mx = s[0][0];
#pragma unroll
    for (int kt = 0; kt < 2; ++kt)
#pragma unroll
        for (int i = 0; i < 16; ++i) mx = fmaxf(mx, s[kt][i]);
    mx = fmaxf(mx, xhalf(mx));
    const float mnew = fmaxf(mrun, mx);
    const float alpha = fexp2(mrun - mnew);
    mrun = mnew;
    float ps = 0.f;
#pragma unroll
    for (int kt = 0; kt < 2; ++kt)
#pragma unroll
        for (int i = 0; i < 16; ++i) { const float e = fexp2(s[kt][i] - mnew); s[kt][i] = e; ps += e; }
    lrun = lrun * alpha + ps;
#pragma unroll
    for (int dt = 0; dt < 2; ++dt)
#pragma unroll
        for (int i = 0; i < 16; ++i) o[dt][i] *= alpha;
#pragma unroll
    for (int kt = 0; kt < 2; ++kt)
#pragma unroll
        for (int sl = 0; sl < 2; ++sl) {
            u32x4 w;
            w.x = pk_bf16_m(s[kt][8 * sl + 0], s[kt][8 * sl + 1]); w.y = pk_bf16_m(s[kt][8 * sl + 2], s[kt][8 * sl + 3]);
            w.z = pk_bf16_m(s[kt][8 * sl + 4], s[kt][8 * sl + 5]); w.w = pk_bf16_m(s[kt][8 * sl + 6], s[kt][8 * sl + 7]);
            pb[kt][sl] = __builtin_bit_cast(bf16x8, w);
        }
}
DEVI int kperm(int r) { return (r & 16) + 8 * ((r >> 2) & 1) + 4 * ((r >> 3) & 1) + (r & 3); }

DEVI void gqa_unit(const Params& p, int layer, int unit, bf16_t* lds) {
    unsigned char* ws = ows(p);
    bf16_t* P = (bf16_t*)(ws + OFF_P);
    const bf16_t* VT = (const bf16_t*)(ws + OFF_VT);
    const int tid = otid(), lane = tid & 63, wave = tid >> 6, l32 = lane & 31, hi = lane >> 5;
    const int qb = unit & 31, h = (unit >> 5) & 7, b = unit >> 8, kvh = h >> 2;
    const int qrow = qb * 256 + wave * 32 + l32;
    bf16_t* Ks = lds;
    bf16_t* Vs = lds + 2 * 64 * LSTR;
    bf16x8 qf[4];
    {
        const bf16_t* qp = P + ((long)(b * SEQ + qrow)) * PW + CQ + h * 64 + hi * 8;
#pragma unroll
        for (int kk = 0; kk < 4; ++kk) qf[kk] = *(const bf16x8*)(qp + kk * 16);
    }
    float mb;
    {
        float gq = fabsf(p.in[2][layer * 64 + lane]), gk = fabsf(p.in[3][layer * 64 + lane]);
#pragma unroll
        for (int o2 = 1; o2 < 64; o2 <<= 1) { gq = fmaxf(gq, __shfl_xor(gq, o2)); gk = fmaxf(gk, __shfl_xor(gk, o2)); }
        mb = 8.0f * gq * gk * LOG2E * 1.01f;
    }
    const bf16_t* kbase = P + ((long)b * SEQ) * PW + CK + kvh * 64;
    const bf16_t* vbase = VT + ((long)(b * 2 + kvh) * 64) * SEQ;
    f32x16 o[2];
#pragma unroll
    for (int dt = 0; dt < 2; ++dt)
#pragma unroll
        for (int i = 0; i < 16; ++i) o[dt][i] = 0.f;
    float lrun = 0.f;
    u32x4 kreg[1], vreg[1];
#pragma unroll
    for (int i = 0; i < 1; ++i) {
        const int c = tid, r = c >> 3, cc = (c & 7) * 8;
        kreg[i] = gld16(kbase + (long)r * PW + cc);
        vreg[i] = gld16(vbase + (long)r * SEQ + cc);
    }
#pragma unroll
    for (int i = 0; i < 1; ++i) {
        const int c = tid, r = c >> 3, cc = (c & 7) * 8;
        *(u32x4*)(Ks + r * LSTR + cc) = kreg[i];
        *(u32x4*)(Vs + r * LSTR + cc) = vreg[i];
    }
    __syncthreads();
    const int kr = kperm(l32);
    for (int kt0 = 0; kt0 < SEQ / 64; ++kt0) {
        const int buf = kt0 & 1;
        const bool more = (kt0 + 1 < SEQ / 64);
        if (more) {
            const int key0 = (kt0 + 1) * 64;
#pragma unroll
            for (int i = 0; i < 1; ++i) {
                const int c = tid, r = c >> 3, cc = (c & 7) * 8;
                kreg[i] = gld16(kbase + (long)(key0 + r) * PW + cc);
                vreg[i] = gld16(vbase + (long)r * SEQ + key0 + cc);
            }
        }
        f32x16 s[2];
        bf16x8 kf[2][4], vf[2][2][2];
#pragma unroll
        for (int kt = 0; kt < 2; ++kt) {
            const bf16_t* kp = Ks + (buf * 64 + kt * 32 + kr) * LSTR + hi * 8;
#pragma unroll
            for (int kk = 0; kk < 4; ++kk) kf[kt][kk] = *(const bf16x8*)(kp + kk * 16);
        }
#pragma unroll
        for (int dt = 0; dt < 2; ++dt) {
            const bf16_t* vp = Vs + (buf * 64 + dt * 32 + l32) * LSTR + hi * 8;
#pragma unroll
            for (int kt = 0; kt < 2; ++kt)
#pragma unroll
                for (int sl = 0; sl < 2; ++sl) vf[dt][kt][sl] = *(const bf16x8*)(vp + kt * 32 + sl * 16);
        }
        __builtin_amdgcn_sched_barrier(0);
        __builtin_amdgcn_s_setprio(1);
#pragma unroll
        for (int kt = 0; kt < 2; ++kt) {
#pragma unroll
            for (int i = 0; i < 16; ++i) s[kt][i] = -mb;
#pragma unroll
            for (int kk = 0; kk < 4; ++kk) s[kt] = mfma32(kf[kt][kk], qf[kk], s[kt]);
        }
        __builtin_amdgcn_s_setprio(0);
        bf16x8 pb[2][2];
#pragma unroll
        for (int kt = 0; kt < 2; ++kt) {
#pragma unroll
            for (int i = 0; i < 16; ++i) { const float e = fexp2(s[kt][i]); s[kt][i] = e; lrun += e; }
#pragma unroll
            for (int sl = 0; sl < 2; ++sl) {
                u32x4 w;
                w.x = pk_bf16_m(s[kt][8 * sl + 0], s[kt][8 * sl + 1]); w.y = pk_bf16_m(s[kt][8 * sl + 2], s[kt][8 * sl + 3]);
                w.z = pk_bf16_m(s[kt][8 * sl + 4], s[kt][8 * sl + 5]); w.w = pk_bf16_m(s[kt][8 * sl + 6], s[kt][8 * sl + 7]);
                pb[kt][sl] = __builtin_bit_cast(bf16x8, w);
            }
        }
#pragma unroll
        for (int dt = 0; dt < 2; ++dt)
#pragma unroll
            for (int kt = 0; kt < 2; ++kt)
#pragma unroll
                for (int sl = 0; sl < 2; ++sl) o[dt] = mfma32(vf[dt][kt][sl], pb[kt][sl], o[dt]);
        if (more) {
            const int nb = buf ^ 1;
#pragma unroll
            for (int i = 0; i < 1; ++i) {
                const int c = tid, r = c >> 3, cc = (c & 7) * 8;
                *(u32x4*)(Ks + (nb * 64 + r) * LSTR + cc) = kreg[i];
                *(u32x4*)(Vs + (nb * 64 + r) * LSTR + cc) = vreg[i];
            }
        }
        __syncthreads();
    }
    lrun += xhalf(lrun);
    const float inv = 1.0f / lrun;
    bf16_t* op = P + ((long)(b * SEQ + qrow)) * PW + CQ + h * 64;
#pragma unroll
    for (int dt = 0; dt < 2; ++dt)
#pragma unroll
        for (int q = 0; q < 4; ++q) {
            u32x2 w; w.x = pk_bf16(o[dt][4 * q] * inv, o[dt][4 * q + 1] * inv); w.y = pk_bf16(o[dt][4 * q + 2] * inv, o[dt][4 * q + 3] * inv);
            *(u32x2*)(op + dt * 32 + 8 * q + 4 * hi) = w;
        }
}

DEVI void nat_block_unit(const Params& p, int layer, int unit, bf16_t* lds) {
    unsigned char* ws = ows(p);
    bf16_t* P = (bf16_t*)(ws + OFF_P);
    const bf16_t* NVT = (const bf16_t*)(ws + OFF_NVT);
    const float* bias = p.in[4] + (long)layer * 8 * 15 * 31;
    const int tid = otid(), lane = tid & 63, wave = __builtin_amdgcn_readfirstlane(tid >> 6), l32 = lane & 31, hi = lane >> 5;
    const int wu = unit * NWAVES + wave;
    const int qt = wu & 1, h = (wu >> 1) & 7, r = (wu >> 4) & 127, b = wu >> 11;
    const int h0 = (unit * 4) & 7;
    float* bl = (float*)lds;
    for (int e = tid; e < 4 * 465; e += NTHREADS) bl[e] = bias[h0 * 465 + e];
    __syncthreads();
    const float* bh = bl + (h - h0) * 465;
    int rs = r - 4; rs = rs < 0 ? 0 : (rs > 120 ? 120 : rs);
    const int qc = qt * 32 + l32;
    int cs = qc - 8; cs = cs < 0 ? 0 : (cs > 48 ? 48 : cs);
    const long tok0 = (long)b * SEQ;
    bf16x8 qf[4];
    {
        const bf16_t* qp = P + (tok0 + r * 64 + qc) * PW + CNQ + h * 64 + hi * 8;
#pragma unroll
        for (int kk = 0; kk < 4; ++kk) qf[kk] = gld16b(qp + kk * 16);
    }
    f32x16 o[2];
#pragma unroll
    for (int dt = 0; dt < 2; ++dt)
#pragma unroll
        for (int i = 0; i < 16; ++i) o[dt][i] = 0.f;
    float mrun = -INFINITY, lrun = 0.f;
    const int kr = kperm(l32);
    constexpr float C = 0.125f * LOG2E;
    const bf16_t* kbase = P + (tok0 + kr) * PW + CNK + h * 64 + hi * 8;
    const bf16_t* vbase = NVT + ((long)(b * 8 + h) * 64 + l32) * SEQ + hi * 8;
    bf16_t* wl = (bf16_t*)((unsigned char*)lds + 8192) + wave * (64 * LSTR);
    const int srow = lane >> 3, scol = (lane & 7) * 8;
    const bf16_t* kg = P + (tok0 + srow) * PW + CNK + h * 64 + scol;
    const bf16_t* vg = NVT + ((long)(b * 8 + h) * 64 + srow) * SEQ + scol;
    u32x4 kst[8], vst[8];
#define NAT_LOADK(krow) do { _Pragma("unroll") for (int i = 0; i < 8; ++i) kst[i] = gld16(kg + (long)((krow) * 64 + 8 * i) * PW); } while (0)
#define NAT_LOADV(krow) do { _Pragma("unroll") for (int i = 0; i < 8; ++i) vst[i] = gld16(vg + (long)(8 * i) * SEQ + (krow) * 64); } while (0)
    NAT_LOADK(rs);
    NAT_LOADV(rs);
#pragma unroll 1
    for (int ir = 0; ir < 8; ++ir) {
        const int krow = rs + ir;
        const int nrow = (ir < 7) ? krow + 1 : krow;
        const float* brow = bh + (krow - r + 7) * 31 + 15 - qc;
        bf16x8 kf[2][4], vf[2][2][2];
#pragma unroll
        for (int i = 0; i < 8; ++i) *(u32x4*)(wl + (srow + 8 * i) * LSTR + scol) = kst[i];
        __builtin_amdgcn_sched_barrier(0);
#pragma unroll
        for (int kt = 0; kt < 2; ++kt)
#pragma unroll
            for (int kk = 0; kk < 4; ++kk) kf[kt][kk] = *(const bf16x8*)(wl + (kt * 32 + kr) * LSTR + hi * 8 + kk * 16);
        __builtin_amdgcn_sched_barrier(0);
        NAT_LOADK(nrow);
        f32x16 s[2];
#pragma unroll
        for (int kt = 0; kt < 2; ++kt) {
#pragma unroll
            for (int i = 0; i < 16; ++i) s[kt][i] = 0.f;
#pragma unroll
            for (int kk = 0; kk < 4; ++kk) s[kt] = mfma32(kf[kt][kk], qf[kk], s[kt]);
        }
        __builtin_amdgcn_sched_barrier(0);
#pragma unroll
        for (int i = 0; i < 8; ++i) *(u32x4*)(wl + (srow + 8 * i) * LSTR + scol) = vst[i];
        __builtin_amdgcn_sched_barrier(0);
#pragma unroll
        for (int dt = 0; dt < 2; ++dt)
#pragma unroll
            for (int kt = 0; kt < 2; ++kt)
#pragma unroll
                for (int sl = 0; sl < 2; ++sl) vf[dt][kt][sl] = *(const bf16x8*)(wl + (dt * 32 + l32) * LSTR + hi * 8 + kt * 32 + sl * 16);
        __builtin_amdgcn_sched_barrier(0);
        NAT_LOADV(nrow);
        float mx = -INFINITY;
#pragma unroll
        for (int g4 = 0; g4 < 4; ++g4) {
            const int kt = g4 >> 1, sl = g4 & 1;
            const bool dead = (g4 == 3 && qt == 0) || (g4 == 0 && qt == 1);
            if (!dead) {
#pragma unroll
                for (int e = 0; e < 8; ++e) {
                    const int i = sl * 8 + e;
                    const int kc = kt * 32 + 16 * sl + 8 * hi + e;
                    const bool valid = (kc >= cs) && (kc < cs + 16);
                    const float bv = brow[valid ? kc : qc];
                    const float v = valid ? (s[kt][i] * C + bv * LOG2E) : -INFINITY;
                    s[kt][i] = v; mx = fmaxf(mx, v);
                }
            }
        }
        mx = fmaxf(mx, xhalf(mx));
        const float mnew = fmaxf(mrun, mx);
        const float alpha = fexp2(mrun - mnew);
        mrun = mnew;
        float ps = 0.f;
        bf16x8 pb[2][2];
#pragma unroll
        for (int g4 = 0; g4 < 4; ++g4) {
            const int kt = g4 >> 1, sl = g4 & 1;
            const bool dead = (g4 == 3 && qt == 0) || (g4 == 0 && qt == 1);
            if (!dead) {
                float pe[8];
#pragma unroll
                for (int e = 0; e < 8; ++e) { pe[e] = fexp2(s[kt][sl * 8 + e] - mnew); ps += pe[e]; }
                u32x4 w;
                w.x = pk_bf16_m(pe[0], pe[1]); w.y = pk_bf16_m(pe[2], pe[3]); w.z = pk_bf16_m(pe[4], pe[5]); w.w = pk_bf16_m(pe[6], pe[7]);
                pb[kt][sl] = __builtin_bit_cast(bf16x8, w);
            }
        }
        lrun = lrun * alpha + ps;
#pragma unroll
        for (int dt = 0; dt < 2; ++dt)
#pragma unroll
            for (int i = 0; i < 16; ++i) o[dt][i] *= alpha;
#pragma unroll
        for (int g4 = 0; g4 < 4; ++g4) {
            const int kt = g4 >> 1, sl = g4 & 1;
            const bool dead = (g4 == 3 && qt == 0) || (g4 == 0 && qt == 1);
            if (!dead) {
#pragma unroll
                for (int dt = 0; dt < 2; ++dt) o[dt] = mfma32(vf[dt][kt][sl], pb[kt][sl], o[dt]);
            }
        }
        __builtin_amdgcn_sched_barrier(0);
    }
#undef NAT_LOADK
#undef NAT_LOADV
    lrun += xhalf(lrun);
    const float inv = 1.0f / lrun;
    bf16_t* op = P + (tok0 + r * 64 + qc) * PW + CNQ + h * 64;
#pragma unroll
    for (int dt = 0; dt < 2; ++dt)
#pragma unroll
        for (int q = 0; q < 4; ++q) {
            u32x2 w; w.x = pk_bf16(o[dt][4 * q] * inv, o[dt][4 * q + 1] * inv); w.y = pk_bf16(o[dt][4 * q + 2] * inv, o[dt][4 * q + 3] * inv);
            *(u32x2*)(op + dt * 32 + 8 * q + 4 * hi) = w;
        }
}

DEVI void s5z_tile(const Params& p, int layer, int t, bf16_t* lds) {
    unsigned char* ws = ows(p);
    const bf16_t* P = (const bf16_t*)(ws + OFF_P);
    const bf16_t* Zt = (const bf16_t*)(ws + OFF_S5 + layer * S5_LAYER + S5_ZT);
    float* ZS = (float*)(ws + OFF_ZS);
    const int lane = otid() & 63, wave = __builtin_amdgcn_readfirstlane(otid() >> 6), wn = wave & 1, wm = wave >> 1, l32 = lane & 31, hi = lane >> 5;
    const int g = t >> 2, tm = t & 3;
    const int m0 = tm * 256;
    f32x16 acc[4][2];
    zero_acc<4, 2>(acc);
    gemm_kloop<4, 2>(acc, Zt + ((long)g * 256) * 512, 512, P + ((long)m0 * 32) * PW + CSU + g * 16, XS5{}, 512, lds);
#pragma unroll
    for (int mt = 0; mt < 2; ++mt) {
        const int R = m0 + wm * 64 + mt * 32 + l32, b = R >> 8, c = R & 255;
        float* zp = ZS + ((long)((b * 32 + g) * 256 + c)) * 256 + wn * 128;
#pragma unroll
        for (int nt = 0; nt < 4; ++nt)
#pragma unroll
            for (int q = 0; q < 4; ++q) {
                f32x4 v = {acc[nt][mt][4 * q], acc[nt][mt][4 * q + 1], acc[nt][mt][4 * q + 2], acc[nt][mt][4 * q + 3]};
                *(f32x4*)(zp + nt * 32 + 8 * q + 4 * hi) = v;
            }
    }
}


DEVI void scan_wave_unit(const Params& p, int layer, int b, int g, int dir) {
    unsigned char* ws = ows(p);
    const float* ZS = (const float*)(ws + OFF_ZS);
    bf16_t* SP = (bf16_t*)(ws + OFF_SPREV);
    const f32x2* LT = (const f32x2*)(ws + OFF_S5 + layer * S5_LAYER + S5_LAMT);
    const int lane = otid() & 63;
    const f32x2 lt = LT[(dir * 32 + g) * 64 + lane];
    const long base = ((long)(b * 32 + g) * 256) * 256 + dir * 128 + lane;
    float sr = 0.f, si = 0.f;
    for (int cb = 0; cb < 16; ++cb) {
        float zr[16], zi[16];
#pragma unroll
        for (int i = 0; i < 16; ++i) {
            const int cc = cb * 16 + i, c = dir ? 255 - cc : cc;
            zr[i] = __uint_as_float(__hip_atomic_load((const unsigned*)(ZS + base + (long)c * 256), __ATOMIC_RELAXED, __HIP_MEMORY_SCOPE_AGENT));
            zi[i] = __uint_as_float(__hip_atomic_load((const unsigned*)(ZS + base + (long)c * 256 + 64), __ATOMIC_RELAXED, __HIP_MEMORY_SCOPE_AGENT));
        }
#pragma unroll
        for (int i = 0; i < 16; ++i) {
            const int cc = cb * 16 + i, c = dir ? 255 - cc : cc;
            SP[base + (long)c * 256] = f2bf(sr); SP[base + (long)c * 256 + 64] = f2bf(si);
            const float nr = lt.x * sr - lt.y * si + zr[i], ni = lt.x * si + lt.y * sr + zi[i];
            sr = nr; si = ni;
        }
    }
}

DEVI void s5c_tile(const Params& p, int layer, int t, bf16_t* lds) {
    unsigned char* ws = ows(p);
    const bf16_t* P = (const bf16_t*)(ws + OFF_P);
    const bf16_t* SP = (const bf16_t*)(ws + OFF_SPREV);
    const bf16_t* Bt = (const bf16_t*)(ws + OFF_S5 + layer * S5_LAYER + S5_BT);
    bf16_t* ZB = (bf16_t*)(ws + OFF_ZB);
    const int lane = otid() & 63, wave = __builtin_amdgcn_readfirstlane(otid() >> 6), wn = wave & 1, wm = wave >> 1, l32 = lane & 31, hi = lane >> 5;
    {
        const int g = t >> 3, tm = (t >> 1) & 3, tn = t & 1;
        const int n0 = tn * 256, m0 = tm * 256;
        f32x16 acc[4][2];
        zero_acc<4, 2>(acc);
        gemm_kloop<4, 2>(acc, Bt + ((long)g * 512 + n0) * 768, 768, P + ((long)m0 * 32) * PW + CSU + g * 16, XS5{}, 512, lds);
        gemm_kloop<4, 2>(acc, Bt + ((long)g * 512 + n0) * 768 + 512, 768, SP + ((long)(((m0 >> 8) * 32 + g) * 256)) * 256, XRow{256}, 256, lds);
#pragma unroll
        for (int mt = 0; mt < 2; ++mt) {
            const int R = m0 + wm * 64 + mt * 32 + l32;
#pragma unroll
            for (int nt = 0; nt < 4; ++nt)
#pragma unroll
                for (int q = 0; q < 4; ++q) {
                    const int n = n0 + wn * 128 + nt * 32 + 8 * q + 4 * hi;
                    u32x2 w;
                    w.x = pk_bf16(gelu_tanh(acc[nt][mt][4 * q]), gelu_tanh(acc[nt][mt][4 * q + 1]));
                    w.y = pk_bf16(gelu_tanh(acc[nt][mt][4 * q + 2]), gelu_tanh(acc[nt][mt][4 * q + 3]));
                    *(u32x2*)(ZB + ((long)R * 32 + (n >> 4)) * 512 + g * 16 + (n & 15)) = w;
                }
        }
    }
}

DEVI void glu_tile(const Params& p, int layer, int t, bf16_t* lds) {
    unsigned char* ws = ows(p);
    bf16_t* P = (bf16_t*)(ws + OFF_P);
    const bf16_t* ZB = (const bf16_t*)(ws + OFF_ZB);
    const bf16_t* wt = (const bf16_t*)(ws + OFF_W + layer * W_LAYER + W_GLU);
    const int lane = otid() & 63, wave = __builtin_amdgcn_readfirstlane(otid() >> 6), wn = wave & 1, wm = wave >> 1, l32 = lane & 31, hi = lane >> 5;
    {
        const int tm = t >> 1, tn = t & 1;
        const int n0 = tn * 256, m0 = tm * 256;
        f32x16 acc[4][2];
        zero_acc<4, 2>(acc);
        gemm_kloop<4, 2>(acc, wt + (long)n0 * 512, 512, ZB + (long)m0 * 512, XRow{512}, 512, lds);
#pragma unroll
        for (int mt = 0; mt < 2; ++mt) {
            const int m = m0 + wm * 64 + mt * 32 + l32;
#pragma unroll
            for (int nt = 0; nt < 4; ++nt)
#pragma unroll
                for (int q = 0; q < 4; ++q) {
                    const int n = n0 + wn * 128 + nt * 32 + 8 * q + 4 * hi;
                    const u32x2 zz = *(const u32x2*)(ZB + (long)m * 512 + n);
                    const float z0 = bf2f(zz.x & 0xffffu), z1 = bf2f(zz.x >> 16), z2 = bf2f(zz.y & 0xffffu), z3 = bf2f(zz.y >> 16);
                    u32x2 w;
                    w.x = pk_bf16(z0 * sigmoidf_(acc[nt][mt][4 * q]), z1 * sigmoidf_(acc[nt][mt][4 * q + 1]));
                    w.y = pk_bf16(z2 * sigmoidf_(acc[nt][mt][4 * q + 2]), z3 * sigmoidf_(acc[nt][mt][4 * q + 3]));
                    *(u32x2*)(P + (long)m * PW + CSU + n) = w;
                }
        }
    }
}

DEVI int queue_grab(unsigned* ctr, volatile unsigned* slot, int tid) {
    asm volatile("s_waitcnt vmcnt(0)" ::: "memory");
    __syncthreads();
    if (tid == 0) *slot = __hip_atomic_fetch_add(ctr, 1u, __ATOMIC_RELAXED, __HIP_MEMORY_SCOPE_AGENT);
    __syncthreads();
    return (int)*slot;
}
DEVI void phase_mixers(const Params& p, int layer, bf16_t* lds) {
    unsigned char* ws = ows(p);
    unsigned* ctl = (unsigned*)(ws + OFF_CTL);
    unsigned* q = ctl + 64 + layer * 320;
    unsigned* done = ctl + 704 + layer * 64;
    volatile unsigned* slot = (volatile unsigned*)((unsigned char*)lds + LDS_BYTES - 16);
    const int tid = otid();
    const int wave = __builtin_amdgcn_readfirstlane(tid >> 6);
    const int xcd = (int)(__builtin_amdgcn_s_getreg((3 << 11) | 20) & 7u);
    int u;
    while ((u = queue_grab(q, slot, tid)) < 128) {
        const int g = u >> 2, b = u & 3;
        s5z_tile(p, layer, u, lds);
        asm volatile("s_waitcnt vmcnt(0)" ::: "memory");
        __syncthreads();
        if (wave < 2) scan_wave_unit(p, layer, b, g, wave);
        asm volatile("s_waitcnt vmcnt(0)" ::: "memory");
        __syncthreads();
        s5c_tile(p, layer, (g << 3) + (b << 1), lds);
        s5c_tile(p, layer, (g << 3) + (b << 1) + 1, lds);
        asm volatile("s_waitcnt vmcnt(0)" ::: "memory");
        __syncthreads();
        if (tid == 0) {
            __builtin_amdgcn_fence(__ATOMIC_RELEASE, "agent");
            asm volatile("s_waitcnt vmcnt(0)" ::: "memory");
            __hip_atomic_fetch_add(done + b * 16, 1u, __ATOMIC_RELAXED, __HIP_MEMORY_SCOPE_AGENT);
        }
    }
#pragma unroll 1
    for (int j8 = 0; j8 < 8; ++j8) {
        const int xs = (xcd + j8) & 7;
        while ((u = queue_grab(q + 16 * (1 + xs), slot, tid)) < 128)
            gqa_unit(p, layer, ((xs >> 1) << 8) | ((((xs & 1) << 2) | (u & 3)) << 5) | (u >> 2), lds);
    }
    while ((u = queue_grab(q + 16 * 9, slot, tid)) < 256) {
        const int b = u >> 6;
        if (tid == 0) {
            while (__hip_atomic_load(done + b * 16, __ATOMIC_RELAXED, __HIP_MEMORY_SCOPE_AGENT) < 32u) __builtin_amdgcn_s_sleep(8);
            __builtin_amdgcn_fence(__ATOMIC_ACQUIRE, "agent");
            asm volatile("s_waitcnt vmcnt(0)" ::: "memory");
        }
        __syncthreads();
        glu_tile(p, layer, u, lds);
    }
#pragma unroll 1
    for (int j8 = 0; j8 < 8; ++j8) {
        const int xs = (xcd + j8) & 7;
        while ((u = queue_grab(q + 16 * (10 + xs), slot, tid)) < 128)
            nat_block_unit(p, layer, ((xs >> 1) << 8) | (u << 1) | (xs & 1), lds);
    }
}

DEVI void phase_merge(const Params& p, int layer, bf16_t* lds) {
    unsigned char* ws = ows(p);
    const bf16_t* P = (const bf16_t*)(ws + OFF_P);
    const bf16_t* xb = (const bf16_t*)(ws + OFF_XB);
    const bf16_t* wg = (const bf16_t*)(ws + OFF_W + layer * W_LAYER + W_IN) + (long)PW * DM;
    const bf16_t* wbr = (const bf16_t*)(ws + OFF_W + layer * W_LAYER + W_BR);
    bf16_t* MG = (bf16_t*)(ws + OFF_MERGED);
    const int lane = otid() & 63, wave = __builtin_amdgcn_readfirstlane(otid() >> 6), wn = wave & 1, wm = wave >> 1, l32 = lane & 31, hi = lane >> 5;
    for (int t = vblock(); t < 8 * 128; t += gridDim.x) {
        const int tm = t >> 3, tn = t & 7;
        const int n0 = tn * 128, m0 = tm * 256;
        f32x16 mg[2][2];
        zero_acc<2, 2>(mg);
#pragma unroll 1
        for (int br = 0; br < 3; ++br) {
            const int bcol = (br == 0) ? CQ : (br == 1 ? CNQ : CSU);
            f32x16 acc[2][2];
            unsigned sg[2][2][8];
            zero_acc<2, 2>(acc);
            gemm_kloop<2, 2>(acc, wg + ((long)br * DM + n0) * DM, DM, xb + (long)m0 * DM, XRow{DM}, DM, lds);
#pragma unroll
            for (int nt = 0; nt < 2; ++nt)
#pragma unroll
                for (int mt = 0; mt < 2; ++mt)
#pragma unroll
                    for (int i = 0; i < 8; ++i) sg[nt][mt][i] = pk_bf16(sigmoidf_(acc[nt][mt][2 * i]), sigmoidf_(acc[nt][mt][2 * i + 1]));
            zero_acc<2, 2>(acc);
            gemm_kloop<2, 2>(acc, wbr + ((long)br * DM + n0) * 512, 512, P + (long)m0 * PW + bcol, XRow{PW}, 512, lds);
#pragma unroll
            for (int nt = 0; nt < 2; ++nt)
#pragma unroll
                for (int mt = 0; mt < 2; ++mt)
#pragma unroll
                    for (int i = 0; i < 8; ++i) {
                        mg[nt][mt][2 * i] += bf2f(sg[nt][mt][i] & 0xffffu) * acc[nt][mt][2 * i];
                        mg[nt][mt][2 * i + 1] += bf2f(sg[nt][mt][i] >> 16) * acc[nt][mt][2 * i + 1];
                    }
        }
        __syncthreads();
        bf16_t* wl = lds + wave * (64 * 72);
#pragma unroll
        for (int mt = 0; mt < 2; ++mt)
#pragma unroll
            for (int nt = 0; nt < 2; ++nt)
#pragma unroll
                for (int q = 0; q < 4; ++q) {
                    u32x2 w; w.x = pk_bf16(mg[nt][mt][4 * q], mg[nt][mt][4 * q + 1]); w.y = pk_bf16(mg[nt][mt][4 * q + 2], mg[nt][mt][4 * q + 3]);
                    *(u32x2*)(wl + (mt * 32 + l32) * 72 + nt * 32 + 8 * q + 4 * hi) = w;
                }
        wave_rows_out<2>(wl, MG + (long)(m0 + wm * 64) * DM + n0 + wn * 64, DM, lane);
    }
}

DEVI void phase_res_gemm_ln(const bf16_t* A, int K, const bf16_t* wt, float* out, bf16_t* xb, const float* gain, const float* bias,
                            f32x2* stats, unsigned* cnt, bf16_t* lds, bool rev = false) {
    const int tid = otid(), lane = tid & 63, wave = __builtin_amdgcn_readfirstlane(tid >> 6), wn = wave & 1, wm = wave >> 1, l32 = lane & 31, hi = lane >> 5;
    for (int t = vblock(); t < 4 * 128; t += gridDim.x) {
        const int tm = rev ? 127 - (t >> 2) : (t >> 2), tn = t & 3;
        const int n0 = tn * 256, m0 = tm * 256;
        f32x16 acc[4][2];
        zero_acc<4, 2>(acc);
        gemm_kloop<4, 2>(acc, wt + (long)n0 * K, K, A + (long)m0 * K, XRow{K}, K, lds);
#pragma unroll
        for (int mt = 0; mt < 2; ++mt) {
            const int m = m0 + wm * 64 + mt * 32 + l32;
            float s1 = 0.f, s2 = 0.f;
#pragma unroll
            for (int nt = 0; nt < 4; ++nt)
#pragma unroll
                for (int q = 0; q < 4; ++q) {
                    const long idx = (long)m * DM + n0 + wn * 128 + nt * 32 + 8 * q + 4 * hi;
                    const u32x2 rr = *(const u32x2*)(xb + idx);
                    const float r[4] = {bf2f(rr.x & 0xffffu), bf2f(rr.x >> 16), bf2f(rr.y & 0xffffu), bf2f(rr.y >> 16)};
#pragma unroll
                    for (int e = 0; e < 4; ++e) {
                        const float v = ALPHA * r[e] + acc[nt][mt][4 * q + e];
                        acc[nt][mt][4 * q + e] = v; s1 += v; s2 += v * v;
                    }
                }
            s1 += xhalf(s1); s2 += xhalf(s2);
            if (hi == 0) __hip_atomic_store((unsigned long long*)(stats + (long)m * 8 + tn * 2 + wn),
                                            ((unsigned long long)__float_as_uint(s2) << 32) | (unsigned long long)__float_as_uint(s1), __ATOMIC_RELAXED, __HIP_MEMORY_SCOPE_AGENT);
        }
        asm volatile("s_waitcnt vmcnt(0)" ::: "memory");
        __syncthreads();
        if (tid == 0) {
            __hip_atomic_fetch_add(cnt + tm, 1u, __ATOMIC_RELAXED, __HIP_MEMORY_SCOPE_AGENT);
            while (__hip_atomic_load(cnt + tm, __ATOMIC_RELAXED, __HIP_MEMORY_SCOPE_AGENT) < 4u) __builtin_amdgcn_s_sleep(1);
        }
        __syncthreads();
        float mu[2], rstd[2];
#pragma unroll
        for (int mt = 0; mt < 2; ++mt) {
            const int m = m0 + wm * 64 + mt * 32 + l32;
            float s1 = 0.f, s2 = 0.f;
#pragma unroll
            for (int j = 0; j < 8; ++j) {
                const unsigned long long pj = __hip_atomic_load((unsigned long long*)(stats + (long)m * 8 + j), __ATOMIC_RELAXED, __HIP_MEMORY_SCOPE_AGENT);
                s1 += __uint_as_float((unsigned)pj); s2 += __uint_as_float((unsigned)(pj >> 32));
            }
            mu[mt] = s1 * (1.0f / DM);
            const float var = fmaxf(s2 * (1.0f / DM) - mu[mt] * mu[mt], 0.f);
            rstd[mt] = rsqrtf(var + 1e-5f);
        }
#pragma unroll
        for (int nt = 0; nt < 4; ++nt) {
#pragma unroll
            for (int q = 0; q < 4; ++q) {
                const int n = n0 + wn * 128 + nt * 32 + 8 * q + 4 * hi;
                const f32x4 g4 = *(const GAS f32x4*)(const GAS float*)(gain + n), b4 = *(const GAS f32x4*)(const GAS float*)(bias + n);
#pragma unroll
                for (int mt = 0; mt < 2; ++mt) {
                    acc[nt][mt][4 * q] = (acc[nt][mt][4 * q] - mu[mt]) * rstd[mt] * g4.x + b4.x; acc[nt][mt][4 * q + 1] = (acc[nt][mt][4 * q + 1] - mu[mt]) * rstd[mt] * g4.y + b4.y;
                    acc[nt][mt][4 * q + 2] = (acc[nt][mt][4 * q + 2] - mu[mt]) * rstd[mt] * g4.z + b4.z; acc[nt][mt][4 * q + 3] = (acc[nt][mt][4 * q + 3] - mu[mt]) * rstd[mt] * g4.w + b4.w;
                }
            }
            __builtin_amdgcn_sched_barrier(0);
        }
        __builtin_amdgcn_sched_barrier(0);
        if (out) {
#pragma unroll
            for (int mt = 0; mt < 2; ++mt) {
                float* orow = out + (long)(m0 + wm * 64 + mt * 32 + l32) * DM + n0 + wn * 128 + 4 * hi;
#pragma unroll
                for (int nt = 0; nt < 4; ++nt)
#pragma unroll
                    for (int q = 0; q < 4; ++q)
                        *(f32x4*)(orow + nt * 32 + 8 * q) = (f32x4){acc[nt][mt][4 * q], acc[nt][mt][4 * q + 1], acc[nt][mt][4 * q + 2], acc[nt][mt][4 * q + 3]};
            }
        } else {
            bf16_t* wl = lds + wave * (64 * 136);
#pragma unroll
            for (int mt = 0; mt < 2; ++mt)
#pragma unroll
                for (int nt = 0; nt < 4; ++nt)
#pragma unroll
                    for (int q = 0; q < 4; ++q) {
                        u32x2 w; w.x = pk_bf16(acc[nt][mt][4 * q], acc[nt][mt][4 * q + 1]); w.y = pk_bf16(acc[nt][mt][4 * q + 2], acc[nt][mt][4 * q + 3]);
                        *(u32x2*)(wl + (mt * 32 + l32) * 136 + nt * 32 + 8 * q + 4 * hi) = w;
                    }
            wave_rows_out<4>(wl, xb + (long)(m0 + wm * 64) * DM + n0 + wn * 128, DM, lane);
        }
    }
}

DEVI void phase_ffn_up(const Params& p, int layer, bf16_t* lds) {
    unsigned char* ws = ows(p);
    const bf16_t* xb = (const bf16_t*)(ws + OFF_XB);
    const bf16_t* wt = (const bf16_t*)(ws + OFF_W + layer * W_LAYER + W_UP);
    bf16_t* H = (bf16_t*)(ws + OFF_H);
    const int lane = otid() & 63, wave = __builtin_amdgcn_readfirstlane(otid() >> 6), wn = wave & 1, wm = wave >> 1, l32 = lane & 31, hi = lane >> 5;
    for (int t = vblock(); t < 16 * 128; t += gridDim.x) {
        const int v8 = t & 255, grp = v8 >> 5, w5 = v8 & 31;
        const int tm = (t >> 8) * 16 + (grp & 3) * 4 + (w5 & 3), tn = (grp >> 2) * 8 + (w5 >> 2);
        const int n0 = tn * 256, m0 = tm * 256;
        f32x16 acc[4][2];
        zero_acc<4, 2>(acc);
        gemm_kloop<4, 2>(acc, wt + (long)n0 * DM, DM, xb + (long)m0 * DM, XRow{DM}, DM, lds);
        __syncthreads();
        bf16_t* wl = lds + wave * (64 * 136);
#pragma unroll
        for (int mt = 0; mt < 2; ++mt)
#pragma unroll
            for (int nt = 0; nt < 4; ++nt)
#pragma unroll
                for (int q = 0; q < 4; ++q) {
                    float v[4];
#pragma unroll
                    for (int e = 0; e < 4; ++e) { const float a = fmaxf(acc[nt][mt][4 * q + e], 0.f); v[e] = a * a; }
                    u32x2 w; w.x = pk_bf16(v[0], v[1]); w.y = pk_bf16(v[2], v[3]);
                    *(u32x2*)(wl + (mt * 32 + l32) * 136 + nt * 32 + 8 * q + 4 * hi) = w;
                }
        wave_rows_out<4>(wl, H + (long)(m0 + wm * 64) * FFN + n0 + wn * 128, FFN, lane);
    }
}

DEVI void phase_ln(const float* src, float* dst, bf16_t* xb, const float* gain, const float* bias) {
    const int lane = otid() & 63, wave = otid() >> 6;
    for (int row = blockIdx.x * NWAVES + wave; row < MTOK; row += gridDim.x * NWAVES) {
        const float* s = src + (long)row * DM;
        f32x4 v[4];
#pragma unroll
        for (int i = 0; i < 4; ++i) v[i] = *(const f32x4*)(s + i * 256 + lane * 4);
        float sum = 0.f;
#pragma unroll
        for (int i = 0; i < 4; ++i) sum += v[i].x + v[i].y + v[i].z + v[i].w;
#pragma unroll
        for (int o = 1; o < 64; o <<= 1) sum += __shfl_xor(sum, o);
        const float mu = sum * (1.0f / DM);
        float sq = 0.f;
#pragma unroll
        for (int i = 0; i < 4; ++i) { v[i].x -= mu; v[i].y -= mu; v[i].z -= mu; v[i].w -= mu; sq += v[i].x * v[i].x + v[i].y * v[i].y + v[i].z * v[i].z + v[i].w * v[i].w; }
#pragma unroll
        for (int o = 1; o < 64; o <<= 1) sq += __shfl_xor(sq, o);
        const float rstd = rsqrtf(sq * (1.0f / DM) + 1e-5f);
#pragma unroll
        for (int i = 0; i < 4; ++i) {
            const int c = i * 256 + lane * 4;
            const f32x4 g = *(const f32x4*)(gain + c), bb = *(const f32x4*)(bias + c);
            f32x4 y;
            y.x = v[i].x * rstd * g.x + bb.x; y.y = v[i].y * rstd * g.y + bb.y; y.z = v[i].z * rstd * g.z + bb.z; y.w = v[i].w * rstd * g.w + bb.w;
            *(f32x4*)(dst + (long)row * DM + c) = y;
            u32x2 w; w.x = pk_bf16(y.x, y.y); w.y = pk_bf16(y.z, y.w);
            *(u32x2*)(xb + (long)row * DM + c) = w;
        }
    }
}

DEVI void transpose_mat(const float* src, int K, int N, bf16_t* dst, float* tl) {
    const int tid = otid();
    const int tk = K / 64, tn = N / 64;
    for (int t = blockIdx.x; t < tk * tn; t += gridDim.x) {
        const int k0 = (t / tn) * 64, n0 = (t % tn) * 64;
        __syncthreads();
#pragma unroll
        for (int i = 0; i < 2; ++i) {
            const int e = tid + 512 * i, r = e >> 4, c4 = (e & 15) * 4;
            const f32x4 v = *(const f32x4*)(src + (long)(k0 + r) * N + n0 + c4);
            tl[r * 65 + c4] = v.x; tl[r * 65 + c4 + 1] = v.y; tl[r * 65 + c4 + 2] = v.z; tl[r * 65 + c4 + 3] = v.w;
        }
        __syncthreads();
#pragma unroll
        for (int i = 0; i < 1; ++i) {
            const int e = tid, n = e >> 3, kc = (e & 7) * 8;
            u32x4 w;
            w.x = pk_bf16(tl[(kc + 0) * 65 + n], tl[(kc + 1) * 65 + n]); w.y = pk_bf16(tl[(kc + 2) * 65 + n], tl[(kc + 3) * 65 + n]);
            w.z = pk_bf16(tl[(kc + 4) * 65 + n], tl[(kc + 5) * 65 + n]); w.w = pk_bf16(tl[(kc + 6) * 65 + n], tl[(kc + 7) * 65 + n]);
            *(u32x4*)(dst + (long)(n0 + n) * K + k0 + kc) = w;
        }
    }
}

struct Cx { float re, im; };
DEVI Cx cmul(Cx a, Cx b) { return {a.re * b.re - a.im * b.im, a.re * b.im + a.im * b.re}; }
DEVI Cx lam_pow(float are, float aim, float dt, float n) {
    const float mag = fexp2(are * dt * n * LOG2E);
    const float ph = (aim * dt) * n;
    return {mag * __cosf(ph), mag * __sinf(ph)};
}
DEVI Cx zoh_coef(float are, float aim, float dt) {
    const Cx lam = lam_pow(are, aim, dt, 1.0f);
    const float den = are * are + aim * aim, nr = lam.re - 1.0f;
    return {(nr * are + lam.im * aim) / den, (lam.im * are - nr * aim) / den};
}

DEVI void phase_prologue_a(const Params& p, bf16_t* lds) {
    unsigned char* ws = ows(p);
    float* tl = (float*)lds;
    const int tid = otid();
    const long gtid = (long)blockIdx.x * NTHREADS + tid, gsz = (long)gridDim.x * NTHREADS;
    {
        const float* x = p.in[0];
        bf16_t* xb = (bf16_t*)(ws + OFF_XB);
        for (long e = gtid; e < (long)MTOK * DM / 4; e += gsz) {
            const f32x4 v = *(const f32x4*)(x + e * 4);
            u32x2 w; w.x = pk_bf16(v.x, v.y); w.y = pk_bf16(v.z, v.w);
            *(u32x2*)(xb + e * 4) = w;
        }
    }
    for (int layer = 0; layer < 2; ++layer) {
        unsigned char* wl = ws + OFF_W + layer * W_LAYER;
        transpose_mat(p.in[1] + (long)layer * DM * INW, DM, INW, (bf16_t*)(wl + W_IN), tl);
        transpose_mat(p.in[13] + (long)layer * 512 * 512, 512, 512, (bf16_t*)(wl + W_GLU), tl);
        for (int br = 0; br < 3; ++br)
            transpose_mat(p.in[14] + ((long)layer * 3 + br) * 512 * DM, 512, DM, (bf16_t*)(wl + W_BR) + (long)br * DM * 512, tl);
        transpose_mat(p.in[15] + (long)layer * DM * DM, DM, DM, (bf16_t*)(wl + W_OUT), tl);
        transpose_mat(p.in[18] + (long)layer * DM * FFN, DM, FFN, (bf16_t*)(wl + W_UP), tl);
        transpose_mat(p.in[19] + (long)layer * FFN * DM, FFN, DM, (bf16_t*)(wl + W_DN), tl);

        unsigned char* sl = ws + OFF_S5 + layer * S5_LAYER;
        bf16_t* Bt = (bf16_t*)(sl + S5_BT);
        bf16_t* Zt = (bf16_t*)(sl + S5_ZT);
        float* KT = (float*)(sl + S5_KTAB);
        f32x2* LT = (f32x2*)(sl + S5_LAMT);
        const float* a_re = p.in[5] + layer * 2 * 32 * 64;
        const float* a_im = p.in[6] + layer * 2 * 32 * 64;
        const float* ldt = p.in[7] + layer * 2 * 32;
        const float* b_re = p.in[8] + (long)layer * 32 * 64 * 16;
        const float* b_im = p.in[9] + (long)layer * 32 * 64 * 16;
        const float* c_re = p.in[10] + (long)layer * 2 * 32 * 16 * 64;
        const float* c_im = p.in[11] + (long)layer * 2 * 32 * 16 * 64;
        for (long e = gtid; e < 2 * 32 * 64; e += gsz) {
            const int dg = (int)(e >> 6);
            const float dt = __expf(ldt[dg]);
            const Cx l = lam_pow(a_re[e], a_im[e], dt, 32.0f);
            LT[e] = (f32x2){l.re, l.im};
        }
        for (long e = gtid; e < 32 * 2 * 32 * 64; e += gsz) {
            const int pp = (int)(e & 63), jt = (int)((e >> 6) & 31), dir = (int)((e >> 11) & 1), g = (int)(e >> 12);
            const int ai = (dir * 32 + g) * 64 + pp;
            const float are = a_re[ai], aim = a_im[ai], dt = __expf(ldt[dir * 32 + g]);
            const Cx coef = zoh_coef(are, aim, dt);
            {
                const Cx w = cmul(lam_pow(are, aim, dt, (float)(dir == 0 ? 31 - jt : jt)), coef);
                bf16_t* zr = Zt + ((long)(g * 256 + dir * 128 + pp)) * 512 + jt * 16;
                bf16_t* zi = zr + 64 * 512;
#pragma unroll
                for (int h = 0; h < 16; ++h) {
                    const Cx bb = {b_re[(g * 64 + pp) * 16 + h], b_im[(g * 64 + pp) * 16 + h]};
                    const Cx wb = cmul(w, bb);
                    zr[h] = f2bf(wb.re); zi[h] = f2bf(wb.im);
                }
            }
            {
                const Cx lp = lam_pow(are, aim, dt, (float)(dir == 0 ? jt + 1 : 32 - jt));
#pragma unroll
                for (int h = 0; h < 16; ++h) {
                    const int ci = ((dir * 32 + g) * 16 + h) * 64 + pp;
                    const Cx c = cmul((Cx){c_re[ci], c_im[ci]}, lp);
                    bf16_t* bp = Bt + ((long)(g * 512 + jt * 16 + h)) * 768 + 512 + dir * 128 + pp;
                    bp[0] = f2bf(c.re); bp[64] = f2bf(-c.im);
                }
            }
        }
        for (int u = blockIdx.x; u < 2 * 32 * 32; u += gridDim.x) {
            const int tau = u & 31, g = (u >> 5) & 31, dir = u >> 10;
            __syncthreads();
            if (tid < 64) {
                const int ai = (dir * 32 + g) * 64 + tid;
                const float are = a_re[ai], aim = a_im[ai], dt = __expf(ldt[dir * 32 + g]);
                const Cx w = cmul(lam_pow(are, aim, dt, (float)tau), zoh_coef(are, aim, dt));
                tl[2 * tid] = w.re; tl[2 * tid + 1] = w.im;
            }
            __syncthreads();
            const int hp = (tid >> 4) & 15, h = tid & 15;
            float acc = 0.f;
            if (tid < 256)
            for (int pp = 0; pp < 64; ++pp) {
                const Cx w = {tl[2 * pp], tl[2 * pp + 1]};
                const Cx bb = {b_re[(g * 64 + pp) * 16 + h], b_im[(g * 64 + pp) * 16 + h]};
                const Cx wb = cmul(w, bb);
                const int ci = ((dir * 32 + g) * 16 + hp) * 64 + pp;
                acc += c_re[ci] * wb.re - c_im[ci] * wb.im;
            }
            if (tid < 256) KT[((long)((dir * 32 + g) * 32 + tau)) * 256 + tid] = acc;
        }
    }
}

DEVI void phase_prologue_b(const Params& p) {
    unsigned char* ws = ows(p);
    const long gtid = (long)blockIdx.x * NTHREADS + otid(), gsz = (long)gridDim.x * NTHREADS;
    for (int layer = 0; layer < 2; ++layer) {
        unsigned char* sl = ws + OFF_S5 + layer * S5_LAYER;
        bf16_t* Bt = (bf16_t*)(sl + S5_BT);
        const float* KT = (const float*)(sl + S5_KTAB);
        const float* dsk = p.in[12] + layer * 32 * 16;
        for (long e = gtid; e < 32L * 512 * 64; e += gsz) {
            const int kc = (int)(e & 63), n = (int)((e >> 6) & 511), g = (int)(e >> 15);
            const int j = kc >> 1, h0 = (kc & 1) * 8, t = n >> 4, hp = n & 15;
            float v[8];
            if (j < t) {
                const float* k = KT + ((long)((0 * 32 + g) * 32 + (t - j))) * 256 + hp * 16 + h0;
#pragma unroll
                for (int i = 0; i < 8; ++i) v[i] = k[i];
            } else if (j > t) {
                const float* k = KT + ((long)((1 * 32 + g) * 32 + (j - t))) * 256 + hp * 16 + h0;
#pragma unroll
                for (int i = 0; i < 8; ++i) v[i] = k[i];
            } else {
                const float* kf = KT + ((long)((0 * 32 + g) * 32)) * 256 + hp * 16 + h0;
                const float* kb = KT + ((long)((1 * 32 + g) * 32)) * 256 + hp * 16 + h0;
#pragma unroll
                for (int i = 0; i < 8; ++i) v[i] = kf[i] + kb[i] + ((h0 + i == hp) ? dsk[g * 16 + hp] : 0.f);
            }
            u32x4 w; w.x = pk_bf16(v[0], v[1]); w.y = pk_bf16(v[2], v[3]); w.z = pk_bf16(v[4], v[5]); w.w = pk_bf16(v[6], v[7]);
            *(u32x4*)(Bt + ((long)(g * 512 + n)) * 768 + kc * 8) = w;
        }
    }
}


#define XB_TMO      128
#define XB_XCNT(j)  (256  + 64 * (j))
#define XB_XSUB(j)  (1280 + 64 * (j))
#define XB_XGEN(j)  (2304 + 64 * (j))
#define XB_TOP      3328
#define XB_TOPGEN   3392
#define XCD_BAR_WORDS 3456
#define XB_SPIN_CAP (1u << 18)

__device__ __forceinline__ unsigned xb_ld(unsigned* p)              { return __hip_atomic_load(p, __ATOMIC_RELAXED, __HIP_MEMORY_SCOPE_AGENT); }
__device__ __forceinline__ unsigned xb_add(unsigned* p, unsigned v) { return __hip_atomic_fetch_add(p, v, __ATOMIC_RELAXED, __HIP_MEMORY_SCOPE_AGENT); }
__device__ __forceinline__ unsigned xb_xcc_id() { return (unsigned)__builtin_amdgcn_s_getreg((3 << 11) | 20) & 0xFu; }
#define XB_SPIN(cond, bar) do { unsigned _sp = 0; while (cond) { __builtin_amdgcn_s_sleep(1); \
    if ((++_sp & 255u) == 0u) { if (xb_ld(&(bar)[XB_TMO])) break; if (_sp > XB_SPIN_CAP) { atomicAdd(&(bar)[XB_TMO], 1u); break; } } } } while (0)

struct XcdBarrier {
    unsigned* bar; unsigned x;
    volatile LAS unsigned* st;
};

__device__ __forceinline__ XcdBarrier xcd_barrier_post(unsigned* bar, volatile LAS unsigned* st) {
    XcdBarrier b; b.bar = bar; b.x = xb_xcc_id(); b.st = st;
    if (threadIdx.x == 0) (void)xb_add(&bar[XB_XCNT(b.x)], 1u);
    return b;
}
__device__ __forceinline__ void xcd_barrier_complete(unsigned* bar, unsigned x, unsigned& nloc, unsigned& nx) {
    const unsigned G = gridDim.x * gridDim.y * gridDim.z;
    unsigned sum, cnt, mine, sp = 0u;
    for (;;) {
        sum = 0u; cnt = 0u; mine = 0u;
#pragma unroll
        for (unsigned j = 0; j < 16; ++j) { const unsigned c = xb_ld(&bar[XB_XCNT(j)]); sum += c; cnt += (c > 0u) ? 1u : 0u; mine = (j == x) ? c : mine; }
        if (sum == G) break;
        __builtin_amdgcn_s_sleep(1);
        if ((++sp & 255u) == 0u) { if (xb_ld(&bar[XB_TMO])) break; if (sp > XB_SPIN_CAP) { atomicAdd(&bar[XB_TMO], 1u); break; } }
    }
    nloc = mine > 0u ? mine : 1u; nx = cnt > 0u ? cnt : 1u;
}

__device__ __forceinline__ void xcd_barrier(const XcdBarrier& b) {
    asm volatile("s_waitcnt vmcnt(0)" ::: "memory");
    __syncthreads();
    if (threadIdx.x == 0) {
        unsigned* bar = b.bar;
        __builtin_amdgcn_s_waitcnt(0);
        unsigned nloc = b.st[0], nx = b.st[1];
        if (nloc == 0u) { xcd_barrier_complete(bar, b.x, nloc, nx); b.st[0] = nloc; b.st[1] = nx; }
        const unsigned old = xb_add(&bar[XB_XSUB(b.x)], 1u);
        const unsigned gen = old / nloc;
        if (old + 1u == (gen + 1u) * nloc) {
            __builtin_amdgcn_fence(__ATOMIC_RELEASE, "agent");
            asm volatile("s_waitcnt vmcnt(0)" ::: "memory");
            const unsigned og = xb_add(&bar[XB_TOP], 1u);
            const unsigned tg = og / nx;
            if (og + 1u == (tg + 1u) * nx) xb_add(&bar[XB_TOPGEN], 1u);
            else XB_SPIN(xb_ld(&bar[XB_TOPGEN]) == tg, bar);
            __builtin_amdgcn_fence(__ATOMIC_ACQUIRE, "agent");
            xb_add(&bar[XB_XGEN(b.x)], 1u);
            asm volatile("s_waitcnt vmcnt(0)" ::: "memory");
        } else {
            XB_SPIN(xb_ld(&bar[XB_XGEN(b.x)]) == gen, bar);
            __builtin_amdgcn_fence(__ATOMIC_ACQUIRE, "agent");
            asm volatile("s_waitcnt vmcnt(0)" ::: "memory");
        }
    }
    __syncthreads();
}


DEVI void grid_barrier(unsigned* ctr, unsigned target) {
    asm volatile("s_waitcnt vmcnt(0) lgkmcnt(0)" ::: "memory");
    __syncthreads();
    if (threadIdx.x == 0) {
        __builtin_amdgcn_fence(__ATOMIC_RELEASE, "agent");
        asm volatile("s_waitcnt vmcnt(0)" ::: "memory");
        __hip_atomic_fetch_add(ctr, 1u, __ATOMIC_RELAXED, __HIP_MEMORY_SCOPE_AGENT);
        while (__hip_atomic_load(ctr, __ATOMIC_RELAXED, __HIP_MEMORY_SCOPE_AGENT) < target) __builtin_amdgcn_s_sleep(2);
        __builtin_amdgcn_fence(__ATOMIC_ACQUIRE, "agent");
        asm volatile("s_waitcnt vmcnt(0)" ::: "memory");
    }
    __syncthreads();
}

constexpr int PH_PER_LAYER = 6;
constexpr int N_PHASES = 2 + PH_PER_LAYER * 2;
__global__ void __launch_bounds__(NTHREADS, 2) fwd_kernel(Params p) {
    extern __shared__ __attribute__((aligned(16))) unsigned char lds_raw[];
    bf16_t* lds = (bf16_t*)lds_raw;
    unsigned char* ws = ows(p);
    volatile LAS unsigned* xst = (volatile LAS unsigned*)(LAS unsigned char*)(lds_raw + LDS_BYTES - 32);
    if (threadIdx.x == 0) { xst[0] = 0u; xst[1] = 0u; }
    __syncthreads();
    const XcdBarrier xbar = xcd_barrier_post((unsigned*)(ws + OFF_CTL + 16384), xst);
    for (int ph = p.ph_lo; ph < p.ph_hi; ++ph) {
        if (ph == 0) phase_prologue_a(p, lds);
        else if (ph == 1) phase_prologue_b(p);
        else {
            const int layer = (ph - 2) / PH_PER_LAYER, sub = (ph - 2) % PH_PER_LAYER;
            switch (sub) {
            case 0: phase_inproj(p, layer, lds); break;
            case 1: phase_mixers(p, layer, lds); break;
            case 2: phase_merge(p, layer, lds); break;
            case 3: phase_res_gemm_ln((const bf16_t*)(ws + OFF_MERGED), DM, (const bf16_t*)(ws + OFF_W + layer * W_LAYER + W_OUT), nullptr, (bf16_t*)(ws + OFF_XB),
                                      p.in[16] + layer * DM, p.in[17] + layer * DM, (f32x2*)(ws + OFF_STATS), (unsigned*)(ws + OFF_CTL) + 1024 + (layer * 2) * 128, lds); break;
            case 4: phase_ffn_up(p, layer, lds); break;
            default: phase_res_gemm_ln((const bf16_t*)(ws + OFF_H), FFN, (const bf16_t*)(ws + OFF_W + layer * W_LAYER + W_DN), layer == 1 ? p.out : nullptr, (bf16_t*)(ws + OFF_XB),
                                      p.in[20] + layer * DM, p.in[21] + layer * DM, (f32x2*)(ws + OFF_STATS), (unsigned*)(ws + OFF_CTL) + 1024 + (layer * 2 + 1) * 128, lds, true); break;
            }
        }
        if (ph + 1 < p.ph_hi) {
            if (p.ph_lo < 0) cg::this_grid().sync();
            xcd_barrier(xbar);
        }
    }
}

extern "C" void kernel_launch(void* const* d_in, const int* in_sizes, int n_in, void* d_out, int out_size, void* d_ws, size_t ws_size, hipStream_t stream) {
    static int grid = 0;
    if (grid == 0) {
        if (n_in != 22 || ws_size < WS_END) { fprintf(stderr, "kernel_launch: unexpected n_in %d / ws_size %zu\n", n_in, ws_size); grid = -1; return; }
        int dev = 0, cus = 0, per_cu = 0;
        hipGetDevice(&dev);
        hipDeviceGetAttribute(&cus, hipDeviceAttributeMultiprocessorCount, dev);
        hipFuncSetAttribute((const void*)fwd_kernel, hipFuncAttributeMaxDynamicSharedMemorySize, LDS_BYTES);
        hipOccupancyMaxActiveBlocksPerMultiprocessor(&per_cu, (const void*)fwd_kernel, NTHREADS, LDS_BYTES);
        if (per_cu < 1) per_cu = 1;
        if (per_cu > 1) per_cu = 1;
        grid = cus * per_cu;
        fprintf(stderr, "kernel_launch: grid %d (%d CUs x %d)\n", grid, cus, per_cu);
    }
    if (grid < 0) return;
    Params p{};
    for (int i = 0; i < 22; ++i) p.in[i] = (const float*)d_in[i];
    p.out = (float*)d_out; p.ws = (unsigned char*)d_ws;
#if SINGLE_LAUNCH
    hipMemsetAsync((unsigned char*)d_ws + OFF_CTL, 0, 32768, stream);
    p.ph_lo = 0; p.ph_hi = N_PHASES;
    void* args[] = {&p};
    hipError_t e = hipLaunchCooperativeKernel((const void*)fwd_kernel, dim3(grid), dim3(NTHREADS), args, LDS_BYTES, stream);
    if (e != hipSuccess) fprintf(stderr, "cooperative launch failed: %s (grid %d)\n", hipGetErrorString(e), grid);
#else
    for (int ph = 0; ph < N_PHASES; ++ph) {
        p.ph_lo = ph; p.ph_hi = ph + 1;
        hipLaunchKernelGGL(fwd_kernel, dim3(grid), dim3(NTHREADS), LDS_BYTES, stream, p);
    }
#endif
}
```

```cpp
#include <hip/hip_runtime.h>
#include <hip/hip_cooperative_groups.h>
#include <cstdio>
namespace cg = cooperative_groups;

#ifndef SINGLE_LAUNCH
#define SINGLE_LAUNCH 1
#endif

typedef unsigned short bf16_t;
typedef short bf16x8 __attribute__((ext_vector_type(8)));
typedef float f32x16 __attribute__((ext_vector_type(16)));
typedef float f32x4 __attribute__((ext_vector_type(4)));
typedef float f32x2 __attribute__((ext_vector_type(2)));
typedef unsigned u32x4 __attribute__((ext_vector_type(4)));
typedef unsigned u32x2 __attribute__((ext_vector_type(2)));
#define DEVI __device__ __forceinline__

constexpr int DM = 1024, SEQ = 8192, NB = 4, MTOK = NB * SEQ, FFN = 4096, INW = 5888;
constexpr int PW = 2816;
constexpr int CQ = 0, CK = 512, CNQ = 768, CNK = 1280, CSU = 2304;
constexpr float ALPHA = 1.4142135623730951f;
constexpr float LOG2E = 1.4426950408889634f;
constexpr int NTHREADS = 512, NWAVES = 8;
constexpr int LSTR = 72;
constexpr int LDS_BYTES = 2 * (256 + 256) * LSTR * 2;

constexpr size_t MiB = 1u << 20;
constexpr size_t OFF_P = 0, OFF_H = 0, OFF_ZB = 176 * MiB, OFF_MERGED = 176 * MiB, OFF_NVT = 208 * MiB, OFF_VT = 240 * MiB;
constexpr size_t OFF_ZS = 256 * MiB, OFF_SPREV = 288 * MiB;
constexpr size_t OFF_W = 304 * MiB, W_LAYER = 34 * MiB;
constexpr size_t W_IN = 0, W_GLU = 12 * MiB, W_BR = 13 * MiB, W_OUT = 16 * MiB, W_UP = 18 * MiB, W_DN = 26 * MiB;
constexpr size_t OFF_S5 = 372 * MiB, S5_LAYER = 35 * MiB;
constexpr size_t S5_BT = 0, S5_ZT = 24 * MiB, S5_KTAB = 32 * MiB, S5_LAMT = 34 * MiB;
constexpr size_t OFF_XB = 442 * MiB;
constexpr size_t OFF_CTL = 506 * MiB;
constexpr size_t OFF_STATS = 507 * MiB;
constexpr size_t WS_END = 509 * MiB;

struct Params {
    const float* in[22];
    float* out;
    unsigned char* ws;
    int ph_lo, ph_hi;
};

DEVI unsigned char* ows(const Params& p) { unsigned char* w = p.ws; asm volatile("" : "+s"(w)); return w; }
#define GAS __attribute__((address_space(1)))
DEVI u32x4 gld16(const void* p) { return *(const GAS u32x4*)(const GAS char*)p; }
DEVI bf16x8 gld16b(const void* p) { return *(const GAS bf16x8*)(const GAS char*)p; }
DEVI void gst8(void* base, unsigned off, u32x2 v) { *(GAS u32x2*)((GAS char*)base + off) = v; }
DEVI void gst2(void* base, unsigned off, bf16_t v) { *(GAS bf16_t*)((GAS char*)base + off) = v; }
DEVI int otid() { int t = threadIdx.x; asm volatile("" : "+v"(t)); return t; }
typedef __bf16 bf16x2_t __attribute__((ext_vector_type(2)));
DEVI unsigned pk_bf16_m(float lo, float hi) { const f32x2 v = {lo, hi}; const bf16x2_t b = __builtin_convertvector(v, bf16x2_t); return __builtin_bit_cast(unsigned, b); }
DEVI unsigned pk_bf16(float lo, float hi) { unsigned r; asm("v_cvt_pk_bf16_f32 %0, %1, %2" : "=v"(r) : "v"(lo), "v"(hi)); return r; }
DEVI bf16_t f2bf(float f) { return (bf16_t)(pk_bf16(f, 0.f) & 0xffffu); }
DEVI float bf2f(unsigned v) { return __uint_as_float(v << 16); }
DEVI float fexp2(float x) { return __builtin_amdgcn_exp2f(x); }
DEVI float sigmoidf_(float x) { return 1.0f / (1.0f + fexp2(-x * LOG2E)); }
DEVI float gelu_tanh(float y) {
    const float u = 0.7978845608028654f * (y + 0.044715f * y * y * y);
    return y * sigmoidf_(2.0f * u);
}
DEVI f32x16 mfma32(bf16x8 a, bf16x8 b, f32x16 c) { return __builtin_amdgcn_mfma_f32_32x32x16_bf16(a, b, c, 0, 0, 0); }
DEVI float xhalf(float v) { return __shfl_xor(v, 32); }

#define LAS __attribute__((address_space(3)))
#define SB() __builtin_amdgcn_sched_barrier(0)
template <int NT, int MT, class XF>
DEVI void gemm_kloop(f32x16 (&acc)[NT][MT], const bf16_t* wbase, int ldw, const bf16_t* xbase, const XF& xf, int K, bf16_t* lds) {
    const int tid = otid(), lane = tid & 63;
    const int wave = __builtin_amdgcn_readfirstlane(tid >> 6);
    const int wn = wave & 1, wm = wave >> 1, l32 = lane & 31, hi = lane >> 5;
    constexpr int WR = 64 * NT, XR = 128 * MT, WI = WR / 64, XI = XR / 64, STAGE = (WR + XR) * 64, NP = WI + XI;
    const int nk = K >> 6;
    const int lrow = wave * 8 + (lane >> 3);
    const int lc = ((lane & 7) ^ ((lrow >> 1) & 7)) * 8;
    const unsigned woff0 = ((unsigned)lrow * (unsigned)ldw + (unsigned)lc) * 2u;
    const unsigned wstep = 64u * (unsigned)ldw * 2u;
    unsigned xoff[XI];
#pragma unroll
    for (int j = 0; j < XI; ++j) xoff[j] = xf.off((unsigned)(lrow + 64 * j), (unsigned)lc) * 2u;
    const GAS char* wp = (const GAS char*)wbase;
    const GAS char* xp = (const GAS char*)xbase;
    const unsigned xstep = (unsigned)xf.kstep() * 2u;
    LAS bf16_t* L = (LAS bf16_t*)lds;
    const int sw = (l32 >> 1) & 7;
    int koff[4];
#pragma unroll
    for (int kk = 0; kk < 4; ++kk) koff[kk] = ((kk * 2 + hi) ^ sw) * 8;
#define GEMM_PIECE(bufi, pi) do { \
        LAS bf16_t* _d = L + (bufi) * STAGE + wave * 8 * 64; \
        if ((pi) < WI) __builtin_amdgcn_global_load_lds((const GAS unsigned*)(wp + woff0 + (pi) * wstep), (LAS unsigned*)(_d + (pi) * 64 * 64), 16, 0, 0); \
        else if ((pi) < NP) __builtin_amdgcn_global_load_lds((const GAS unsigned*)(xp + xoff[((pi) - WI) < XI ? ((pi) - WI) : 0]), (LAS unsigned*)(_d + (WR + ((pi) - WI) * 64) * 64), 16, 0, 0); \
    } while (0)
#define GEMM_RFR(set, kk) do { \
        _Pragma("unroll") for (int mt = 0; mt < MT; ++mt) fb[set][mt] = *(const LAS bf16x8*)(xsb + mt * 32 * 64 + koff[kk]); \
        _Pragma("unroll") for (int nt = 0; nt < NT; ++nt) fa[set][nt] = *(const LAS bf16x8*)(wsb + nt * 32 * 64 + koff[kk]); \
    } while (0)
#define GEMM_MMA(set, nlo, nhi) do { \
        __builtin_amdgcn_s_setprio(1); \
        _Pragma("unroll") for (int nt = (nlo); nt < (nhi); ++nt) \
        _Pragma("unroll") for (int mt = 0; mt < MT; ++mt) acc[nt][mt] = mfma32(fa[set][nt], fb[set][mt], acc[nt][mt]); \
        __builtin_amdgcn_s_setprio(0); \
    } while (0)
    asm volatile("s_waitcnt vmcnt(0)" ::: "memory");
    __builtin_amdgcn_s_barrier();
#pragma unroll
    for (int pi = 0; pi < NP; ++pi) GEMM_PIECE(0, pi);
#pragma unroll 1
    for (int kt = 0; kt < nk; ++kt) {
        const int buf = kt & 1;
        const bool more = (kt + 1 < nk);
        asm volatile("s_waitcnt vmcnt(0) lgkmcnt(0)" ::: "memory");
        __builtin_amdgcn_s_barrier();
        const LAS bf16_t* wsb = L + buf * STAGE + (wn * 32 * NT + l32) * 64;
        const LAS bf16_t* xsb = L + buf * STAGE + (WR + wm * 32 * MT + l32) * 64;
        bf16x8 fa[2][NT], fb[2][MT];
        GEMM_RFR(0, 0);
        SB();
        if (more) { wp += 128; xp += xstep; }
#pragma unroll
        for (int kk = 0; kk < 4; ++kk) {
            if (kk < 3) { GEMM_RFR((kk + 1) & 1, kk + 1); }
            SB();
            if (more && kk < 2) { GEMM_PIECE(buf ^ 1, 4 * kk); GEMM_PIECE(buf ^ 1, 4 * kk + 1); }
            SB();
            GEMM_MMA(kk & 1, 0, NT / 2);
            SB();
            if (more && kk < 2) { GEMM_PIECE(buf ^ 1, 4 * kk + 2); GEMM_PIECE(buf ^ 1, 4 * kk + 3); }
            SB();
            GEMM_MMA(kk & 1, NT / 2, NT);
            SB();
        }
    }
#undef GEMM_PIECE
#undef GEMM_RFR
#undef GEMM_MMA
}

template <int NT, int MT> DEVI void zero_acc(f32x16 (&acc)[NT][MT]) {
#pragma unroll
    for (int nt = 0; nt < NT; ++nt)
#pragma unroll
        for (int mt = 0; mt < MT; ++mt)
#pragma unroll
            for (int i = 0; i < 16; ++i) acc[nt][mt][i] = 0.f;
}
DEVI int vblock() { const int G = gridDim.x, b = blockIdx.x; return (G % 8 == 0) ? (b % 8) * (G / 8) + b / 8 : b; }

struct XRow {
    int ld;
    DEVI unsigned off(unsigned r, unsigned kc) const { return r * (unsigned)ld + kc; }
    DEVI int kstep() const { return 64; }
};
struct XS5 {
    DEVI unsigned off(unsigned r, unsigned kc) const { return (r * 32u + (kc >> 4)) * (unsigned)PW + (kc & 15u); }
    DEVI int kstep() const { return 4 * PW; }
};


template <int NT, int ROWS = 64> DEVI void wave_rows_out(const bf16_t* wl, bf16_t* gbase, long ld, int lane) {
    constexpr int RS = NT * 32 + 8, CPR = NT * 4, RPI = 64 / CPR;
    asm volatile("s_waitcnt lgkmcnt(0)" ::: "memory");
    const bf16_t* lp = wl + (lane / CPR) * RS + (lane % CPR) * 8;
    const unsigned loff = ((unsigned)(lane / CPR) * (unsigned)ld + (unsigned)(lane % CPR) * 8u) * 2u;
    GAS char* gp = (GAS char*)gbase;
    const unsigned gstep = (unsigned)RPI * (unsigned)ld * 2u;
#pragma unroll 4
    for (int j = 0; j < NT * 4 * ROWS / 64; ++j) {
        const u32x4 v = *(const u32x4*)(lp);
        __builtin_nontemporal_store(v, (GAS u32x4*)(gp + loff));
        gp += gstep; lp += RPI * RS;
    }
}

template <int MT>
DEVI void inproj_tile(int n0, int m0, const bf16_t* wt, const bf16_t* xb, bf16_t* P, bf16_t* VT, bf16_t* NVT, const float* qg, const float* kg,
                      int tid0, int wave, int wn, int wm, bf16_t* lds) {
        f32x16 acc[4][MT];
        zero_acc<4, MT>(acc);
        gemm_kloop<4, MT>(acc, wt + (long)n0 * DM, DM, xb + (long)m0 * DM, XRow{DM}, DM, lds);
        __syncthreads();
        bf16_t* wl = lds + wave * (64 * 136);
        int lane = tid0 & 63; asm volatile("" : "+v"(lane));
        const int l32 = lane & 31, hi = lane >> 5;
        const int nbw = n0 + wn * 128;
        const int mw = m0 + wm * 32 * MT;
        bf16_t* pbase = P + (long)mw * PW + nbw;
        if (nbw < 640) {
            const float* gain = (nbw < 512) ? qg : kg;
#pragma unroll
            for (int hp = 0; hp < 2; ++hp)
#pragma unroll
            for (int mt = 0; mt < MT; ++mt) {
                const int tpos = (mw + mt * 32 + l32) & (SEQ - 1);
                float ss = 0.f;
#pragma unroll
                for (int nt = 0; nt < 2; ++nt)
#pragma unroll
                    for (int i = 0; i < 16; ++i) ss += acc[2 * hp + nt][mt][i] * acc[2 * hp + nt][mt][i];
                ss += xhalf(ss);
                const float rs = rsqrtf(ss * (1.0f / 64.0f) + 1e-6f) * ((nbw < 512) ? 0.125f * LOG2E : 1.0f);
#pragma unroll
                for (int nt = 0; nt < 2; ++nt) {
                    const float pos = (float)(nt == 0 ? (tpos >> 6) : (tpos & 63));
                    float v[16];
#pragma unroll
                    for (int q = 0; q < 4; ++q) {
                        const f32x4 g4 = *(const GAS f32x4*)(const GAS float*)(gain + nt * 32 + 8 * q + 4 * hi);
                        v[4 * q] = acc[2 * hp + nt][mt][4 * q] * rs * g4.x; v[4 * q + 1] = acc[2 * hp + nt][mt][4 * q + 1] * rs * g4.y;
                        v[4 * q + 2] = acc[2 * hp + nt][mt][4 * q + 2] * rs * g4.z; v[4 * q + 3] = acc[2 * hp + nt][mt][4 * q + 3] * rs * g4.w;
                    }
#pragma unroll
                    for (int i = 0; i < 8; ++i) {
                        const int j = 8 * (i >> 2) + 4 * hi + (i & 3);
                        const float inv = fexp2(-(float)j * 0.8304820237218406f);
                        const float ang = pos * inv;
                        const float c = __cosf(ang), sn = __sinf(ang);
                        const float x1 = v[i], x2 = v[i + 8];
                        v[i] = x1 * c - x2 * sn;
                        v[i + 8] = x2 * c + x1 * sn;
                    }
#pragma unroll
                    for (int q = 0; q < 4; ++q) {
                        u32x2 w; w.x = pk_bf16(v[4 * q], v[4 * q + 1]); w.y = pk_bf16(v[4 * q + 2], v[4 * q + 3]);
                        *(u32x2*)(wl + (mt * 32 + l32) * 136 + hp * 64 + nt * 32 + 8 * q + 4 * hi) = w;
                    }
                    __builtin_amdgcn_sched_barrier(0);
                }
            }
            wave_rows_out<4, 32 * MT>(wl, pbase, PW, lane);
        } else if (nbw == 640 || (nbw >= 1792 && nbw < 2304)) {
            const int b = mw >> 13, tpos0 = mw & (SEQ - 1);
            bf16_t* base = (nbw == 640) ? VT + ((long)(b * 2) * 64) * SEQ + tpos0 : NVT + ((long)(b * 8 + ((nbw - 1792) >> 6)) * 64) * SEQ + tpos0;
            const unsigned voff = (unsigned)(4 * hi * SEQ + l32) * 2u;
#pragma unroll
            for (int mt = 0; mt < MT; ++mt)
#pragma unroll
                for (int nt = 0; nt < 4; ++nt)
#pragma unroll
                    for (int i = 0; i < 16; ++i)
                        gst2(base, voff + (unsigned)(((nt * 32 + 8 * (i >> 2) + (i & 3)) * SEQ + mt * 32) * 2), f2bf(acc[nt][mt][i]));
        } else {
#pragma unroll
            for (int mt = 0; mt < MT; ++mt)
#pragma unroll
                for (int nt = 0; nt < 4; ++nt)
#pragma unroll
                    for (int q = 0; q < 4; ++q) {
                        u32x2 w; w.x = pk_bf16(acc[nt][mt][4 * q], acc[nt][mt][4 * q + 1]); w.y = pk_bf16(acc[nt][mt][4 * q + 2], acc[nt][mt][4 * q + 3]);
                        *(u32x2*)(wl + (mt * 32 + l32) * 136 + nt * 32 + 8 * q + 4 * hi) = w;
                    }
            wave_rows_out<4, 32 * MT>(wl, pbase, PW, lane);
        }
}

DEVI void phase_inproj(const Params& p, int layer, bf16_t* lds) {
    unsigned char* ws = ows(p);
    const bf16_t* xb = (const bf16_t*)(ws + OFF_XB);
    const bf16_t* wt = (const bf16_t*)(ws + OFF_W + layer * W_LAYER + W_IN);
    bf16_t* P = (bf16_t*)(ws + OFF_P);
    bf16_t* VT = (bf16_t*)(ws + OFF_VT);
    bf16_t* NVT = (bf16_t*)(ws + OFF_NVT);
    const float* qg = p.in[2] + layer * 64;
    const float* kg = p.in[3] + layer * 64;
    const int tid0 = otid();
    const int wave = __builtin_amdgcn_readfirstlane(tid0 >> 6), wn = wave & 1, wm = wave >> 1;
    constexpr int NT_N = PW / 256, NT_M = MTOK / 256;
    for (int t = vblock(); t < 5 * 256; t += gridDim.x)
        inproj_tile<2>((t % NT_N) * 256, (t / NT_N) * 256, wt, xb, P, VT, NVT, qg, kg, tid0, wave, wn, wm, lds);
    if (gridDim.x == 256) {
        const int t = 5 * 256 + (vblock() >> 1);
        inproj_tile<1>((t % NT_N) * 256, (t / NT_N) * 256 + (vblock() & 1) * 128, wt, xb, P, VT, NVT, qg, kg, tid0, wave, wn, wm, lds);
    } else {
        for (int t = 5 * 256 + vblock(); t < NT_N * NT_M; t += gridDim.x)
            inproj_tile<2>((t % NT_N) * 256, (t / NT_N) * 256, wt, xb, P, VT, NVT, qg, kg, tid0, wave, wn, wm, lds);
    }
}

DEVI void online_softmax(f32x16 (&s)[2], f32x16 (&o)[2], float& mrun, float& lrun, bf16x8 (&pb)[2][2]) {
    float mx = s[0][0];
#pragma unroll
    for (int kt = 0; kt < 2; ++kt)
#pragma unroll
        for (int i = 0; i < 16; ++i) mx = fmaxf(mx, s[kt][i]);
    mx = fmaxf(mx, xhalf(mx));
    const float mnew = fmaxf(mrun, mx);
    const float alpha = fexp2(mrun - mnew);
    mrun = mnew;
    float ps = 0.f;
#pragma unroll
    for (int kt = 0; kt < 2; ++kt)
#pragma unroll
        for (int i = 0; i < 16; ++i) { const float e = fexp2(s[kt][i] - mnew); s[kt][i] = e; ps += e; }
    lrun = lrun * alpha + ps;
#pragma unroll
    for (int dt = 0; dt < 2; ++dt)
#pragma unroll
        for (int i = 0; i < 16; ++i) o[dt][i] *= alpha;
#pragma unroll
    for (int kt = 0; kt < 2; ++kt)
#pragma unroll
        for (int sl = 0; sl < 2; ++sl) {
            u32x4 w;
            w.x = pk_bf16_m(s[kt][8 * sl + 0], s[kt][8 * sl + 1]); w.y = pk_bf16_m(s[kt][8 * sl + 2], s[kt][8 * sl + 3]);
            w.z = pk_bf16_m(s[kt][8 * sl + 4], s[kt][8 * sl + 5]); w.w = pk_bf16_m(s[kt][8 * sl + 6], s[kt][8 * sl + 7]);
            pb[kt][sl] = __builtin_bit_cast(bf16x8, w);
        }
}
DEVI int kperm(int r) { return (r & 16) + 8 * ((r >> 2) & 1) + 4 * ((r >> 3) & 1) + (r & 3); }

DEVI void gqa_unit(const Params& p, int layer, int unit, bf16_t* lds) {
    unsigned char* ws = ows(p);
    bf16_t* P = (bf16_t*)(ws + OFF_P);
    const bf16_t* VT = (const bf16_t*)(ws + OFF_VT);
    const int tid = otid(), lane = tid & 63, wave = tid >> 6, l32 = lane & 31, hi = lane >> 5;
    const int qb = unit & 31, h = (unit >> 5) & 7, b = unit >> 8, kvh = h >> 2;
    const int qrow = qb * 256 + wave * 32 + l32;
    bf16_t* Ks = lds;
    bf16_t* Vs = lds + 2 * 64 * LSTR;
    bf16x8 qf[4];
    {
        const bf16_t* qp = P + ((long)(b * SEQ + qrow)) * PW + CQ + h * 64 + hi * 8;
#pragma unroll
        for (int kk = 0; kk < 4; ++kk) qf[kk] = *(const bf16x8*)(qp + kk * 16);
    }
    float mb;
    {
        float gq = fabsf(p.in[2][layer * 64 + lane]), gk = fabsf(p.in[3][layer * 64 + lane]);
#pragma unroll
        for (int o2 = 1; o2 < 64; o2 <<= 1) { gq = fmaxf(gq, __shfl_xor(gq, o2)); gk = fmaxf(gk, __shfl_xor(gk, o2)); }
        mb = 8.0f * gq * gk * LOG2E * 1.01f;
    }
    const bf16_t* kbase = P + ((long)b * SEQ) * PW + CK + kvh * 64;
    const bf16_t* vbase = VT + ((long)(b * 2 + kvh) * 64) * SEQ;
    f32x16 o[2];
#pragma unroll
    for (int dt = 0; dt < 2; ++dt)
#pragma unroll
        for (int i = 0; i < 16; ++i) o[dt][i] = 0.f;
    float lrun = 0.f;
    u32x4 kreg[1], vreg[1];
#pragma unroll
    for (int i = 0; i < 1; ++i) {
        const int c = tid, r = c >> 3, cc = (c & 7) * 8;
        kreg[i] = gld16(kbase + (long)r * PW + cc);
        vreg[i] = gld16(vbase + (long)r * SEQ + cc);
    }
#pragma unroll
    for (int i = 0; i < 1; ++i) {
        const int c = tid, r = c >> 3, cc = (c & 7) * 8;
        *(u32x4*)(Ks + r * LSTR + cc) = kreg[i];
        *(u32x4*)(Vs + r * LSTR + cc) = vreg[i];
    }
    __syncthreads();
    const int kr = kperm(l32);
    for (int kt0 = 0; kt0 < SEQ / 64; ++kt0) {
        const int buf = kt0 & 1;
        const bool more = (kt0 + 1 < SEQ / 64);
        if (more) {
            const int key0 = (kt0 + 1) * 64;
#pragma unroll
            for (int i = 0; i < 1; ++i) {
                const int c = tid, r = c >> 3, cc = (c & 7) * 8;
                kreg[i] = gld16(kbase + (long)(key0 + r) * PW + cc);
                vreg[i] = gld16(vbase + (long)r * SEQ + key0 + cc);
            }
        }
        f32x16 s[2];
        bf16x8 kf[2][4], vf[2][2][2];
#pragma unroll
        for (int kt = 0; kt < 2; ++kt) {
            const bf16_t* kp = Ks + (buf * 64 + kt * 32 + kr) * LSTR + hi * 8;
#pragma unroll
            for (int kk = 0; kk < 4; ++kk) kf[kt][kk] = *(const bf16x8*)(kp + kk * 16);
        }
#pragma unroll
        for (int dt = 0; dt < 2; ++dt) {
            const bf16_t* vp = Vs + (buf * 64 + dt * 32 + l32) * LSTR + hi * 8;
#pragma unroll
            for (int kt = 0; kt < 2; ++kt)
#pragma unroll
                for (int sl = 0; sl < 2; ++sl) vf[dt][kt][sl] = *(const bf16x8*)(vp + kt * 32 + sl * 16);
        }
        __builtin_amdgcn_sched_barrier(0);
        __builtin_amdgcn_s_setprio(1);
#pragma unroll
        for (int kt = 0; kt < 2; ++kt) {
#pragma unroll
            for (int i = 0; i < 16; ++i) s[kt][i] = -mb;
#pragma unroll
            for (int kk = 0; kk < 4; ++kk) s[kt] = mfma32(kf[kt][kk], qf[kk], s[kt]);
        }
        __builtin_amdgcn_s_setprio(0);
        bf16x8 pb[2][2];
#pragma unroll
        for (int kt = 0; kt < 2; ++kt) {
#pragma unroll
            for (int i = 0; i < 16; ++i) { const float e = fexp2(s[kt][i]); s[kt][i] = e; lrun += e; }
#pragma unroll
            for (int sl = 0; sl < 2; ++sl) {
                u32x4 w;
                w.x = pk_bf16_m(s[kt][8 * sl + 0], s[kt][8 * sl + 1]); w.y = pk_bf16_m(s[kt][8 * sl + 2], s[kt][8 * sl + 3]);
                w.z = pk_bf16_m(s[kt][8 * sl + 4], s[kt][8 * sl + 5]); w.w = pk_bf16_m(s[kt][8 * sl + 6], s[kt][8 * sl + 7]);
                pb[kt][sl] = __builtin_bit_cast(bf16x8, w);
            }
        }
#pragma unroll
        for (int dt = 0; dt < 2; ++dt)
#pragma unroll
            for (int kt = 0; kt < 2; ++kt)
#pragma unroll
                for (int sl = 0; sl < 2; ++sl) o[dt] = mfma32(vf[dt][kt][sl], pb[kt][sl], o[dt]);
        if (more) {
            const int nb = buf ^ 1;
#pragma unroll
            for (int i = 0; i < 1; ++i) {
                const int c = tid, r = c >> 3, cc = (c & 7) * 8;
                *(u32x4*)(Ks + (nb * 64 + r) * LSTR + cc) = kreg[i];
                *(u32x4*)(Vs + (nb * 64 + r) * LSTR + cc) = vreg[i];
            }
        }
        __syncthreads();
    }
    lrun += xhalf(lrun);
    const float inv = 1.0f / lrun;
    bf16_t* op = P + ((long)(b * SEQ + qrow)) * PW + CQ + h * 64;
#pragma unroll
    for (int dt = 0; dt < 2; ++dt)
#pragma unroll
        for (int q = 0; q < 4; ++q) {
            u32x2 w; w.x = pk_bf16(o[dt][4 * q] * inv, o[dt][4 * q + 1] * inv); w.y = pk_bf16(o[dt][4 * q + 2] * inv, o[dt][4 * q + 3] * inv);
            *(u32x2*)(op + dt * 32 + 8 * q + 4 * hi) = w;
        }
}

DEVI void nat_block_unit(const Params& p, int layer, int unit, bf16_t* lds) {
    unsigned char* ws = ows(p);
    bf16_t* P = (bf16_t*)(ws + OFF_P);
    const bf16_t* NVT = (const bf16_t*)(ws + OFF_NVT);
    const float* bias = p.in[4] + (long)layer * 8 * 15 * 31;
    const int tid = otid(), lane = tid & 63, wave = __builtin_amdgcn_readfirstlane(tid >> 6), l32 = lane & 31, hi = lane >> 5;
    const int wu = unit * NWAVES + wave;
    const int qt = wu & 1, h = (wu >> 1) & 7, r = (wu >> 4) & 127, b = wu >> 11;
    const int h0 = (unit * 4) & 7;
    float* bl = (float*)lds;
    for (int e = tid; e < 4 * 465; e += NTHREADS) bl[e] = bias[h0 * 465 + e];
    __syncthreads();
    const float* bh = bl + (h - h0) * 465;
    int rs = r - 4; rs = rs < 0 ? 0 : (rs > 120 ? 120 : rs);
    const int qc = qt * 32 + l32;
    int cs = qc - 8; cs = cs < 0 ? 0 : (cs > 48 ? 48 : cs);
    const long tok0 = (long)b * SEQ;
    bf16x8 qf[4];
    {
        const bf16_t* qp = P + (tok0 + r * 64 + qc) * PW + CNQ + h * 64 + hi * 8;
#pragma unroll
        for (int kk = 0; kk < 4; ++kk) qf[kk] = gld16b(qp + kk * 16);
    }
    f32x16 o[2];
#pragma unroll
    for (int dt = 0; dt < 2; ++dt)
#pragma unroll
        for (int i = 0; i < 16; ++i) o[dt][i] = 0.f;
    float mrun = -INFINITY, lrun = 0.f;
    const int kr = kperm(l32);
    constexpr float C = 0.125f * LOG2E;
    const bf16_t* kbase = P + (tok0 + kr) * PW + CNK + h * 64 + hi * 8;
    const bf16_t* vbase = NVT + ((long)(b * 8 + h) * 64 + l32) * SEQ + hi * 8;
    bf16_t* wl = (bf16_t*)((unsigned char*)lds + 8192) + wave * (64 * LSTR);
    const int srow = lane >> 3, scol = (lane & 7) * 8;
    const bf16_t* kg = P + (tok0 + srow) * PW + CNK + h * 64 + scol;
    const bf16_t* vg = NVT + ((long)(b * 8 + h) * 64 + srow) * SEQ + scol;
    u32x4 kst[8], vst[8];
#define NAT_LOADK(krow) do { _Pragma("unroll") for (int i = 0; i < 8; ++i) kst[i] = gld16(kg + (long)((krow) * 64 + 8 * i) * PW); } while (0)
#define NAT_LOADV(krow) do { _Pragma("unroll") for (int i = 0; i < 8; ++i) vst[i] = gld16(vg + (long)(8 * i) * SEQ + (krow) * 64); } while (0)
    NAT_LOADK(rs);
    NAT_LOADV(rs);
#pragma unroll 1
    for (int ir = 0; ir < 8; ++ir) {
        const int krow = rs + ir;
        const int nrow = (ir < 7) ? krow + 1 : krow;
        const float* brow = bh + (krow - r + 7) * 31 + 15 - qc;
        bf16x8 kf[2][4], vf[2][2][2];
#pragma unroll
        for (int i = 0; i < 8; ++i) *(u32x4*)(wl + (srow + 8 * i) * LSTR + scol) = kst[i];
        __builtin_amdgcn_sched_barrier(0);
#pragma unroll
        for (int kt = 0; kt < 2; ++kt)
#pragma unroll
            for (int kk = 0; kk < 4; ++kk) kf[kt][kk] = *(const bf16x8*)(wl + (kt * 32 + kr) * LSTR + hi * 8 + kk * 16);
        __builtin_amdgcn_sched_barrier(0);
        NAT_LOADK(nrow);
        f32x16 s[2];
#pragma unroll
        for (int kt = 0; kt < 2; ++kt) {
#pragma unroll
            for (int i = 0; i < 16; ++i) s[kt][i] = 0.f;
#pragma unroll
            for (int kk = 0; kk < 4; ++kk) s[kt] = mfma32(kf[kt][kk], qf[kk], s[kt]);
        }
        __builtin_amdgcn_sched_barrier(0);
#pragma unroll
        for (int i = 0; i < 8; ++i) *(u32x4*)(wl + (srow + 8 * i) * LSTR + scol) = vst[i];
        __builtin_amdgcn_sched_barrier(0);
#pragma unroll
        for (int dt = 0; dt < 2; ++dt)
#pragma unroll
            for (int kt = 0; kt < 2; ++kt)
#pragma unroll
                for (int sl = 0; sl < 2; ++sl) vf[dt][kt][sl] = *(const bf16x8*)(wl + (dt * 32 + l32) * LSTR + hi * 8 + kt * 32 + sl * 16);
        __builtin_amdgcn_sched_barrier(0);
        NAT_LOADV(nrow);
        float mx = -INFINITY;
#pragma unroll
        for (int g4 = 0; g4 < 4; ++g4) {
            const int kt = g4 >> 1, sl = g4 & 1;
            const bool dead = (g4 == 3 && qt == 0) || (g4 == 0 && qt == 1);
            if (!dead) {
#pragma unroll
                for (int e = 0; e < 8; ++e) {
                    const int i = sl * 8 + e;
                    const int kc = kt * 32 + 16 * sl + 8 * hi + e;
                    const bool valid = (kc >= cs) && (kc < cs + 16);
                    const float bv = brow[valid ? kc : qc];
                    const float v = valid ? (s[kt][i] * C + bv * LOG2E) : -INFINITY;
                    s[kt][i] = v; mx = fmaxf(mx, v);
                }
            }
        }
        mx = fmaxf(mx, xhalf(mx));
        const float mnew = fmaxf(mrun, mx);
        const float alpha = fexp2(mrun - mnew);
        mrun = mnew;
        float ps = 0.f;
        bf16x8 pb[2][2];
#pragma unroll
        for (int g4 = 0; g4 < 4; ++g4) {
            const int kt = g4 >> 1, sl = g4 & 1;
            const bool dead = (g4 == 3 && qt == 0) || (g4 == 0 && qt == 1);
            if (!dead) {
                float pe[8];
#pragma unroll
                for (int e = 0; e < 8; ++e) { pe[e] = fexp2(s[kt][sl * 8 + e] - mnew); ps += pe[e]; }
                u32x4 w;
                w.x = pk_bf16_m(pe[0], pe[1]); w.y = pk_bf16_m(pe[2], pe[3]); w.z = pk_bf16_m(pe[4], pe[5]); w.w = pk_bf16_m(pe[6], pe[7]);
                pb[kt][sl] = __builtin_bit_cast(bf16x8, w);
            }
        }
        lrun = lrun * alpha + ps;
#pragma unroll
        for (int dt = 0; dt < 2; ++dt)
#pragma unroll
            for (int i = 0; i < 16; ++i) o[dt][i] *= alpha;
#pragma unroll
        for (int g4 = 0; g4 < 4; ++g4) {
            const int kt = g4 >> 1, sl = g4 & 1;
            const bool dead = (g4 == 3 && qt == 0) || (g4 == 0 && qt == 1);
            if (!dead) {
#pragma unroll
                for (int dt = 0; dt < 2; ++dt) o[dt] = mfma32(vf[dt][kt][sl], pb[kt][sl], o[dt]);
            }
        }
        __builtin_amdgcn_sched_barrier(0);
    }
#undef NAT_LOADK
#undef NAT_LOADV
    lrun += xhalf(lrun);
    const float inv = 1.0f / lrun;
    bf16_t* op = P + (tok0 + r * 64 + qc) * PW + CNQ + h * 64;
#pragma unroll
    for (int dt = 0; dt < 2; ++dt)
#pragma unroll
        for (int q = 0; q < 4; ++q) {
            u32x2 w; w.x = pk_bf16(o[dt][4 * q] * inv, o[dt][4 * q + 1] * inv); w.y = pk_bf16(o[dt][4 * q + 2] * inv, o[dt][4 * q + 3] * inv);
            *(u32x2*)(op + dt * 32 + 8 * q + 4 * hi) = w;
        }
}

DEVI void s5z_tile(const Params& p, int layer, int t, bf16_t* lds) {
    unsigned char* ws = ows(p);
    const bf16_t* P = (const bf16_t*)(ws + OFF_P);
    const bf16_t* Zt = (const bf16_t*)(ws + OFF_S5 + layer * S5_LAYER + S5_ZT);
    float* ZS = (float*)(ws + OFF_ZS);
    const int lane = otid() & 63, wave = __builtin_amdgcn_readfirstlane(otid() >> 6), wn = wave & 1, wm = wave >> 1, l32 = lane & 31, hi = lane >> 5;
    const int g = t >> 2, tm = t & 3;
    const int m0 = tm * 256;
    f32x16 acc[4][2];
    zero_acc<4, 2>(acc);
    gemm_kloop<4, 2>(acc, Zt + ((long)g * 256) * 512, 512, P + ((long)m0 * 32) * PW + CSU + g * 16, XS5{}, 512, lds);
#pragma unroll
    for (int mt = 0; mt < 2; ++mt) {
        const int R = m0 + wm * 64 + mt * 32 + l32, b = R >> 8, c = R & 255;
        float* zp = ZS + ((long)((b * 32 + g) * 256 + c)) * 256 + wn * 128;
#pragma unroll
        for (int nt = 0; nt < 4; ++nt)
#pragma unroll
            for (int q = 0; q < 4; ++q) {
                f32x4 v = {acc[nt][mt][4 * q], acc[nt][mt][4 * q + 1], acc[nt][mt][4 * q + 2], acc[nt][mt][4 * q + 3]};
                *(f32x4*)(zp + nt * 32 + 8 * q + 4 * hi) = v;
            }
    }
}


DEVI void scan_wave_unit(const Params& p, int layer, int b, int g, int dir) {
    unsigned char* ws = ows(p);
    const float* ZS = (const float*)(ws + OFF_ZS);
    bf16_t* SP = (bf16_t*)(ws + OFF_SPREV);
    const f32x2* LT = (const f32x2*)(ws + OFF_S5 + layer * S5_LAYER + S5_LAMT);
    const int lane = otid() & 63;
    const f32x2 lt = LT[(dir * 32 + g) * 64 + lane];
    const long base = ((long)(b * 32 + g) * 256) * 256 + dir * 128 + lane;
    float sr = 0.f, si = 0.f;
    for (int cb = 0; cb < 16; ++cb) {
        float zr[16], zi[16];
#pragma unroll
        for (int i = 0; i < 16; ++i) {
            const int cc = cb * 16 + i, c = dir ? 255 - cc : cc;
            zr[i] = __uint_as_float(__hip_atomic_load((const unsigned*)(ZS + base + (long)c * 256), __ATOMIC_RELAXED, __HIP_MEMORY_SCOPE_AGENT));
            zi[i] = __uint_as_float(__hip_atomic_load((const unsigned*)(ZS + base + (long)c * 256 + 64), __ATOMIC_RELAXED, __HIP_MEMORY_SCOPE_AGENT));
        }
#pragma unroll
        for (int i = 0; i < 16; ++i) {
            const int cc = cb * 16 + i, c = dir ? 255 - cc : cc;
            SP[base + (long)c * 256] = f2bf(sr); SP[base + (long)c * 256 + 64] = f2bf(si);
            const float nr = lt.x * sr - lt.y * si + zr[i], ni = lt.x * si + lt.y * sr + zi[i];
            sr = nr; si = ni;
        }
    }
}

DEVI void s5c_tile(const Params& p, int layer, int t, bf16_t* lds) {
    unsigned char* ws = ows(p);
    const bf16_t* P = (const bf16_t*)(ws + OFF_P);
    const bf16_t* SP = (const bf16_t*)(ws + OFF_SPREV);
    const bf16_t* Bt = (const bf16_t*)(ws + OFF_S5 + layer * S5_LAYER + S5_BT);
    bf16_t* ZB = (bf16_t*)(ws + OFF_ZB);
    const int lane = otid() & 63, wave = __builtin_amdgcn_readfirstlane(otid() >> 6), wn = wave & 1, wm = wave >> 1, l32 = lane & 31, hi = lane >> 5;
    {
        const int g = t >> 3, tm = (t >> 1) & 3, tn = t & 1;
        const int n0 = tn * 256, m0 = tm * 256;
        f32x16 acc[4][2];
        zero_acc<4, 2>(acc);
        gemm_kloop<4, 2>(acc, Bt + ((long)g * 512 + n0) * 768, 768, P + ((long)m0 * 32) * PW + CSU + g * 16, XS5{}, 512, lds);
        gemm_kloop<4, 2>(acc, Bt + ((long)g * 512 + n0) * 768 + 512, 768, SP + ((long)(((m0 >> 8) * 32 + g) * 256)) * 256, XRow{256}, 256, lds);
#pragma unroll
        for (int mt = 0; mt < 2; ++mt) {
            const int R = m0 + wm * 64 + mt * 32 + l32;
#pragma unroll
            for (int nt = 0; nt < 4; ++nt)
#pragma unroll
                for (int q = 0; q < 4; ++q) {
                    const int n = n0 + wn * 128 + nt * 32 + 8 * q + 4 * hi;
                    u32x2 w;
                    w.x = pk_bf16(gelu_tanh(acc[nt][mt][4 * q]), gelu_tanh(acc[nt][mt][4 * q + 1]));
                    w.y = pk_bf16(gelu_tanh(acc[nt][mt][4 * q + 2]), gelu_tanh(acc[nt][mt][4 * q + 3]));
                    *(u32x2*)(ZB + ((long)R * 32 + (n >> 4)) * 512 + g * 16 + (n & 15)) = w;
                }
        }
    }
}

DEVI void glu_tile(const Params& p, int layer, int t, bf16_t* lds) {
    unsigned char* ws = ows(p);
    bf16_t* P = (bf16_t*)(ws + OFF_P);
    const bf16_t* ZB = (const bf16_t*)(ws + OFF_ZB);
    const bf16_t* wt = (const bf16_t*)(ws + OFF_W + layer * W_LAYER + W_GLU);
    const int lane = otid() & 63, wave = __builtin_amdgcn_readfirstlane(otid() >> 6), wn = wave & 1, wm = wave >> 1, l32 = lane & 31, hi = lane >> 5;
    {
        const int tm = t >> 1, tn = t & 1;
        const int n0 = tn * 256, m0 = tm * 256;
        f32x16 acc[4][2];
        zero_acc<4, 2>(acc);
        gemm_kloop<4, 2>(acc, wt + (long)n0 * 512, 512, ZB + (long)m0 * 512, XRow{512}, 512, lds);
#pragma unroll
        for (int mt = 0; mt < 2; ++mt) {
            const int m = m0 + wm * 64 + mt * 32 + l32;
#pragma unroll
            for (int nt = 0; nt < 4; ++nt)
#pragma unroll
                for (int q = 0; q < 4; ++q) {
                    const int n = n0 + wn * 128 + nt * 32 + 8 * q + 4 * hi;
                    const u32x2 zz = *(const u32x2*)(ZB + (long)m * 512 + n);
                    const float z0 = bf2f(zz.x & 0xffffu), z1 = bf2f(zz.x >> 16), z2 = bf2f(zz.y & 0xffffu), z3 = bf2f(zz.y >> 16);
                    u32x2 w;
                    w.x = pk_bf16(z0 * sigmoidf_(acc[nt][mt][4 * q]), z1 * sigmoidf_(acc[nt][mt][4 * q + 1]));
                    w.y = pk_bf16(z2 * sigmoidf_(acc[nt][mt][4 * q + 2]), z3 * sigmoidf_(acc[nt][mt][4 * q + 3]));
                    *(u32x2*)(P + (long)m * PW + CSU + n) = w;
                }
        }
    }
}

DEVI int queue_grab(unsigned* ctr, volatile unsigned* slot, int tid) {
    asm volatile("s_waitcnt vmcnt(0)" ::: "memory");
    __syncthreads();
    if (tid == 0) *slot = __hip_atomic_fetch_add(ctr, 1u, __ATOMIC_RELAXED, __HIP_MEMORY_SCOPE_AGENT);
    __syncthreads();
    return (int)*slot;
}
DEVI void phase_mixers(const Params& p, int layer, bf16_t* lds) {
    unsigned char* ws = ows(p);
    unsigned* ctl = (unsigned*)(ws + OFF_CTL);
    unsigned* q = ctl + 64 + layer * 320;
    unsigned* done = ctl + 704 + layer * 64;
    volatile unsigned* slot = (volatile unsigned*)((unsigned char*)lds + LDS_BYTES - 16);
    const int tid = otid();
    const int wave = __builtin_amdgcn_readfirstlane(tid >> 6);
    const int xcd = (int)(__builtin_amdgcn_s_getreg((3 << 11) | 20) & 7u);
    int u;
    while ((u = queue_grab(q, slot, tid)) < 128) {
        const int g = u >> 2, b = u & 3;
        s5z_tile(p, layer, u, lds);
        asm volatile("s_waitcnt vmcnt(0)" ::: "memory");
        __syncthreads();
        if (wave < 2) scan_wave_unit(p, layer, b, g, wave);
        asm volatile("s_waitcnt vmcnt(0)" ::: "memory");
        __syncthreads();
        s5c_tile(p, layer, (g << 3) + (b << 1), lds);
        s5c_tile(p, layer, (g << 3) + (b << 1) + 1, lds);
        asm volatile("s_waitcnt vmcnt(0)" ::: "memory");
        __syncthreads();
        if (tid == 0) {
            __builtin_amdgcn_fence(__ATOMIC_RELEASE, "agent");
            asm volatile("s_waitcnt vmcnt(0)" ::: "memory");
            __hip_atomic_fetch_add(done + b * 16, 1u, __ATOMIC_RELAXED, __HIP_MEMORY_SCOPE_AGENT);
        }
    }
#pragma unroll 1
    for (int j8 = 0; j8 < 8; ++j8) {
        const int xs = (xcd + j8) & 7;
        while ((u = queue_grab(q + 16 * (1 + xs), slot, tid)) < 128)
            gqa_unit(p, layer, ((xs >> 1) << 8) | ((((xs & 1) << 2) | (u & 3)) << 5) | (u >> 2), lds);
    }
    while ((u = queue_grab(q + 16 * 9, slot, tid)) < 256) {
        const int b = u >> 6;
        if (tid == 0) {
            while (__hip_atomic_load(done + b * 16, __ATOMIC_RELAXED, __HIP_MEMORY_SCOPE_AGENT) < 32u) __builtin_amdgcn_s_sleep(8);
            __builtin_amdgcn_fence(__ATOMIC_ACQUIRE, "agent");
            asm volatile("s_waitcnt vmcnt(0)" ::: "memory");
        }
        __syncthreads();
        glu_tile(p, layer, u, lds);
    }
#pragma unroll 1
    for (int j8 = 0; j8 < 8; ++j8) {
        const int xs = (xcd + j8) & 7;
        while ((u = queue_grab(q + 16 * (10 + xs), slot, tid)) < 128)
            nat_block_unit(p, layer, ((xs >> 1) << 8) | (u << 1) | (xs & 1), lds);
    }
}

DEVI void phase_merge(const Params& p, int layer, bf16_t* lds) {
    unsigned char* ws = ows(p);
    const bf16_t* P = (const bf16_t*)(ws + OFF_P);
    const bf16_t* xb = (const bf16_t*)(ws + OFF_XB);
    const bf16_t* wg = (const bf16_t*)(ws + OFF_W + layer * W_LAYER + W_IN) + (long)PW * DM;
    const bf16_t* wbr = (const bf16_t*)(ws + OFF_W + layer * W_LAYER + W_BR);
    bf16_t* MG = (bf16_t*)(ws + OFF_MERGED);
    const int lane = otid() & 63, wave = __builtin_amdgcn_readfirstlane(otid() >> 6), wn = wave & 1, wm = wave >> 1, l32 = lane & 31, hi = lane >> 5;
    for (int t = vblock(); t < 8 * 128; t += gridDim.x) {
        const int tm = t >> 3, tn = t & 7;
        const int n0 = tn * 128, m0 = tm * 256;
        f32x16 mg[2][2];
        zero_acc<2, 2>(mg);
#pragma unroll 1
        for (int br = 0; br < 3; ++br) {
            const int bcol = (br == 0) ? CQ : (br == 1 ? CNQ : CSU);
            f32x16 acc[2][2];
            unsigned sg[2][2][8];
            zero_acc<2, 2>(acc);
            gemm_kloop<2, 2>(acc, wg + ((long)br * DM + n0) * DM, DM, xb + (long)m0 * DM, XRow{DM}, DM, lds);
#pragma unroll
            for (int nt = 0; nt < 2; ++nt)
#pragma unroll
                for (int mt = 0; mt < 2; ++mt)
#pragma unroll
                    for (int i = 0; i < 8; ++i) sg[nt][mt][i] = pk_bf16(sigmoidf_(acc[nt][mt][2 * i]), sigmoidf_(acc[nt][mt][2 * i + 1]));
            zero_acc<2, 2>(acc);
            gemm_kloop<2, 2>(acc, wbr + ((long)br * DM + n0) * 512, 512, P + (long)m0 * PW + bcol, XRow{PW}, 512, lds);
#pragma unroll
            for (int nt = 0; nt < 2; ++nt)
#pragma unroll
                for (int mt = 0; mt < 2; ++mt)
#pragma unroll
                    for (int i = 0; i < 8; ++i) {
                        mg[nt][mt][2 * i] += bf2f(sg[nt][mt][i] & 0xffffu) * acc[nt][mt][2 * i];
                        mg[nt][mt][2 * i + 1] += bf2f(sg[nt][mt][i] >> 16) * acc[nt][mt][2 * i + 1];
                    }
        }
        __syncthreads();
        bf16_t* wl = lds + wave * (64 * 72);
#pragma unroll
        for (int mt = 0; mt < 2; ++mt)
#pragma unroll
            for (int nt = 0; nt < 2; ++nt)
#pragma unroll
                for (int q = 0; q < 4; ++q) {
                    u32x2 w; w.x = pk_bf16(mg[nt][mt][4 * q], mg[nt][mt][4 * q + 1]); w.y = pk_bf16(mg[nt][mt][4 * q + 2], mg[nt][mt][4 * q + 3]);
                    *(u32x2*)(wl + (mt * 32 + l32) * 72 + nt * 32 + 8 * q + 4 * hi) = w;
                }
        wave_rows_out<2>(wl, MG + (long)(m0 + wm * 64) * DM + n0 + wn * 64, DM, lane);
    }
}

DEVI void phase_res_gemm_ln(const bf16_t* A, int K, const bf16_t* wt, float* out, bf16_t* xb, const float* gain, const float* bias,
                            f32x2* stats, unsigned* cnt, bf16_t* lds, bool rev = false) {
    const int tid = otid(), lane = tid & 63, wave = __builtin_amdgcn_readfirstlane(tid >> 6), wn = wave & 1, wm = wave >> 1, l32 = lane & 31, hi = lane >> 5;
    for (int t = vblock(); t < 4 * 128; t += gridDim.x) {
        const int tm = rev ? 127 - (t >> 2) : (t >> 2), tn = t & 3;
        const int n0 = tn * 256, m0 = tm * 256;
        f32x16 acc[4][2];
        zero_acc<4, 2>(acc);
        gemm_kloop<4, 2>(acc, wt + (long)n0 * K, K, A + (long)m0 * K, XRow{K}, K, lds);
#pragma unroll
        for (int mt = 0; mt < 2; ++mt) {
            const int m = m0 + wm * 64 + mt * 32 + l32;
            float s1 = 0.f, s2 = 0.f;
#pragma unroll
            for (int nt = 0; nt < 4; ++nt)
#pragma unroll
                for (int q = 0; q < 4; ++q) {
                    const long idx = (long)m * DM + n0 + wn * 128 + nt * 32 + 8 * q + 4 * hi;
                    const u32x2 rr = *(const u32x2*)(xb + idx);
                    const float r[4] = {bf2f(rr.x & 0xffffu), bf2f(rr.x >> 16), bf2f(rr.y & 0xffffu), bf2f(rr.y >> 16)};
#pragma unroll
                    for (int e = 0; e < 4; ++e) {
                        const float v = ALPHA * r[e] + acc[nt][mt][4 * q + e];
                        acc[nt][mt][4 * q + e] = v; s1 += v; s2 += v * v;
                    }
                }
            s1 += xhalf(s1); s2 += xhalf(s2);
            if (hi == 0) __hip_atomic_store((unsigned long long*)(stats + (long)m * 8 + tn * 2 + wn),
                                            ((unsigned long long)__float_as_uint(s2) << 32) | (unsigned long long)__float_as_uint(s1), __ATOMIC_RELAXED, __HIP_MEMORY_SCOPE_AGENT);
        }
        asm volatile("s_waitcnt vmcnt(0)" ::: "memory");
        __syncthreads();
        if (tid == 0) {
            __hip_atomic_fetch_add(cnt + tm, 1u, __ATOMIC_RELAXED, __HIP_MEMORY_SCOPE_AGENT);
            while (__hip_atomic_load(cnt + tm, __ATOMIC_RELAXED, __HIP_MEMORY_SCOPE_AGENT) < 4u) __builtin_amdgcn_s_sleep(1);
        }
        __syncthreads();
        float mu[2], rstd[2];
#pragma unroll
        for (int mt = 0; mt < 2; ++mt) {
            const int m = m0 + wm * 64 + mt * 32 + l32;
            float s1 = 0.f, s2 = 0.f;
#pragma unroll
            for (int j = 0; j < 8; ++j) {
                const unsigned long long pj = __hip_atomic_load((unsigned long long*)(stats + (long)m * 8 + j), __ATOMIC_RELAXED, __HIP_MEMORY_SCOPE_AGENT);
                s1 += __uint_as_float((unsigned)pj); s2 += __uint_as_float((unsigned)(pj >> 32));
            }
            mu[mt] = s1 * (1.0f / DM);
            const float var = fmaxf(s2 * (1.0f / DM) - mu[mt] * mu[mt], 0.f);
            rstd[mt] = rsqrtf(var + 1e-5f);
        }
#pragma unroll
        for (int nt = 0; nt < 4; ++nt) {
#pragma unroll
            for (int q = 0; q < 4; ++q) {
                const int n = n0 + wn * 128 + nt * 32 + 8 * q + 4 * hi;
                const f32x4 g4 = *(const GAS f32x4*)(const GAS float*)(gain + n), b4 = *(const GAS f32x4*)(const GAS float*)(bias + n);
#pragma unroll
                for (int mt = 0; mt < 2; ++mt) {
                    acc[nt][mt][4 * q] = (acc[nt][mt][4 * q] - mu[mt]) * rstd[mt] * g4.x + b4.x; acc[nt][mt][4 * q + 1] = (acc[nt][mt][4 * q + 1] - mu[mt]) * rstd[mt] * g4.y + b4.y;
                    acc[nt][mt][4 * q + 2] = (acc[nt][mt][4 * q + 2] - mu[mt]) * rstd[mt] * g4.z + b4.z; acc[nt][mt][4 * q + 3] = (acc[nt][mt][4 * q + 3] - mu[mt]) * rstd[mt] * g4.w + b4.w;
                }
            }
            __builtin_amdgcn_sched_barrier(0);
        }
        __builtin_amdgcn_sched_barrier(0);
        if (out) {
#pragma unroll
            for (int mt = 0; mt < 2; ++mt) {
                float* orow = out + (long)(m0 + wm * 64 + mt * 32 + l32) * DM + n0 + wn * 128 + 4 * hi;
#pragma unroll
                for (int nt = 0; nt < 4; ++nt)
#pragma unroll
                    for (int q = 0; q < 4; ++q)
                        *(f32x4*)(orow + nt * 32 + 8 * q) = (f32x4){acc[nt][mt][4 * q], acc[nt][mt][4 * q + 1], acc[nt][mt][4 * q + 2], acc[nt][mt][4 * q + 3]};
            }
        } else {
            bf16_t* wl = lds + wave * (64 * 136);
#pragma unroll
            for (int mt = 0; mt < 2; ++mt)
#pragma unroll
                for (int nt = 0; nt < 4; ++nt)
#pragma unroll
                    for (int q = 0; q < 4; ++q) {
                        u32x2 w; w.x = pk_bf16(acc[nt][mt][4 * q], acc[nt][mt][4 * q + 1]); w.y = pk_bf16(acc[nt][mt][4 * q + 2], acc[nt][mt][4 * q + 3]);
                        *(u32x2*)(wl + (mt * 32 + l32) * 136 + nt * 32 + 8 * q + 4 * hi) = w;
                    }
            wave_rows_out<4>(wl, xb + (long)(m0 + wm * 64) * DM + n0 + wn * 128, DM, lane);
        }
    }
}

DEVI void phase_ffn_up(const Params& p, int layer, bf16_t* lds) {
    unsigned char* ws = ows(p);
    const bf16_t* xb = (const bf16_t*)(ws + OFF_XB);
    const bf16_t* wt = (const bf16_t*)(ws + OFF_W + layer * W_LAYER + W_UP);
    bf16_t* H = (bf16_t*)(ws + OFF_H);
    const int lane = otid() & 63, wave = __builtin_amdgcn_readfirstlane(otid() >> 6), wn = wave & 1, wm = wave >> 1, l32 = lane & 31, hi = lane >> 5;
    for (int t = vblock(); t < 16 * 128; t += gridDim.x) {
        const int v8 = t & 255, grp = v8 >> 5, w5 = v8 & 31;
        const int tm = (t >> 8) * 16 + (grp & 3) * 4 + (w5 & 3), tn = (grp >> 2) * 8 + (w5 >> 2);
        const int n0 = tn * 256, m0 = tm * 256;
        f32x16 acc[4][2];
        zero_acc<4, 2>(acc);
        gemm_kloop<4, 2>(acc, wt + (long)n0 * DM, DM, xb + (long)m0 * DM, XRow{DM}, DM, lds);
        __syncthreads();
        bf16_t* wl = lds + wave * (64 * 136);
#pragma unroll
        for (int mt = 0; mt < 2; ++mt)
#pragma unroll
            for (int nt = 0; nt < 4; ++nt)
#pragma unroll
                for (int q = 0; q < 4; ++q) {
                    float v[4];
#pragma unroll
                    for (int e = 0; e < 4; ++e) { const float a = fmaxf(acc[nt][mt][4 * q + e], 0.f); v[e] = a * a; }
                    u32x2 w; w.x = pk_bf16(v[0], v[1]); w.y = pk_bf16(v[2], v[3]);
                    *(u32x2*)(wl + (mt * 32 + l32) * 136 + nt * 32 + 8 * q + 4 * hi) = w;
                }
        wave_rows_out<4>(wl, H + (long)(m0 + wm * 64) * FFN + n0 + wn * 128, FFN, lane);
    }
}

DEVI void phase_ln(const float* src, float* dst, bf16_t* xb, const float* gain, const float* bias) {
    const int lane = otid() & 63, wave = otid() >> 6;
    for (int row = blockIdx.x * NWAVES + wave; row < MTOK; row += gridDim.x * NWAVES) {
        const float* s = src + (long)row * DM;
        f32x4 v[4];
#pragma unroll
        for (int i = 0; i < 4; ++i) v[i] = *(const f32x4*)(s + i * 256 + lane * 4);
        float sum = 0.f;
#pragma unroll
        for (int i = 0; i < 4; ++i) sum += v[i].x + v[i].y + v[i].z + v[i].w;
#pragma unroll
        for (int o = 1; o < 64; o <<= 1) sum += __shfl_xor(sum, o);
        const float mu = sum * (1.0f / DM);
        float sq = 0.f;
#pragma unroll
        for (int i = 0; i < 4; ++i) { v[i].x -= mu; v[i].y -= mu; v[i].z -= mu; v[i].w -= mu; sq += v[i].x * v[i].x + v[i].y * v[i].y + v[i].z * v[i].z + v[i].w * v[i].w; }
#pragma unroll
        for (int o = 1; o < 64; o <<= 1) sq += __shfl_xor(sq, o);
        const float rstd = rsqrtf(sq * (1.0f / DM) + 1e-5f);
#pragma unroll
        for (int i = 0; i < 4; ++i) {
            const int c = i * 256 + lane * 4;
            const f32x4 g = *(const f32x4*)(gain + c), bb = *(const f32x4*)(bias + c);
            f32x4 y;
            y.x = v[i].x * rstd * g.x + bb.x; y.y = v[i].y * rstd * g.y + bb.y; y.z = v[i].z * rstd * g.z + bb.z; y.w = v[i].w * rstd * g.w + bb.w;
            *(f32x4*)(dst + (long)row * DM + c) = y;
            u32x2 w; w.x = pk_bf16(y.x, y.y); w.y = pk_bf16(y.z, y.w);
            *(u32x2*)(xb + (long)row * DM + c) = w;
        }
    }
}

DEVI void transpose_mat(const float* src, int K, int N, bf16_t* dst, float* tl) {
    const int tid = otid();
    const int tk = K / 64, tn = N / 64;
    for (int t = blockIdx.x; t < tk * tn; t += gridDim.x) {
        const int k0 = (t / tn) * 64, n0 = (t % tn) * 64;
        __syncthreads();
#pragma unroll
        for (int i = 0; i < 2; ++i) {
            const int e = tid + 512 * i, r = e >> 4, c4 = (e & 15) * 4;
            const f32x4 v = *(const f32x4*)(src + (long)(k0 + r) * N + n0 + c4);
            tl[r * 65 + c4] = v.x; tl[r * 65 + c4 + 1] = v.y; tl[r * 65 + c4 + 2] = v.z; tl[r * 65 + c4 + 3] = v.w;
        }
        __syncthreads();
#pragma unroll
        for (int i = 0; i < 1; ++i) {
            const int e = tid, n = e >> 3, kc = (e & 7) * 8;
            u32x4 w;
            w.x = pk_bf16(tl[(kc + 0) * 65 + n], tl[(kc + 1) * 65 + n]); w.y = pk_bf16(tl[(kc + 2) * 65 + n], tl[(kc + 3) * 65 + n]);
            w.z = pk_bf16(tl[(kc + 4) * 65 + n], tl[(kc + 5) * 65 + n]); w.w = pk_bf16(tl[(kc + 6) * 65 + n], tl[(kc + 7) * 65 + n]);
            *(u32x4*)(dst + (long)(n0 + n) * K + k0 + kc) = w;
        }
    }
}

struct Cx { float re, im; };
DEVI Cx cmul(Cx a, Cx b) { return {a.re * b.re - a.im * b.im, a.re * b.im + a.im * b.re}; }
DEVI Cx lam_pow(float are, float aim, float dt, float n) {
    const float mag = fexp2(are * dt * n * LOG2E);
    const float ph = (aim * dt) * n;
    return {mag * __cosf(ph), mag * __sinf(ph)};
}
DEVI Cx zoh_coef(float are, float aim, float dt) {
    const Cx lam = lam_pow(are, aim, dt, 1.0f);
    const float den = are * are + aim * aim, nr = lam.re - 1.0f;
    return {(nr * are + lam.im * aim) / den, (lam.im * are - nr * aim) / den};
}

DEVI void phase_prologue_a(const Params& p, bf16_t* lds) {
    unsigned char* ws = ows(p);
    float* tl = (float*)lds;
    const int tid = otid();
    const long gtid = (long)blockIdx.x * NTHREADS + tid, gsz = (long)gridDim.x * NTHREADS;
    {
        const float* x = p.in[0];
        bf16_t* xb = (bf16_t*)(ws + OFF_XB);
        for (long e = gtid; e < (long)MTOK * DM / 4; e += gsz) {
            const f32x4 v = *(const f32x4*)(x + e * 4);
            u32x2 w; w.x = pk_bf16(v.x, v.y); w.y = pk_bf16(v.z, v.w);
            *(u32x2*)(xb + e * 4) = w;
        }
    }
    for (int layer = 0; layer < 2; ++layer) {
        unsigned char* wl = ws + OFF_W + layer * W_LAYER;
        transpose_mat(p.in[1] + (long)layer * DM * INW, DM, INW, (bf16_t*)(wl + W_IN), tl);
        transpose_mat(p.in[13] + (long)layer * 512 * 512, 512, 512, (bf16_t*)(wl + W_GLU), tl);
        for (int br = 0; br < 3; ++br)
            transpose_mat(p.in[14] + ((long)layer * 3 + br) * 512 * DM, 512, DM, (bf16_t*)(wl + W_BR) + (long)br * DM * 512, tl);
        transpose_mat(p.in[15] + (long)layer * DM * DM, DM, DM, (bf16_t*)(wl + W_OUT), tl);
        transpose_mat(p.in[18] + (long)layer * DM * FFN, DM, FFN, (bf16_t*)(wl + W_UP), tl);
        transpose_mat(p.in[19] + (long)layer * FFN * DM, FFN, DM, (bf16_t*)(wl + W_DN), tl);

        unsigned char* sl = ws + OFF_S5 + layer * S5_LAYER;
        bf16_t* Bt = (bf16_t*)(sl + S5_BT);
        bf16_t* Zt = (bf16_t*)(sl + S5_ZT);
        float* KT = (float*)(sl + S5_KTAB);
        f32x2* LT = (f32x2*)(sl + S5_LAMT);
        const float* a_re = p.in[5] + layer * 2 * 32 * 64;
        const float* a_im = p.in[6] + layer * 2 * 32 * 64;
        const float* ldt = p.in[7] + layer * 2 * 32;
        const float* b_re = p.in[8] + (long)layer * 32 * 64 * 16;
        const float* b_im = p.in[9] + (long)layer * 32 * 64 * 16;
        const float* c_re = p.in[10] + (long)layer * 2 * 32 * 16 * 64;
        const float* c_im = p.in[11] + (long)layer * 2 * 32 * 16 * 64;
        for (long e = gtid; e < 2 * 32 * 64; e += gsz) {
            const int dg = (int)(e >> 6);
            const float dt = __expf(ldt[dg]);
            const Cx l = lam_pow(a_re[e], a_im[e], dt, 32.0f);
            LT[e] = (f32x2){l.re, l.im};
        }
        for (long e = gtid; e < 32 * 2 * 32 * 64; e += gsz) {
            const int pp = (int)(e & 63), jt = (int)((e >> 6) & 31), dir = (int)((e >> 11) & 1), g = (int)(e >> 12);
            const int ai = (dir * 32 + g) * 64 + pp;
            const float are = a_re[ai], aim = a_im[ai], dt = __expf(ldt[dir * 32 + g]);
            const Cx coef = zoh_coef(are, aim, dt);
            {
                const Cx w = cmul(lam_pow(are, aim, dt, (float)(dir == 0 ? 31 - jt : jt)), coef);
                bf16_t* zr = Zt + ((long)(g * 256 + dir * 128 + pp)) * 512 + jt * 16;
                bf16_t* zi = zr + 64 * 512;
#pragma unroll
                for (int h = 0; h < 16; ++h) {
                    const Cx bb = {b_re[(g * 64 + pp) * 16 + h], b_im[(g * 64 + pp) * 16 + h]};
                    const Cx wb = cmul(w, bb);
                    zr[h] = f2bf(wb.re); zi[h] = f2bf(wb.im);
                }
            }
            {
                const Cx lp = lam_pow(are, aim, dt, (float)(dir == 0 ? jt + 1 : 32 - jt));
#pragma unroll
                for (int h = 0; h < 16; ++h) {
                    const int ci = ((dir * 32 + g) * 16 + h) * 64 + pp;
                    const Cx c = cmul((Cx){c_re[ci], c_im[ci]}, lp);
                    bf16_t* bp = Bt + ((long)(g * 512 + jt * 16 + h)) * 768 + 512 + dir * 128 + pp;
                    bp[0] = f2bf(c.re); bp[64] = f2bf(-c.im);
                }
            }
        }
        for (int u = blockIdx.x; u < 2 * 32 * 32; u += gridDim.x) {
            const int tau = u & 31, g = (u >> 5) & 31, dir = u >> 10;
            __syncthreads();
            if (tid < 64) {
                const int ai = (dir * 32 + g) * 64 + tid;
                const float are = a_re[ai], aim = a_im[ai], dt = __expf(ldt[dir * 32 + g]);
                const Cx w = cmul(lam_pow(are, aim, dt, (float)tau), zoh_coef(are, aim, dt));
                tl[2 * tid] = w.re; tl[2 * tid + 1] = w.im;
            }
            __syncthreads();
            const int hp = (tid >> 4) & 15, h = tid & 15;
            float acc = 0.f;
            if (tid < 256)
            for (int pp = 0; pp < 64; ++pp) {
                const Cx w = {tl[2 * pp], tl[2 * pp + 1]};
                const Cx bb = {b_re[(g * 64 + pp) * 16 + h], b_im[(g * 64 + pp) * 16 + h]};
                const Cx wb = cmul(w, bb);
                const int ci = ((dir * 32 + g) * 16 + hp) * 64 + pp;
                acc += c_re[ci] * wb.re - c_im[ci] * wb.im;
            }
            if (tid < 256) KT[((long)((dir * 32 + g) * 32 + tau)) * 256 + tid] = acc;
        }
    }
}

DEVI void phase_prologue_b(const Params& p) {
    unsigned char* ws = ows(p);
    const long gtid = (long)blockIdx.x * NTHREADS + otid(), gsz = (long)gridDim.x * NTHREADS;
    for (int layer = 0; layer < 2; ++layer) {
        unsigned char* sl = ws + OFF_S5 + layer * S5_LAYER;
        bf16_t* Bt = (bf16_t*)(sl + S5_BT);
        const float* KT = (const float*)(sl + S5_KTAB);
        const float* dsk = p.in[12] + layer * 32 * 16;
        for (long e = gtid; e < 32L * 512 * 64; e += gsz) {
            const int kc = (int)(e & 63), n = (int)((e >> 6) & 511), g = (int)(e >> 15);
            const int j = kc >> 1, h0 = (kc & 1) * 8, t = n >> 4, hp = n & 15;
            float v[8];
            if (j < t) {
                const float* k = KT + ((long)((0 * 32 + g) * 32 + (t - j))) * 256 + hp * 16 + h0;
#pragma unroll
                for (int i = 0; i < 8; ++i) v[i] = k[i];
            } else if (j > t) {
                const float* k = KT + ((long)((1 * 32 + g) * 32 + (j - t))) * 256 + hp * 16 + h0;
#pragma unroll
                for (int i = 0; i < 8; ++i) v[i] = k[i];
            } else {
                const float* kf = KT + ((long)((0 * 32 + g) * 32)) * 256 + hp * 16 + h0;
                const float* kb = KT + ((long)((1 * 32 + g) * 32)) * 256 + hp * 16 + h0;
#pragma unroll
                for (int i = 0; i < 8; ++i) v[i] = kf[i] + kb[i] + ((h0 + i == hp) ? dsk[g * 16 + hp] : 0.f);
            }
            u32x4 w; w.x = pk_bf16(v[0], v[1]); w.y = pk_bf16(v[2], v[3]); w.z = pk_bf16(v[4], v[5]); w.w = pk_bf16(v[6], v[7]);
            *(u32x4*)(Bt + ((long)(g * 512 + n)) * 768 + kc * 8) = w;
        }
    }
}


#define XB_TMO      128
#define XB_XCNT(j)  (256  + 64 * (j))
#define XB_XSUB(j)  (1280 + 64 * (j))
#define XB_XGEN(j)  (2304 + 64 * (j))
#define XB_TOP      3328
#define XB_TOPGEN   3392
#define XCD_BAR_WORDS 3456
#define XB_SPIN_CAP (1u << 18)

__device__ __forceinline__ unsigned xb_ld(unsigned* p)              { return __hip_atomic_load(p, __ATOMIC_RELAXED, __HIP_MEMORY_SCOPE_AGENT); }
__device__ __forceinline__ unsigned xb_add(unsigned* p, unsigned v) { return __hip_atomic_fetch_add(p, v, __ATOMIC_RELAXED, __HIP_MEMORY_SCOPE_AGENT); }
__device__ __forceinline__ unsigned xb_xcc_id() { return (unsigned)__builtin_amdgcn_s_getreg((3 << 11) | 20) & 0xFu; }
#define XB_SPIN(cond, bar) do { unsigned _sp = 0; while (cond) { __builtin_amdgcn_s_sleep(1); \
    if ((++_sp & 255u) == 0u) { if (xb_ld(&(bar)[XB_TMO])) break; if (_sp > XB_SPIN_CAP) { atomicAdd(&(bar)[XB_TMO], 1u); break; } } } } while (0)

struct XcdBarrier {
    unsigned* bar; unsigned x;
    volatile LAS unsigned* st;
};

__device__ __forceinline__ XcdBarrier xcd_barrier_post(unsigned* bar, volatile LAS unsigned* st) {
    XcdBarrier b; b.bar = bar; b.x = xb_xcc_id(); b.st = st;
    if (threadIdx.x == 0) (void)xb_add(&bar[XB_XCNT(b.x)], 1u);
    return b;
}
__device__ __forceinline__ void xcd_barrier_complete(unsigned* bar, unsigned x, unsigned& nloc, unsigned& nx) {
    const unsigned G = gridDim.x * gridDim.y * gridDim.z;
    unsigned sum, cnt, mine, sp = 0u;
    for (;;) {
        sum = 0u; cnt = 0u; mine = 0u;
#pragma unroll
        for (unsigned j = 0; j < 16; ++j) { const unsigned c = xb_ld(&bar[XB_XCNT(j)]); sum += c; cnt += (c > 0u) ? 1u : 0u; mine = (j == x) ? c : mine; }
        if (sum == G) break;
        __builtin_amdgcn_s_sleep(1);
        if ((++sp & 255u) == 0u) { if (xb_ld(&bar[XB_TMO])) break; if (sp > XB_SPIN_CAP) { atomicAdd(&bar[XB_TMO], 1u); break; } }
    }
    nloc = mine > 0u ? mine : 1u; nx = cnt > 0u ? cnt : 1u;
}

__device__ __forceinline__ void xcd_barrier(const XcdBarrier& b) {
    asm volatile("s_waitcnt vmcnt(0)" ::: "memory");
    __syncthreads();
    if (threadIdx.x == 0) {
        unsigned* bar = b.bar;
        __builtin_amdgcn_s_waitcnt(0);
        unsigned nloc = b.st[0], nx = b.st[1];
        if (nloc == 0u) { xcd_barrier_complete(bar, b.x, nloc, nx); b.st[0] = nloc; b.st[1] = nx; }
        const unsigned old = xb_add(&bar[XB_XSUB(b.x)], 1u);
        const unsigned gen = old / nloc;
        if (old + 1u == (gen + 1u) * nloc) {
            __builtin_amdgcn_fence(__ATOMIC_RELEASE, "agent");
            asm volatile("s_waitcnt vmcnt(0)" ::: "memory");
            const unsigned og = xb_add(&bar[XB_TOP], 1u);
            const unsigned tg = og / nx;
            if (og + 1u == (tg + 1u) * nx) xb_add(&bar[XB_TOPGEN], 1u);
            else XB_SPIN(xb_ld(&bar[XB_TOPGEN]) == tg, bar);
            __builtin_amdgcn_fence(__ATOMIC_ACQUIRE, "agent");
            xb_add(&bar[XB_XGEN(b.x)], 1u);
            asm volatile("s_waitcnt vmcnt(0)" ::: "memory");
        } else {
            XB_SPIN(xb_ld(&bar[XB_XGEN(b.x)]) == gen, bar);
            __builtin_amdgcn_fence(__ATOMIC_ACQUIRE, "agent");
            asm volatile("s_waitcnt vmcnt(0)" ::: "memory");
        }
    }
    __syncthreads();
}


DEVI void grid_barrier(unsigned* ctr, unsigned target) {
    asm volatile("s_waitcnt vmcnt(0) lgkmcnt(0)" ::: "memory");
    __syncthreads();
    if (threadIdx.x == 0) {
        __builtin_amdgcn_fence(__ATOMIC_RELEASE, "agent");
        asm volatile("s_waitcnt vmcnt(0)" ::: "memory");
        __hip_atomic_fetch_add(ctr, 1u, __ATOMIC_RELAXED, __HIP_MEMORY_SCOPE_AGENT);
        while (__hip_atomic_load(ctr, __ATOMIC_RELAXED, __HIP_MEMORY_SCOPE_AGENT) < target) __builtin_amdgcn_s_sleep(2);
        __builtin_amdgcn_fence(__ATOMIC_ACQUIRE, "agent");
        asm volatile("s_waitcnt vmcnt(0)" ::: "memory");
    }
    __syncthreads();
}

constexpr int PH_PER_LAYER = 6;
constexpr int N_PHASES = 2 + PH_PER_LAYER * 2;
__global__ void __launch_bounds__(NTHREADS, 2) fwd_kernel(Params p) {
    extern __shared__ __attribute__((aligned(16))) unsigned char lds_raw[];
    bf16_t* lds = (bf16_t*)lds_raw;
    unsigned char* ws = ows(p);
    volatile LAS unsigned* xst = (volatile LAS unsigned*)(LAS unsigned char*)(lds_raw + LDS_BYTES - 32);
    if (threadIdx.x == 0) { xst[0] = 0u; xst[1] = 0u; }
    __syncthreads();
    const XcdBarrier xbar = xcd_barrier_post((unsigned*)(ws + OFF_CTL + 16384), xst);
    for (int ph = p.ph_lo; ph < p.ph_hi; ++ph) {
        if (ph == 0) phase_prologue_a(p, lds);
        else if (ph == 1) phase_prologue_b(p);
        else {
            const int layer = (ph - 2) / PH_PER_LAYER, sub = (ph - 2) % PH_PER_LAYER;
            switch (sub) {
            case 0: phase_inproj(p, layer, lds); break;
            case 1: phase_mixers(p, layer, lds); break;
            case 2: phase_merge(p, layer, lds); break;
            case 3: phase_res_gemm_ln((const bf16_t*)(ws + OFF_MERGED), DM, (const bf16_t*)(ws + OFF_W + layer * W_LAYER + W_OUT), nullptr, (bf16_t*)(ws + OFF_XB),
                                      p.in[16] + layer * DM, p.in[17] + layer * DM, (f32x2*)(ws + OFF_STATS), (unsigned*)(ws + OFF_CTL) + 1024 + (layer * 2) * 128, lds); break;
            case 4: phase_ffn_up(p, layer, lds); break;
            default: phase_res_gemm_ln((const bf16_t*)(ws + OFF_H), FFN, (const bf16_t*)(ws + OFF_W + layer * W_LAYER + W_DN), layer == 1 ? p.out : nullptr, (bf16_t*)(ws + OFF_XB),
                                      p.in[20] + layer * DM, p.in[21] + layer * DM, (f32x2*)(ws + OFF_STATS), (unsigned*)(ws + OFF_CTL) + 1024 + (layer * 2 + 1) * 128, lds, true); break;
            }
        }
        if (ph + 1 < p.ph_hi) {
            if (p.ph_lo < 0) cg::this_grid().sync();
            xcd_barrier(xbar);
        }
    }
}

extern "C" void kernel_launch(void* const* d_in, const int* in_sizes, int n_in, void* d_out, int out_size, void* d_ws, size_t ws_size, hipStream_t stream) {
    static int grid = 0;
    if (grid == 0) {
        if (n_in != 22 || ws_size < WS_END) { fprintf(stderr, "kernel_launch: unexpected n_in %d / ws_size %zu\n", n_in, ws_size); grid = -1; return; }
        int dev = 0, cus = 0, per_cu = 0;
        hipGetDevice(&dev);
        hipDeviceGetAttribute(&cus, hipDeviceAttributeMultiprocessorCount, dev);
        hipFuncSetAttribute((const void*)fwd_kernel, hipFuncAttributeMaxDynamicSharedMemorySize, LDS_BYTES);
        hipOccupancyMaxActiveBlocksPerMultiprocessor(&per_cu, (const void*)fwd_kernel, NTHREADS, LDS_BYTES);
        if (per_cu < 1) per_cu = 1;
        if (per_cu > 1) per_cu = 1;
        grid = cus * per_cu;
        fprintf(stderr, "kernel_launch: grid %d (%d CUs x %d)\n", grid, cus, per_cu);
    }
    if (grid < 0) return;
    Params p{};
    for (int i = 0; i < 22; ++i) p.in[i] = (const float*)d_in[i];
    p.out = (float*)d_out; p.ws = (unsigned char*)d_ws;
#if SINGLE_LAUNCH
    hipMemsetAsync((unsigned char*)d_ws + OFF_CTL, 0, 32768, stream);
    p.ph_lo = 0; p.ph_hi = N_PHASES;
    void* args[] = {&p};
    hipError_t e = hipLaunchCooperativeKernel((const void*)fwd_kernel, dim3(grid), dim3(NTHREADS), args, LDS_BYTES, stream);
    if (e != hipSuccess) fprintf(stderr, "cooperative launch failed: %s (grid %d)\n", hipGetErrorString(e), grid);
#else
    for (int ph = 0; ph < N_PHASES; ++ph) {
        p.ph_lo = ph; p.ph_hi = ph + 1;
        hipLaunchKernelGGL(fwd_kernel, dim3(grid), dim3(NTHREADS), LDS_BYTES, stream, p);
    }
#endif
}
```
